# Optimizing an MI355X kernel written in HIP

```python
import math
import jax, jax.numpy as jnp
from jax import lax
import numpy as np

D_MODEL = 1024
BATCH = 8
SEQ = 4096
DEPTH = 1

HEAD_DIM = 64
FOX_HEADS = 8
NSA_HEADS = 8
NSA_KV_GROUPS = 2
NSA_HPG = NSA_HEADS // NSA_KV_GROUPS
FOX_WIDTH = FOX_HEADS * HEAD_DIM
NSA_WIDTH = NSA_HEADS * HEAD_DIM
NSA_KV_WIDTH = NSA_KV_GROUPS * HEAD_DIM
CMP_BLOCK = 32
CMP_STRIDE = 16
SEL_BLOCK = 64
SEL_TOPN = 16
WINDOW = 512
FOX_Q_BLOCK = 128
NSA_Q_BLOCK = 64
REL_BUCKETS = 32
REL_MAX_DIST = 128
N_EXPERTS = 32
TOP_K = 4
D_EXPERT = D_MODEL
SWIGLU_LIMIT = 7.0
SWIGLU_ALPHA = 1.702
MOE_BLOCK = 256
RMS_EPS = 1e-6
NEG = -1e30
BIG = 1e9
IN_SIZES = (FOX_WIDTH, FOX_WIDTH, FOX_WIDTH, FOX_HEADS, NSA_WIDTH,
            NSA_KV_WIDTH, NSA_KV_WIDTH, NSA_KV_WIDTH, NSA_KV_WIDTH, NSA_KV_WIDTH, NSA_KV_WIDTH,
            3 * NSA_HEADS, D_MODEL, D_MODEL)
IN_WIDTH = sum(IN_SIZES)

kernel_name = "hybrid_fox_nsa_moe_block"


def rms_norm(x, g):
    xf = x.astype(jnp.float32)
    y = xf * lax.rsqrt(jnp.mean(xf * xf, axis=-1, keepdims=True) + RMS_EPS)
    return (y * g.astype(jnp.float32)).astype(x.dtype)


def t5_bucket(dist):
    n = jnp.maximum(dist, 0)
    max_exact = REL_BUCKETS // 2
    nf = jnp.maximum(n, 1).astype(jnp.float32)
    large = max_exact + (jnp.log(nf / max_exact) / math.log(REL_MAX_DIST / max_exact)
                         * (REL_BUCKETS - max_exact)).astype(jnp.int32)
    large = jnp.minimum(large, REL_BUCKETS - 1)
    return jnp.where(n < max_exact, n, large)


def fox_attention(q, k, v, log_f):
    B, S, H, dh = q.shape
    scale = dh ** -0.5
    cum = jnp.cumsum(log_f, axis=1).transpose(0, 2, 1)
    qh = q.transpose(0, 2, 1, 3)
    kh = k.transpose(0, 2, 1, 3)
    vh = v.transpose(0, 2, 1, 3)
    kpos = jnp.arange(S)

    def block(b):
        q0 = b * FOX_Q_BLOCK
        qb = lax.dynamic_slice_in_dim(qh, q0, FOX_Q_BLOCK, axis=2)
        cb = lax.dynamic_slice_in_dim(cum, q0, FOX_Q_BLOCK, axis=2)
        tpos = q0 + jnp.arange(FOX_Q_BLOCK)
        logits = (jnp.einsum('bhqd,bhkd->bhqk', qb, kh).astype(jnp.float32) * scale
                  + (cb[..., :, None] - cum[..., None, :]))
        logits = jnp.where(kpos[None, :] <= tpos[:, None], logits, NEG)
        p = jax.nn.softmax(logits, axis=-1)
        return jnp.einsum('bhqk,bhkd->bhqd', p.astype(vh.dtype), vh)

    out = lax.map(block, jnp.arange(S // FOX_Q_BLOCK))
    return out.transpose(1, 0, 3, 2, 4).reshape(B, S, H * dh)


def nsa_attention(q, k_cmp, v_cmp, k_slc, v_slc, k_win, v_win, gates,
                  pe_k, pe_v, w_ck, w_cv, rel_bias):
    B, S, H, dh = q.shape
    G, hpg, Tq = NSA_KV_GROUPS, NSA_HPG, NSA_Q_BLOCK
    scale = dh ** -0.5
    n_cmp = (S - CMP_BLOCK) // CMP_STRIDE + 1
    cidx = jnp.arange(n_cmp)[:, None] * CMP_STRIDE + jnp.arange(CMP_BLOCK)[None, :]

    def compress(kv, pe, w):
        blk = kv[:, cidx] + pe[None, None, :, None, :]
        blk = blk.transpose(0, 3, 1, 2, 4).reshape(B, G, n_cmp, CMP_BLOCK * dh)
        return blk @ w

    kc = compress(k_cmp, pe_k, w_ck)
    vc = compress(v_cmp, pe_v, w_cv)
    cmp_start = jnp.arange(n_cmp) * CMP_STRIDE
    cmp_end = cmp_start + CMP_BLOCK - 1
    n_sel = S // SEL_BLOCK
    top_n = min(SEL_TOPN, n_sel)
    ks = k_slc.reshape(B, n_sel, SEL_BLOCK, G, dh).transpose(0, 3, 1, 2, 4)
    vs = v_slc.reshape(B, n_sel, SEL_BLOCK, G, dh).transpose(0, 3, 1, 2, 4)
    sel_start = jnp.arange(n_sel) * SEL_BLOCK
    overlap = ((cmp_start[:, None] < sel_start[None, :] + SEL_BLOCK)
               & (cmp_start[:, None] + CMP_BLOCK > sel_start[None, :])).astype(jnp.float32)
    kw = jnp.pad(k_win, ((0, 0), (WINDOW, 0), (0, 0), (0, 0))).transpose(0, 2, 1, 3)
    vw = jnp.pad(v_win, ((0, 0), (WINDOW, 0), (0, 0), (0, 0))).transpose(0, 2, 1, 3)
    wk = WINDOW + Tq
    rel_d = (jnp.arange(Tq)[:, None] + WINDOW) - jnp.arange(wk)[None, :]
    win_band = (rel_d >= 0) & (rel_d < WINDOW)
    win_bias = rel_bias[t5_bucket(rel_d)].transpose(2, 0, 1).reshape(G, hpg, Tq, wk)
    tbl = rel_bias.reshape(REL_BUCKETS, G, hpg)
    qg = q.reshape(B, S, G, hpg, dh).transpose(0, 2, 3, 1, 4)
    gts = gates.reshape(B, S, G, hpg, 3).transpose(0, 2, 3, 1, 4)
    gather_blocks = jax.vmap(jax.vmap(lambda kv, ix: kv[ix]))
    garr = jnp.arange(G)[None, :, None, None, None]
    jblk = jnp.arange(n_sel)

    def block(b):
        q0 = b * Tq
        t = q0 + jnp.arange(Tq)
        qb = lax.dynamic_slice_in_dim(qg, q0, Tq, axis=3)
        cvalid = cmp_end[None, :] <= t[:, None]
        cbias = tbl[t5_bucket(t[:, None] - cmp_end[None, :])].transpose(2, 3, 0, 1)
        lc = jnp.einsum('bghtd,bgcd->bghtc', qb, kc).astype(jnp.float32) * scale + cbias
        pc = jax.nn.softmax(jnp.where(cvalid, lc, NEG), axis=-1) * cvalid
        o_cmp = jnp.einsum('bghtc,bgcd->bghtd', pc.astype(vc.dtype), vc)
        imp = jnp.einsum('bghtc,cj->bgtj', pc, overlap)
        cur = t // SEL_BLOCK
        forced = (jblk[None, :] == 0) | (jblk[None, :] == cur[:, None]) | (jblk[None, :] == cur[:, None] - 1)
        svalid = jblk[None, :] * SEL_BLOCK <= t[:, None]
        score = jnp.where(forced, BIG, jnp.where(svalid, imp, -BIG))
        _, sel = lax.top_k(score, top_n)
        kb = gather_blocks(ks, sel)
        vb = gather_blocks(vs, sel).reshape(B, G, Tq, top_n * SEL_BLOCK, dh)
        pos = sel[..., None] * SEL_BLOCK + jnp.arange(SEL_BLOCK)
        dist = t[None, None, :, None, None] - pos
        sbias = jnp.moveaxis(tbl[t5_bucket(dist), garr], -1, 2).reshape(B, G, hpg, Tq, top_n * SEL_BLOCK)
        ls = (jnp.einsum('bghtd,bgtnkd->bghtnk', qb, kb).reshape(B, G, hpg, Tq, top_n * SEL_BLOCK)
              .astype(jnp.float32) * scale + sbias)
        smask = (dist >= 0).reshape(B, G, Tq, top_n * SEL_BLOCK)[:, :, None]
        ps = jax.nn.softmax(jnp.where(smask, ls, NEG), axis=-1)
        o_slc = jnp.einsum('bghtm,bgtmd->bghtd', ps.astype(vb.dtype), vb)
        kwb = lax.dynamic_slice_in_dim(kw, q0, wk, axis=2)
        vwb = lax.dynamic_slice_in_dim(vw, q0, wk, axis=2)
        kpos = q0 - WINDOW + jnp.arange(wk)
        wmask = win_band & (kpos[None, :] >= 0)
        lw = jnp.einsum('bghtd,bgkd->bghtk', qb, kwb).astype(jnp.float32) * scale + win_bias
        pw = jax.nn.softmax(jnp.where(wmask, lw, NEG), axis=-1)
        o_win = jnp.einsum('bghtk,bgkd->bghtd', pw.astype(vwb.dtype), vwb)
        g = lax.dynamic_slice_in_dim(gts, q0, Tq, axis=3)
        return g[..., 0:1] * o_cmp + g[..., 1:2] * o_slc + g[..., 2:3] * o_win

    out = lax.map(block, jnp.arange(S // Tq))
    return out.transpose(1, 0, 4, 2, 3, 5).reshape(B, S, H * dh)


def moe_ffn(h, w_router, b_router, w_gate, b_gate, w_up, b_up, w_down, b_down):
    B, S, D = h.shape
    xt = h.reshape(-1, D)
    T = xt.shape[0]
    logits = (xt @ w_router).astype(jnp.float32) + b_router
    top_v, top_i = lax.top_k(logits, TOP_K)
    top_w = jax.nn.softmax(top_v, axis=-1)
    A = T * TOP_K
    flat_e = top_i.reshape(-1)
    order = jnp.argsort(flat_e)
    sorted_e = flat_e[order]
    token_of = order // TOP_K
    counts = jax.ops.segment_sum(jnp.ones_like(flat_e), flat_e, num_segments=N_EXPERTS)
    padded = ((counts + MOE_BLOCK - 1) // MOE_BLOCK) * MOE_BLOCK
    pad_end = jnp.cumsum(padded)
    pad_start = pad_end - padded
    grp_start = jnp.cumsum(counts) - counts
    dest = pad_start[sorted_e] + jnp.arange(A) - grp_start[sorted_e]
    n_blocks = -(-A // MOE_BLOCK) + N_EXPERTS
    P = n_blocks * MOE_BLOCK
    xs = jnp.zeros((P, D), h.dtype).at[dest].set(xt[token_of])
    blk_e = jnp.minimum(jnp.searchsorted(pad_end, jnp.arange(n_blocks) * MOE_BLOCK, side='right'),
                        N_EXPERTS - 1)

    def expert_block(args):
        xb, e = args
        gt = jnp.minimum(xb @ w_gate[e] + b_gate[e], SWIGLU_LIMIT)
        up = jnp.clip(xb @ w_up[e] + b_up[e], -SWIGLU_LIMIT, SWIGLU_LIMIT)
        glu = gt * jax.nn.sigmoid(SWIGLU_ALPHA * gt)
        return (glu * (up + 1.0)) @ w_down[e] + b_down[e]

    ys = lax.map(expert_block, (xs.reshape(n_blocks, MOE_BLOCK, D), blk_e)).reshape(P, D)
    w_sorted = top_w.reshape(-1)[order]
    contrib = ys[dest] * w_sorted[:, None].astype(ys.dtype)
    return jax.ops.segment_sum(contrib, token_of, num_segments=T).reshape(B, S, D)


def setup_inputs(seed: int = 0) -> dict:
    key = jax.random.key(seed)
    ks = jax.random.split(key, 32)
    f32 = jnp.float32
    L, D, E, F = DEPTH, D_MODEL, N_EXPERTS, D_EXPERT

    def nrm(k, shape, s):
        return jax.random.normal(k, shape, f32) * s

    return {
        "x": nrm(ks[0], (BATCH, SEQ, D), 1.0),
        "c": nrm(ks[1], (BATCH, D), 1.0),
        "w_ada": nrm(ks[2], (L, D, 6 * D), 0.5 * D ** -0.5),
        "b_ada": nrm(ks[3], (L, 6 * D), 0.02),
        "g_mix_pre": 1.0 + nrm(ks[4], (L, D), 0.05),
        "g_mix_post": 1.0 + nrm(ks[5], (L, D), 0.05),
        "w_in": nrm(ks[6], (L, D, IN_WIDTH), D ** -0.5),
        "b_forget": jax.random.uniform(ks[7], (L, FOX_HEADS), f32, 3.0, 6.0),
        "pe_k": nrm(ks[8], (L, CMP_BLOCK, HEAD_DIM), 0.5),
        "pe_v": nrm(ks[9], (L, CMP_BLOCK, HEAD_DIM), 0.5),
        "w_cmp_k": nrm(ks[10], (L, CMP_BLOCK * HEAD_DIM, HEAD_DIM), (CMP_BLOCK * HEAD_DIM) ** -0.5),
        "w_cmp_v": nrm(ks[11], (L, CMP_BLOCK * HEAD_DIM, HEAD_DIM), (CMP_BLOCK * HEAD_DIM) ** -0.5),
        "w_fox_proj": nrm(ks[12], (L, FOX_WIDTH, D), FOX_WIDTH ** -0.5),
        "w_nsa_proj": nrm(ks[13], (L, NSA_WIDTH, D), NSA_WIDTH ** -0.5),
        "w_mix_out": nrm(ks[14], (L, D, D), D ** -0.5),
        "rel_bias": nrm(ks[15], (REL_BUCKETS, NSA_HEADS), 0.5),
        "g_ffn_pre": 1.0 + nrm(ks[16], (L, D), 0.05),
        "g_ffn_post": 1.0 + nrm(ks[17], (L, D), 0.05),
        "w_router": nrm(ks[18], (L, D, E), D ** -0.5),
        "b_router": nrm(ks[19], (L, E), 0.01),
        "w_gate": nrm(ks[20], (L, E, D, F), D ** -0.5),
        "b_gate": nrm(ks[21], (L, E, F), 0.01),
        "w_up": nrm(ks[22], (L, E, D, F), D ** -0.5),
        "b_up": nrm(ks[23], (L, E, F), 0.01),
        "w_down": nrm(ks[24], (L, E, F, D), F ** -0.5),
        "b_down": nrm(ks[25], (L, E, D), 0.01),
    }


def reference(x, c, w_ada, b_ada, g_mix_pre, g_mix_post, w_in, b_forget, pe_k, pe_v,
              w_cmp_k, w_cmp_v, w_fox_proj, w_nsa_proj, w_mix_out, rel_bias,
              g_ffn_pre, g_ffn_post, w_router, b_router, w_gate, b_gate, w_up, b_up, w_down, b_down):
    B, S, D = x.shape
    offs = []
    acc = 0
    for s in IN_SIZES[:-1]:
        acc += s
        offs.append(acc)
    for l in range(DEPTH):
        ada = (jax.nn.silu(c) @ w_ada[l] + b_ada[l])[:, None, :]
        sh1, sc1, ga1, sh2, sc2, ga2 = jnp.split(ada, 6, axis=-1)
        h = rms_norm(x, g_mix_pre[l]) * (1.0 + sc1) + sh1
        proj = h @ w_in[l]
        (fq, fk, fv, ff, nq, kcm, vcm, ksl, vsl, kwn, vwn, ng, mg_fox, mg_nsa) = jnp.split(proj, offs, axis=-1)
        log_f = jax.nn.log_sigmoid(ff.astype(jnp.float32) + b_forget[l])
        hd = lambda t, n: t.reshape(B, S, n, HEAD_DIM)
        y_fox = fox_attention(hd(fq, FOX_HEADS), hd(fk, FOX_HEADS), hd(fv, FOX_HEADS), log_f) @ w_fox_proj[l]
        y_nsa = nsa_attention(hd(nq, NSA_HEADS), hd(kcm, NSA_KV_GROUPS), hd(vcm, NSA_KV_GROUPS),
                              hd(ksl, NSA_KV_GROUPS), hd(vsl, NSA_KV_GROUPS),
                              hd(kwn, NSA_KV_GROUPS), hd(vwn, NSA_KV_GROUPS),
                              jax.nn.sigmoid(ng).reshape(B, S, NSA_HEADS, 3),
                              pe_k[l], pe_v[l], w_cmp_k[l], w_cmp_v[l], rel_bias) @ w_nsa_proj[l]
        mixed = (jax.nn.sigmoid(mg_fox) * y_fox + jax.nn.sigmoid(mg_nsa) * y_nsa) @ w_mix_out[l]
        x = x + ga1 * rms_norm(mixed, g_mix_post[l])
        h = rms_norm(x, g_ffn_pre[l]) * (1.0 + sc2) + sh2
        y = moe_ffn(h, w_router[l], b_router[l], w_gate[l], b_gate[l], w_up[l], b_up[l], w_down[l], b_down[l])
        x = x + ga2 * rms_norm(y, g_ffn_post[l])
    return x
```

```cpp
#include <hip/hip_runtime.h>
#include <cstdio>
#include <cstdint>

#define GAS __attribute__((address_space(1)))
#define LAS __attribute__((address_space(3)))
typedef unsigned short bf16;
typedef unsigned v4u __attribute__((ext_vector_type(4)));
typedef unsigned v2u __attribute__((ext_vector_type(2)));
typedef float f32x2 __attribute__((ext_vector_type(2)));
typedef float f32x4 __attribute__((ext_vector_type(4)));
typedef float f32x16 __attribute__((ext_vector_type(16)));
typedef short bf16x8 __attribute__((ext_vector_type(8)));
typedef short s16x4 __attribute__((ext_vector_type(4)));
typedef __bf16 bf16x2_t __attribute__((ext_vector_type(2)));

constexpr int NB = 8, SEQ = 4096, DM = 1024, NTOK = NB * SEQ;
constexpr int NPROJ = 5120;
constexpr int NEXP = 32, TOPK = 4;
constexpr float LOG2E = 1.4426950408889634f;
constexpr float QSCALE = 0.125f * 1.4426950408889634f;
constexpr float RMS_EPS = 1e-6f;
constexpr float NEGBIG = -1e30f;

__device__ __forceinline__ unsigned pk2(float lo, float hi) { f32x2 v = {lo, hi}; bf16x2_t b = __builtin_convertvector(v, bf16x2_t); return __builtin_bit_cast(unsigned, b); }
__device__ __forceinline__ float bf_lo(unsigned u) { return __builtin_bit_cast(float, u << 16); }
__device__ __forceinline__ float bf_hi(unsigned u) { return __builtin_bit_cast(float, u & 0xffff0000u); }
__device__ __forceinline__ float wave_sum(float v) {
#pragma unroll
    for (int o = 1; o < 64; o <<= 1) v += __shfl_xor(v, o);
    return v;
}
__device__ __forceinline__ float sigmoidf_(float x) { return 1.f / (1.f + __expf(-x)); }
#define LDS_WAIT() asm volatile("s_waitcnt lgkmcnt(0)" ::: "memory")
#define VM_WAIT() asm volatile("s_waitcnt vmcnt(0)" ::: "memory")

namespace pg8 {
#define PG8_LAS __attribute__((address_space(3)))
typedef unsigned short bf16_t;
typedef unsigned u32x4 __attribute__((ext_vector_type(4)));
constexpr int BM = 256, BK = 64, HALF = 128, HTB = HALF * BK * 2  , STAGE_BYTES = 8 * HTB, NXCD = 8, WGM = 8;

__host__ __device__ __forceinline__ int lds_byte(int r, int c) { const int st = (r >> 4) * 2 + (c >> 5), rr = r & 15, cc = c & 31, ob = rr * 64 + cc * 2; return st * 1024 + (ob ^ (((ob >> 9) & 1) << 5)); }
__host__ __device__ __forceinline__ void stage_rc(int b, int& R, int& C) { const int st = b / 1024, sb = b % 1024, swz = sb ^ (((sb >> 9) & 1) << 5); R = (st >> 1) * 16 + swz / 64; C = (st & 1) * 32 + (swz % 64) / 2; }
__host__ __device__ __forceinline__ int perm32(int rho) { const int n = rho >> 4, i = rho & 15; return 8 * (i >> 2) + 4 * n + (i & 3); }

struct Unit { int pm, pn, e, rt; };
struct Gemm { const bf16_t* A; const bf16_t* Bt; int K; };

struct StaticOrder {
    int nM, nN, nwg, G, c, lda2;
    __device__ void init(int M, int N, int G_, int c_, int lda_elems) { nM = M / BM; nN = N / BM; nwg = nM * nN; G = G_; c = c_; lda2 = lda_elems * 2; }
    __device__ bool next(int i, Unit& u) const {
        const long L = (long)i * G + c; if (L >= nwg) return false;
        int wgid = (int)L; { const int q = nwg / NXCD, r = nwg % NXCD, xcd = wgid % NXCD, off = wgid / NXCD; wgid = (xcd < r ? xcd * (q + 1) : r * (q + 1) + (xcd - r) * q) + off; }
        const int nig = WGM * nN, gid = wgid / nig, fm = gid * WGM, gsz = (nM - fm) < WGM ? (nM - fm) : WGM;
        u.pm = fm + ((wgid % nig) % gsz); u.pn = (wgid % nig) / gsz; u.e = 0; u.rt = 0; return true;
    }
    __device__ __forceinline__ unsigned a_off(const Unit& u, int r) const { return (unsigned)(u.pm * BM + r) * (unsigned)lda2; }
};

template <class Epi, class Sched, bool ALIGN_EPI = true>
__device__ __forceinline__ void gemm_phase(PG8_LAS unsigned char* lds, const Gemm g, const Sched& S, const Epi& E) {
    const int tid = threadIdx.x, wid = __builtin_amdgcn_readfirstlane(tid >> 6), lane = tid & 63, wr = wid >> 2, wc = wid & 3, fr = lane & 15, fq = lane >> 4;
    const int K = g.K, nt = K / BK;
    int RA[2], CA2[2]; unsigned voffB[2];
#pragma unroll
    for (int i = 0; i < 2; ++i) { int R, C; stage_rc(tid * 16 + i * 8192, R, C); const int Rb = (R & ~31) + perm32(R & 31);
        RA[i] = R; CA2[i] = C * 2; voffB[i] = (unsigned)(Rb * K + C) * 2u; }
    const size_t kstep = (size_t)(BK * 2);
    const size_t hstep = (size_t)HALF * K * 2;
    const size_t tstep = 2 * hstep;
    const unsigned ldsw = (unsigned)wid * 1024u;
    const int aoff = lds_byte(wr * 64 + fr, fq * 8), boff = lds_byte(wc * 32 + fr, fq * 8);
#define PG8_SA(b, h) (((b) * 2 + (h)) * HTB)
#define PG8_SB(b, h) ((4 + (b) * 2 + (h)) * HTB)
#define PG8_STAGE(bufoff, gbase, voff) do { _Pragma("unroll") for (int _i = 0; _i < 2; ++_i) \
        __builtin_amdgcn_global_load_lds((const unsigned*)((const char*)(gbase) + (voff)[_i]), (PG8_LAS unsigned*)(lds + (bufoff) + ldsw + _i * 8192), 16, 0, 0); } while (0)
#define PG8_LDA(dst, b, h) do { _Pragma("unroll") for (int m = 0; m < 4; ++m) _Pragma("unroll") for (int k = 0; k < 2; ++k) dst[m][k] = *(const PG8_LAS bf16x8*)(lds + PG8_SA(b, h) + aoff + m * 2048 + k * 1024); } while (0)
#define PG8_LDB(dst, b, h) do { _Pragma("unroll") for (int n = 0; n < 2; ++n) _Pragma("unroll") for (int k = 0; k < 2; ++k) dst[n][k] = *(const PG8_LAS bf16x8*)(lds + PG8_SB(b, h) + boff + n * 2048 + k * 1024); } while (0)
#define PG8_MMA(ai, bj, At, Bt) do { __builtin_amdgcn_s_setprio(1); _Pragma("unroll") for (int m = 0; m < 4; ++m) _Pragma("unroll") for (int n = 0; n < 2; ++n) _Pragma("unroll") for (int k = 0; k < 2; ++k) \
        acc[ai][bj][m][n] = __builtin_amdgcn_mfma_f32_16x16x32_bf16(Bt[n][k], At[m][k], acc[ai][bj][m][n], 0, 0, 0); __builtin_amdgcn_s_setprio(0); } while (0)
#define PG8_WAIT_V(n) asm volatile("s_waitcnt vmcnt(" #n ")" ::: "memory")
#define PG8_WAIT_L(n) asm volatile("s_waitcnt lgkmcnt(" #n ")" ::: "memory")
#define PG8_BAR __builtin_amdgcn_s_barrier()
#define PG8_SCHED __builtin_amdgcn_sched_barrier(0)
    Unit cur, nxt; int ui = 0;
    if (!S.next(0, cur)) return;
    f32x4 acc[2][2][4][2];
#pragma unroll
    for (int a = 0; a < 2; ++a)
#pragma unroll
        for (int b = 0; b < 2; ++b)
#pragma unroll
            for (int m = 0; m < 4; ++m)
#pragma unroll
                for (int n = 0; n < 2; ++n) acc[a][b][m][n] = (f32x4){0.f, 0.f, 0.f, 0.f};
    bf16x8 At[4][2], B0[2][2], B1[2][2];
    const char* gA = (const char*)g.A;
    unsigned oc0[2], oc1[2], on0[2], on1[2];
#pragma unroll
    for (int i = 0; i < 2; ++i) { oc0[i] = S.a_off(cur, RA[i]) + CA2[i]; oc1[i] = S.a_off(cur, HALF + RA[i]) + CA2[i]; }
    const char* cB = (const char*)g.Bt + (size_t)cur.pn * tstep;
    PG8_STAGE(PG8_SB(0, 0), cB, voffB); PG8_STAGE(PG8_SB(0, 1), cB + hstep, voffB); PG8_STAGE(PG8_SA(0, 0), gA, oc0); PG8_STAGE(PG8_SA(0, 1), gA, oc1);
    if (wr == 1) PG8_BAR;
    PG8_WAIT_V(2); PG8_BAR;
    PG8_STAGE(PG8_SB(1, 0), cB + kstep, voffB); PG8_STAGE(PG8_SA(1, 0), gA + kstep, oc0); PG8_STAGE(PG8_SB(1, 1), cB + hstep + kstep, voffB);
    PG8_WAIT_V(6); PG8_BAR;
    for (;;) {
        const bool has_next = S.next(ui + 1, nxt);
        if (has_next) {
#pragma unroll
            for (int i = 0; i < 2; ++i) { on0[i] = S.a_off(nxt, RA[i]) + CA2[i]; on1[i] = S.a_off(nxt, HALF + RA[i]) + CA2[i]; }
        } else {
#pragma unroll
            for (int i = 0; i < 2; ++i) { on0[i] = oc0[i]; on1[i] = oc1[i]; }
        }
        const char* nB = has_next ? (const char*)g.Bt + (size_t)nxt.pn * tstep : cB;
        for (int t = 0; t < nt; t += 2) {
            const bool last = (t == nt - 2);
            const char* a1 = gA + (size_t)(t + 1) * kstep;
            const char* a2 = last ? gA : gA + (size_t)(t + 2) * kstep; const char* b2 = last ? nB : cB + (size_t)(t + 2) * kstep;
            const char* a3 = a2 + kstep; const char* b3 = b2 + kstep;
            unsigned s0[2], s1[2];
#pragma unroll
            for (int i = 0; i < 2; ++i) { s0[i] = last ? on0[i] : oc0[i]; s1[i] = last ? on1[i] : oc1[i]; }
            PG8_LDB(B0, 0, 0); PG8_LDB(B1, 0, 1); PG8_SCHED; PG8_LDA(At, 0, 0); PG8_STAGE(PG8_SA(1, 1), a1, oc1);
            PG8_WAIT_V(8); PG8_WAIT_L(0); PG8_BAR; PG8_MMA(0, 0, At, B0); PG8_MMA(0, 1, At, B1); PG8_BAR; PG8_SCHED;
            PG8_LDA(At, 0, 1); PG8_STAGE(PG8_SB(0, 0), b2, voffB); PG8_STAGE(PG8_SB(0, 1), b2 + hstep, voffB); PG8_STAGE(PG8_SA(0, 0), a2, s0);
            PG8_WAIT_V(8); PG8_WAIT_L(0); PG8_BAR; PG8_MMA(1, 0, At, B0); PG8_MMA(1, 1, At, B1); PG8_BAR; PG8_SCHED;
            PG8_LDB(B0, 1, 0); PG8_LDB(B1, 1, 1); PG8_SCHED; PG8_LDA(At, 1, 0); PG8_STAGE(PG8_SA(0, 1), a2, s1);
            PG8_WAIT_V(8); PG8_WAIT_L(0); PG8_BAR; PG8_MMA(0, 0, At, B0); PG8_MMA(0, 1, At, B1); PG8_BAR; PG8_SCHED;
            PG8_LDA(At, 1, 1); PG8_STAGE(PG8_SB(1, 0), b3, voffB); PG8_STAGE(PG8_SB(1, 1), b3 + hstep, voffB); PG8_STAGE(PG8_SA(1, 0), a3, s0);
            PG8_WAIT_V(8); PG8_WAIT_L(0); PG8_BAR; PG8_MMA(1, 0, At, B0); PG8_MMA(1, 1, At, B1); PG8_BAR; PG8_SCHED;
        }
        if constexpr (ALIGN_EPI) { if (wr == 0) PG8_BAR; }
        E(acc, cur, wr, wc, fr, fq);
        if (!has_next) break;
#pragma unroll
        for (int a = 0; a < 2; ++a)
#pragma unroll
            for (int b = 0; b < 2; ++b)
#pragma unroll
                for (int m = 0; m < 4; ++m)
#pragma unroll
                    for (int n = 0; n < 2; ++n) acc[a][b][m][n] = (f32x4){0.f, 0.f, 0.f, 0.f};
        cur = nxt; cB = nB; ++ui;
#pragma unroll
        for (int i = 0; i < 2; ++i) { oc0[i] = on0[i]; oc1[i] = on1[i]; }
        if constexpr (ALIGN_EPI) { if (wr == 1) PG8_BAR; }
    }
    PG8_WAIT_V(0);
    if constexpr (!ALIGN_EPI) { if (wr == 0) PG8_BAR; }
    PG8_BAR;
#undef PG8_SA
#undef PG8_SB
#undef PG8_STAGE
#undef PG8_LDA
#undef PG8_LDB
#undef PG8_MMA
#undef PG8_WAIT_V
#undef PG8_WAIT_L
#undef PG8_BAR
#undef PG8_SCHED
}
}

#define XB_TMO      128
#define XB_XCNT(j)  (256  + 64 * (j))
#define XB_XSUB(j)  (1280 + 64 * (j))
#define XB_XGEN(j)  (2304 + 64 * (j))
#define XB_TOP      3328
#define XB_TOPGEN   3392
#define XCD_BAR_WORDS 3456
#define XB_SPIN_CAP (1u << 18)

__device__ __forceinline__ unsigned xb_ld(unsigned* p)              { return __hip_atomic_load(p, __ATOMIC_RELAXED, __HIP_MEMORY_SCOPE_AGENT); }
__device__ __forceinline__ unsigned xb_add(unsigned* p, unsigned v) { return __hip_atomic_fetch_add(p, v, __ATOMIC_RELAXED, __HIP_MEMORY_SCOPE_AGENT); }
__device__ __forceinline__ unsigned xb_xcc_id() { return (unsigned)__builtin_amdgcn_s_getreg((3 << 11) | 20) & 0xFu; }
#define XB_SPIN(cond, bar) do { unsigned _sp = 0; while (cond) { __builtin_amdgcn_s_sleep(1); \
    if ((++_sp & 255u) == 0u) { if (xb_ld(&(bar)[XB_TMO])) break; if (_sp > XB_SPIN_CAP) { atomicAdd(&(bar)[XB_TMO], 1u); break; } } } } while (0)

struct XcdBarrier {
    unsigned* bar; unsigned x;
    volatile LAS unsigned* st;
};

__device__ __forceinline__ XcdBarrier xcd_barrier_post(unsigned* bar, volatile LAS unsigned* st) {
    XcdBarrier b; b.bar = bar; b.x = xb_xcc_id(); b.st = st;
    if (threadIdx.x == 0) (void)xb_add(&bar[XB_XCNT(b.x)], 1u);
    return b;
}
__device__ __forceinline__ void xcd_barrier_complete(unsigned* bar, unsigned x, unsigned& nloc, unsigned& nx) {
    const unsigned G = gridDim.x * gridDim.y * gridDim.z;
    unsigned sum, cnt, mine, sp = 0u;
    for (;;) {
        sum = 0u; cnt = 0u; mine = 0u;
#pragma unroll
        for (unsigned j = 0; j < 16; ++j) { const unsigned c = xb_ld(&bar[XB_XCNT(j)]); sum += c; cnt += (c > 0u) ? 1u : 0u; mine = (j == x) ? c : mine; }
        if (sum == G) break;
        __builtin_amdgcn_s_sleep(1);
        if ((++sp & 255u) == 0u) { if (xb_ld(&bar[XB_TMO])) break; if (sp > XB_SPIN_CAP) { atomicAdd(&bar[XB_TMO], 1u); break; } }
    }
    nloc = mine > 0u ? mine : 1u; nx = cnt > 0u ? cnt : 1u;
}

__device__ __forceinline__ void xcd_barrier(const XcdBarrier& b) {
    asm volatile("s_waitcnt vmcnt(0)" ::: "memory");
    __syncthreads();
    if (threadIdx.x == 0) {
        unsigned* bar = b.bar;
        __builtin_amdgcn_s_waitcnt(0);
        unsigned nloc = b.st[0], nx = b.st[1];
        if (nloc == 0u) { xcd_barrier_complete(bar, b.x, nloc, nx); b.st[0] = nloc; b.st[1] = nx; }
        const unsigned old = xb_add(&bar[XB_XSUB(b.x)], 1u);
        const unsigned gen = old / nloc;
        if (old + 1u == (gen + 1u) * nloc) {
            __builtin_amdgcn_fence(__ATOMIC_RELEASE, "agent");
            asm volatile("s_waitcnt vmcnt(0)" ::: "memory");
            const unsigned og = xb_add(&bar[XB_TOP], 1u);
            const unsigned tg = og / nx;
            if (og + 1u == (tg + 1u) * nx) xb_add(&bar[XB_TOPGEN], 1u);
            else XB_SPIN(xb_ld(&bar[XB_TOPGEN]) == tg, bar);
            __builtin_amdgcn_fence(__ATOMIC_ACQUIRE, "agent");
            xb_add(&bar[XB_XGEN(b.x)], 1u);
            asm volatile("s_waitcnt vmcnt(0)" ::: "memory");
        } else {
            XB_SPIN(xb_ld(&bar[XB_XGEN(b.x)]) == gen, bar);
            __builtin_amdgcn_fence(__ATOMIC_ACQUIRE, "agent");
            asm volatile("s_waitcnt vmcnt(0)" ::: "memory");
        }
    }
    __syncthreads();
}

constexpr size_t MiB = 1u << 20;
constexpr size_t WS_CTL = 0, CTL_ZERO_BYTES = 1 * MiB;
constexpr size_t WS_ADAP = 1 * MiB;
constexpr size_t WS_ADA = 4 * MiB;
constexpr size_t WS_CB = 4 * MiB + 512 * 1024;
constexpr size_t WS_LOGF = 5 * MiB;
constexpr size_t WS_GATES = 6 * MiB;
constexpr size_t WS_KBIAS = 9 * MiB;
constexpr size_t WS_KC = 10 * MiB, WS_VC = 10 * MiB + 512 * 1024;
constexpr size_t WS_WRT = 11 * MiB;
constexpr size_t WS_WCK = 11 * MiB + 256 * 1024, WS_WCV = 11 * MiB + 512 * 1024;
constexpr size_t WS_TOPE = 12 * MiB, WS_TOPW = 12 * MiB + 512 * 1024, WS_RANK = 13 * MiB;
constexpr size_t WS_TOKOF = 14 * MiB;
constexpr size_t WS_WFOX = 18 * MiB, WS_WNSA = 19 * MiB, WS_WMIX = 20 * MiB, WS_WIN = 22 * MiB;
constexpr size_t WS_WD = 32 * MiB;
constexpr size_t WS_WGU = 96 * MiB;
constexpr size_t WS_YSHI = 96 * MiB;
constexpr size_t WS_FQ = 224 * MiB, WS_FK = 256 * MiB, WS_FV = 288 * MiB, WS_NQ = 320 * MiB;
constexpr size_t WS_KV6 = 352 * MiB;
constexpr size_t WS_SGF = 400 * MiB, WS_SGN = 464 * MiB;
constexpr size_t WS_MIXED = 224 * MiB;
constexpr size_t WS_GATED = 288 * MiB;
constexpr size_t WS_ACT = 288 * MiB;
constexpr size_t WS_END = 544 * MiB;
constexpr size_t OUT_H = 0, OUT_OFOX = 64 * MiB, OUT_ONSA = 96 * MiB, OUT_H2 = 0;
constexpr size_t KV6_STRIDE = (size_t)NTOK * 128;

constexpr int CW_TMO = 0;
constexpr int CW_BAR = 4096;
constexpr int CW_ECNT = 32768;

constexpr int RING_BYTES = 131072;
constexpr int MISC_OFF = 131072;
constexpr int TAB_OFF = 131072 + 256;
constexpr int LDS_BYTES = 147456;

__device__ const unsigned char T5_BUCKET[128] = {
 0,1,2,3,4,5,6,7,8,9,10,11,12,13,14,15,16,16,16,17,17,18,18,18,19,19,19,20,20,20,20,21,21,21,21,22,22,22,22,22,23,23,23,23,23,23,24,24,24,24,24,24,25,25,25,25,25,25,25,26,26,26,26,26,26,26,26,
 27,27,27,27,27,27,27,27,27,27,28,28,28,28,28,28,28,28,28,28,29,29,29,29,29,29,29,29,29,29,29,29,30,30,30,30,30,30,30,30,30,30,30,30,30,30,31,31,31,31,31,31,31,31,31,31,31,31,31,31,31};

struct Args { const float* in[26]; float* out; unsigned char* ws; int ph_lo, ph_hi; };
struct Ctx {
    float* out; unsigned char* ws;
    LAS unsigned char* lds; int tid, lane, wave, vcu, G;
};

__device__ __forceinline__ void conv64(const float* __restrict__ W, size_t ldw, int col, int k0, bf16* __restrict__ dst) {
#pragma unroll
    for (int h = 0; h < 2; ++h) {
        float v[32];
#pragma unroll
        for (int kk = 0; kk < 32; ++kk) v[kk] = W[(size_t)(k0 + h * 32 + kk) * ldw + col];
#pragma unroll
        for (int q = 0; q < 4; ++q) { v4u o; o.x = pk2(v[8 * q], v[8 * q + 1]); o.y = pk2(v[8 * q + 2], v[8 * q + 3]); o.z = pk2(v[8 * q + 4], v[8 * q + 5]); o.w = pk2(v[8 * q + 6], v[8 * q + 7]);
            *(v4u*)(dst + h * 32 + q * 8) = o; }
    }
}
__device__ __forceinline__ void conv_item(const float* W, size_t ldw, int col0, int ncb, bf16* WT, int Kd, int dst_row0, int r, int lane) {
    const int cbk = r % ncb, kb = r / ncb;
    conv64(W, ldw, col0 + cbk * 64 + lane, kb * 64, WT + (size_t)(dst_row0 + cbk * 64 + lane) * Kd + kb * 64);
}

__device__ __forceinline__ void phase0a(const Args& A, const Ctx& X) {
    const float* c = A.in[1]; const float* w_ada = A.in[2]; const float* w_in = A.in[6];
    LAS float* sl = (LAS float*)X.lds;
    for (int i = X.tid; i < 8192; i += 512) { const float v = c[i]; sl[i] = v / (1.f + __expf(-v)); }
    __syncthreads();
    const int gw = X.vcu * 8 + X.wave, NGW = X.G * 8, lane = X.lane;
    unsigned char* ws = X.ws;
    bf16* WIN = (bf16*)(ws + WS_WIN);
    constexpr int J_ADA = 96 * 16, J_INA = 24 * 16, J_INB = 20 * 16, J_INC = 32 * 16, J_IND = 256, J_FOX = 16 * 8, J_NSA = 16 * 8, J_MIX = 16 * 16, J_CK = 32, J_CV = 32, J_RT = 32, J_CB = 128;
    constexpr int J_EXP = 32 * 256;
    constexpr int NITEMS = J_ADA + J_INA + J_INB + J_INC + J_IND + J_FOX + J_NSA + J_MIX + J_CK + J_CV + J_RT + J_CB + 3 * J_EXP;
    for (int it = gw; it < NITEMS; it += NGW) {
        int r = it;
        if (r < J_ADA) {
            const int cb = r % 96, ks = r / 96, j = cb * 64 + lane; float acc[8];
#pragma unroll
            for (int b = 0; b < 8; ++b) acc[b] = 0.f;
#pragma unroll 8
            for (int kk = 0; kk < 64; ++kk) { const int k = ks * 64 + kk; const float w = w_ada[(size_t)k * 6144 + j];
#pragma unroll
                for (int b = 0; b < 8; ++b) acc[b] += sl[b * 1024 + k] * w; }
            float* P = (float*)(ws + WS_ADAP);
#pragma unroll
            for (int b = 0; b < 8; ++b) P[(size_t)(ks * 8 + b) * 6144 + j] = acc[b];
            continue; }
        r -= J_ADA;
        if (r < J_INA) { conv_item(w_in, 4896, 0, 24, WIN, 1024, 0, r, lane); continue; } r -= J_INA;
        if (r < J_INB) { conv_item(w_in, 4896, 1544, 20, WIN, 1024, 1536, r, lane); continue; } r -= J_INB;
        if (r < J_INC) { conv_item(w_in, 4896, 2848, 32, WIN, 1024, 2816, r, lane); continue; } r -= J_INC;
        if (r < J_IND) {
            const int row = 4864 + r; const int col = (row < 4872) ? 1536 + (row - 4864) : (row < 4896 ? 2824 + (row - 4872) : -1);
            float v[16];
#pragma unroll
            for (int i = 0; i < 16; ++i) v[i] = (col >= 0) ? w_in[(size_t)(lane * 16 + i) * 4896 + col] : 0.f;
            v4u o0, o1; o0.x = pk2(v[0], v[1]); o0.y = pk2(v[2], v[3]); o0.z = pk2(v[4], v[5]); o0.w = pk2(v[6], v[7]); o1.x = pk2(v[8], v[9]); o1.y = pk2(v[10], v[11]); o1.z = pk2(v[12], v[13]); o1.w = pk2(v[14], v[15]);
            *(v4u*)(WIN + (size_t)row * 1024 + lane * 16) = o0; *(v4u*)(WIN + (size_t)row * 1024 + lane * 16 + 8) = o1;
            continue; }
        r -= J_IND;
        if (r < J_FOX) { conv_item(A.in[12], 1024, 0, 16, (bf16*)(ws + WS_WFOX), 512, 0, r, lane); continue; } r -= J_FOX;
        if (r < J_NSA) { conv_item(A.in[13], 1024, 0, 16, (bf16*)(ws + WS_WNSA), 512, 0, r, lane); continue; } r -= J_NSA;
        if (r < J_MIX) { conv_item(A.in[14], 1024, 0, 16, (bf16*)(ws + WS_WMIX), 1024, 0, r, lane); continue; } r -= J_MIX;
        if (r < J_CK) { conv_item(A.in[10], 64, 0, 1, (bf16*)(ws + WS_WCK), 2048, 0, r, lane); continue; } r -= J_CK;
        if (r < J_CV) { conv_item(A.in[11], 64, 0, 1, (bf16*)(ws + WS_WCV), 2048, 0, r, lane); continue; } r -= J_CV;
        if (r < J_RT) { const float* wr_ = A.in[18]; float* WRT = (float*)(ws + WS_WRT);
#pragma unroll
            for (int i = 0; i < 16; ++i) { const int k = lane + 64 * i; WRT[r * 1024 + k] = wr_[k * 32 + r]; }
            continue; }
        r -= J_RT;
        if (r < J_CB) { const int which = r >> 6, j = r & 63; const float* pe = A.in[8 + which]; const float* wc = A.in[10 + which]; float s = 0.f;
#pragma unroll 8
            for (int i = 0; i < 32; ++i) { const int q = lane * 32 + i; s += pe[q] * wc[q * 64 + j]; }
            s = wave_sum(s); if (lane == 0) ((float*)(ws + WS_CB))[which * 64 + j] = s;
            continue; }
        r -= J_CB;
        if (r < 2 * J_EXP) {
            const int kind = r / J_EXP, q = r % J_EXP, e = q >> 8, rr = q & 255, cbk = rr & 15, kb = rr >> 4;
            const float* W = A.in[kind ? 22 : 20] + (size_t)e * 1048576;
            const int drow = e * 2048 + (cbk >> 1) * 256 + (cbk & 1) * 64 + kind * 128 + lane;
            conv64(W, 1024, cbk * 64 + lane, kb * 64, (bf16*)(ws + WS_WGU) + (size_t)drow * 1024 + kb * 64);
            continue; }
        r -= 2 * J_EXP;
        { const int e = r >> 8, rr = r & 255, cbk = rr & 15, kb = rr >> 4;
          conv64(A.in[24] + (size_t)e * 1048576, 1024, cbk * 64 + lane, kb * 64, (bf16*)(ws + WS_WD) + (size_t)(e * 1024 + cbk * 64 + lane) * 1024 + kb * 64); }
    }
}

__device__ __forceinline__ void phase0b(const Args& A, const Ctx& X) {
    const float* P = (const float*)(X.ws + WS_ADAP); const float* b_ada = A.in[3];
    float* ADA = (float*)(X.ws + WS_ADA);
    for (int gid = blockIdx.x * 512 + X.tid; gid < 8 * 6144; gid += X.G * 512) {
        const int b = gid / 6144, col = gid % 6144; float s = b_ada[col];
#pragma unroll
        for (int ks = 0; ks < 16; ++ks) s += P[(size_t)(ks * 8 + b) * 6144 + col];
        ADA[gid] = s;
    }
    LAS float* gs = (LAS float*)X.lds;
    LAS float* sh = gs + 1024;
    const float* x = A.in[0]; const float* g = A.in[4];
    bf16* H = (bf16*)((unsigned char*)X.out + OUT_H);
    for (int ch = blockIdx.x; ch < NTOK / 128; ch += X.G) {
        const int row0 = ch * 128, b = row0 / SEQ;
        __syncthreads();
        for (int j = X.tid; j < 2048; j += 512) { float s = b_ada[j];
#pragma unroll
            for (int ks = 0; ks < 16; ++ks) s += P[(size_t)(ks * 8 + b) * 6144 + j];
            if (j < 1024) sh[j] = s; else gs[j - 1024] = g[j - 1024] * (1.f + s); }
        __syncthreads();
        for (int i = 0; i < 16; ++i) {
            const int row = row0 + X.wave + 8 * i;
            const f32x4* xr = (const f32x4*)(x + (size_t)row * DM) + X.lane;
            f32x4 v[4]; float ss = 0.f;
#pragma unroll
            for (int j = 0; j < 4; ++j) { v[j] = xr[64 * j]; ss += (v[j].x * v[j].x + v[j].y * v[j].y) + (v[j].z * v[j].z + v[j].w * v[j].w); }
            const float rstd = 1.f / sqrtf(wave_sum(ss) * (1.f / DM) + RMS_EPS);
            v2u* o8 = (v2u*)(H + (size_t)row * DM) + X.lane;
#pragma unroll
            for (int j = 0; j < 4; ++j) { const int k = 4 * X.lane + 256 * j; const f32x4 gg = *(LAS f32x4*)(gs + k), ss4 = *(LAS f32x4*)(sh + k);
                v2u o; o.x = pk2(v[j].x * rstd * gg.x + ss4.x, v[j].y * rstd * gg.y + ss4.y); o.y = pk2(v[j].z * rstd * gg.z + ss4.z, v[j].w * rstd * gg.w + ss4.w); o8[64 * j] = o; }
        }
    }
}

__device__ __forceinline__ void phase2(const Args& A, const Ctx& X) {
    const int lane = X.lane, wid = X.wave, r32 = lane & 31, hi = lane >> 5;
    LAS float* red = (LAS float*)X.lds;
    for (int it = blockIdx.x; it < 256; it += X.G) {
        const int cblk = it & 7, which = (it >> 3) & 1, bg = it >> 4;
        const bf16* src = (const bf16*)(X.ws + WS_KV6) + (size_t)which * KV6_STRIDE + (size_t)bg * SEQ * 64;
        const bf16* WT = (const bf16*)(X.ws + (which ? WS_WCV : WS_WCK));
        const int c0 = cblk * 32, kbase = wid * 256;
        f32x16 acc0 = {}, acc1 = {};
        const bf16* ap = src + (size_t)(16 * (c0 + r32)) * 64 + kbase + hi * 8;
        const bf16* bp0 = WT + (size_t)r32 * 2048 + kbase + hi * 8;
        const bf16* bp1 = WT + (size_t)(32 + r32) * 2048 + kbase + hi * 8;
#pragma unroll
        for (int kk = 0; kk < 16; ++kk) {
            const bf16x8 a = *(const bf16x8*)(ap + kk * 16), b0 = *(const bf16x8*)(bp0 + kk * 16), b1 = *(const bf16x8*)(bp1 + kk * 16);
            acc0 = __builtin_amdgcn_mfma_f32_32x32x16_bf16(a, b0, acc0, 0, 0, 0);
            acc1 = __builtin_amdgcn_mfma_f32_32x32x16_bf16(a, b1, acc1, 0, 0, 0);
        }
        __syncthreads();
#pragma unroll
        for (int r = 0; r < 16; ++r) { const int row = (r & 3) + 8 * (r >> 2) + 4 * hi; red[(wid * 32 + row) * 64 + r32] = acc0[r]; red[(wid * 32 + row) * 64 + 32 + r32] = acc1[r]; }
        __syncthreads();
        { const int c = X.tid >> 4, n4 = (X.tid & 15) * 4; f32x4 s = *(const f32x4*)((const float*)(X.ws + WS_CB) + which * 64 + n4);
#pragma unroll
          for (int w = 0; w < 8; ++w) s += *(LAS f32x4*)(red + (w * 32 + c) * 64 + n4);
          if (c0 + c == 255) s = (f32x4){0.f, 0.f, 0.f, 0.f};
          v2u o; o.x = pk2(s.x, s.y); o.y = pk2(s.z, s.w);
          *(v2u*)((bf16*)(X.ws + (which ? WS_VC : WS_KC)) + ((size_t)bg * 256 + c0 + c) * 64 + n4) = o; }
    }
    for (int sq = blockIdx.x * 8 + wid; sq < 64; sq += X.G * 8) {
        const int b = sq >> 3, h = sq & 7; const float* lf = (const float*)(X.ws + WS_LOGF) + (size_t)b * SEQ * 8 + h;
        float run = 0.f;
        for (int i = 0; i < 64; ++i) run += lf[(size_t)(lane * 64 + i) * 8];
        float incl = run;
#pragma unroll
        for (int o = 1; o < 64; o <<= 1) { const float t = __shfl_up(incl, o); if (lane >= o) incl += t; }
        float pre = incl - run; float* kb = (float*)(X.ws + WS_KBIAS) + (size_t)sq * SEQ + lane * 64;
        for (int i = 0; i < 64; ++i) { pre += lf[(size_t)(lane * 64 + i) * 8]; kb[i] = -pre * LOG2E; }
    }
}

__device__ __forceinline__ v4u pack8(const f32x4 a, const f32x4 b) { v4u w; w.x = pk2(a[0], a[1]); w.y = pk2(a[2], a[3]); w.z = pk2(b[0], b[1]); w.w = pk2(b[2], b[3]); return w; }

struct EpiInProj {
    unsigned char* ws; const float* b_forget;
    __device__ __forceinline__ void operator()(const f32x4 (&acc)[2][2][4][2], const pg8::Unit& u, int wr, int wc, int fr, int fq) const {
        part<0>(acc, u, wr, wc, fr, fq); part<1>(acc, u, wr, wc, fr, fq);
    }
    template <int bj> __device__ __forceinline__ void part(const f32x4 (&acc)[2][2][4][2], const pg8::Unit& u, int wr, int wc, int fr, int fq) const {
        const int row0 = u.pm * 256 + wr * 64 + fr, b = (u.pm * 256) >> 12;
        {
            const int cb = u.pn * 256 + bj * 128 + wc * 32;
            if (cb >= 4896) return;
            if (cb < 4864) {
                bf16* base; int pitch; float scl = 1.f; bool sig = false;
                if (cb < 2048) { const int tt = cb >> 9, head = (cb & 511) >> 6; if (tt == 0 || tt == 3) scl = QSCALE; pitch = 64;
                    base = (bf16*)(ws + WS_FQ) + (size_t)tt * ((size_t)NTOK * 512) + ((size_t)(b * 7 + head) * SEQ) * 64 + (cb & 63) + 8 * fq; }
                else if (cb < 2816) { const int q = cb - 2048, idx6 = q >> 7, grp = (q & 127) >> 6; pitch = 64;
                    base = (bf16*)(ws + WS_KV6) + (size_t)idx6 * KV6_STRIDE + ((size_t)(b + grp) * SEQ) * 64 + (cb & 63) + 8 * fq; }
                else { const int q = cb - 2816, which = q >> 10; pitch = 1024; sig = true; base = (bf16*)(ws + (which ? WS_SGN : WS_SGF)) + (q & 1023) + 8 * fq; }
#pragma unroll
                for (int ai = 0; ai < 2; ++ai)
#pragma unroll
                    for (int m = 0; m < 4; ++m) {
                        const int row = row0 + ai * 128 + m * 16;
                        f32x4 v0 = acc[ai][bj][m][0], v1 = acc[ai][bj][m][1];
                        if (sig) {
#pragma unroll
                            for (int i = 0; i < 4; ++i) { v0[i] = sigmoidf_(v0[i]); v1[i] = sigmoidf_(v1[i]); }
                        } else { v0 = v0 * scl; v1 = v1 * scl; }
                        *(v4u*)(base + (size_t)row * pitch) = pack8(v0, v1);
                    }
            } else {
#pragma unroll
                for (int ai = 0; ai < 2; ++ai)
#pragma unroll
                    for (int m = 0; m < 4; ++m) {
                        const int row = row0 + ai * 128 + m * 16;
                        const f32x4 v0 = acc[ai][bj][m][0], v1 = acc[ai][bj][m][1]; f32x4 o0, o1;
                        if (fq == 0) {
#pragma unroll
                            for (int i = 0; i < 4; ++i) { const float z0 = v0[i] + b_forget[i], z1 = v1[i] + b_forget[4 + i];
                                o0[i] = fminf(z0, 0.f) - log1pf(__expf(-fabsf(z0))); o1[i] = fminf(z1, 0.f) - log1pf(__expf(-fabsf(z1))); }
                        } else {
#pragma unroll
                            for (int i = 0; i < 4; ++i) { o0[i] = sigmoidf_(v0[i]); o1[i] = sigmoidf_(v1[i]); }
                        }
                        float* dst = (fq == 0) ? (float*)(ws + WS_LOGF) + (size_t)row * 8 : (float*)(ws + WS_GATES) + (size_t)row * 24 + 8 * (fq - 1);
                        *(f32x4*)dst = o0; *(f32x4*)(dst + 4) = o1;
                    }
            }
        }
    }
};

template <bool ADD> struct EpiGate {
    bf16* O; const bf16* SG;
    __device__ __forceinline__ void operator()(const f32x4 (&acc)[2][2][4][2], const pg8::Unit& u, int wr, int wc, int fr, int fq) const {
#pragma unroll
        for (int ai = 0; ai < 2; ++ai)
#pragma unroll
            for (int m = 0; m < 4; ++m)
#pragma unroll
                for (int bj = 0; bj < 2; ++bj) {
                    const size_t off = (size_t)(u.pm * 256 + ai * 128 + wr * 64 + m * 16 + fr) * 1024 + u.pn * 256 + bj * 128 + wc * 32 + 8 * fq;
                    const v4u g = *(const v4u*)(SG + off);
                    f32x4 v0 = acc[ai][bj][m][0], v1 = acc[ai][bj][m][1];
                    v0[0] *= bf_lo(g.x); v0[1] *= bf_hi(g.x); v0[2] *= bf_lo(g.y); v0[3] *= bf_hi(g.y); v1[0] *= bf_lo(g.z); v1[1] *= bf_hi(g.z); v1[2] *= bf_lo(g.w); v1[3] *= bf_hi(g.w);
                    if (ADD) { const v4u p = *(const v4u*)(O + off);
                        v0[0] += bf_lo(p.x); v0[1] += bf_hi(p.x); v0[2] += bf_lo(p.y); v0[3] += bf_hi(p.y); v1[0] += bf_lo(p.z); v1[1] += bf_hi(p.z); v1[2] += bf_lo(p.w); v1[3] += bf_hi(p.w); }
                    *(v4u*)(O + off) = pack8(v0, v1);
                }
    }
};

struct EpiPlain {
    bf16* O; int ldc;
    __device__ __forceinline__ void operator()(const f32x4 (&acc)[2][2][4][2], const pg8::Unit& u, int wr, int wc, int fr, int fq) const {
#pragma unroll
        for (int ai = 0; ai < 2; ++ai)
#pragma unroll
            for (int m = 0; m < 4; ++m)
#pragma unroll
                for (int bj = 0; bj < 2; ++bj) {
                    const size_t off = (size_t)(u.pm * 256 + ai * 128 + wr * 64 + m * 16 + fr) * ldc + u.pn * 256 + bj * 128 + wc * 32 + 8 * fq;
                    *(v4u*)(O + off) = pack8(acc[ai][bj][m][0], acc[ai][bj][m][1]);
                }
    }
};

struct MoeOrder {
    int G, c, NP, mode;
    LAS const int* tab; const int* tokof;
    __device__ __forceinline__ bool next(int i, pg8::Unit& u) const {
        const int L = i * G + c, ntile = tab[32 + 32];
        if (L >= ntile * NP) return false;
        const int ti = L / NP, pnl = L % NP; int e = 0;
#pragma unroll 1
        for (int k = 1; k < 32; ++k) e = (tab[32 + k] <= ti) ? k : e;
        u.e = e; u.rt = ti - tab[32 + e]; u.pm = ti; u.pn = e * NP + pnl; return true;
    }
    __device__ __forceinline__ unsigned a_off(const pg8::Unit& u, int r) const {
        const int cnt = tab[u.e]; int rank = u.rt * 256 + r; rank = rank < cnt ? rank : cnt - 1;
        if (mode == 0) { const int id = tokof[(size_t)u.e * NTOK + rank]; return (unsigned)(id >> 2) * 2048u; }
        return (unsigned)(tab[65 + u.e] + rank) * 2048u;
    }
};
__device__ __forceinline__ void moe_tables(const Args& A, const Ctx& X) {
    LAS int* tab = (LAS int*)(X.lds + TAB_OFF);
    __syncthreads();
    if (X.tid == 0) { const unsigned* ctl = (const unsigned*)(X.ws + WS_CTL); int ts = 0, gs = 0;
        for (int e = 0; e < 32; ++e) { const int cnt = (int)__hip_atomic_load(ctl + CW_ECNT + 64 * e, __ATOMIC_RELAXED, __HIP_MEMORY_SCOPE_AGENT); tab[e] = cnt; tab[32 + e] = ts; tab[65 + e] = gs; ts += (cnt + 255) >> 8; gs += cnt; }
        tab[32 + 32] = ts; tab[65 + 32] = gs; }
    __syncthreads();
}

struct EpiGateUp {
    bf16* ACT; const float* bg; const float* bu; LAS const int* tab;
    __device__ __forceinline__ void operator()(const f32x4 (&acc)[2][2][4][2], const pg8::Unit& u, int wr, int wc, int fr, int fq) const {
        const int e = u.e, pnl = u.pn - e * 8, col = pnl * 128 + wc * 32 + 8 * fq, cnt = tab[e], gs = tab[65 + e];
        const f32x4 g0 = *(const f32x4*)(bg + e * 1024 + col), g1 = *(const f32x4*)(bg + e * 1024 + col + 4), u0 = *(const f32x4*)(bu + e * 1024 + col), u1 = *(const f32x4*)(bu + e * 1024 + col + 4);
#pragma unroll
        for (int ai = 0; ai < 2; ++ai)
#pragma unroll
            for (int m = 0; m < 4; ++m) {
                const int rank = u.rt * 256 + ai * 128 + wr * 64 + m * 16 + fr;
                f32x4 a0 = acc[ai][0][m][0] + g0, a1 = acc[ai][0][m][1] + g1, b0 = acc[ai][1][m][0] + u0, b1 = acc[ai][1][m][1] + u1, o0, o1;
#pragma unroll
                for (int i = 0; i < 4; ++i) {
                    float gt = fminf(a0[i], 7.f), up = fminf(fmaxf(b0[i], -7.f), 7.f); o0[i] = gt * sigmoidf_(1.702f * gt) * (up + 1.f);
                    gt = fminf(a1[i], 7.f); up = fminf(fmaxf(b1[i], -7.f), 7.f); o1[i] = gt * sigmoidf_(1.702f * gt) * (up + 1.f); }
                if (rank < cnt) *(v4u*)(ACT + (size_t)(gs + rank) * 1024 + col) = pack8(o0, o1);
            }
    }
};
struct EpiDown {
    unsigned char* out; unsigned char* yshi; const float* bd; LAS const int* tab; const int* tokof;
    __device__ __forceinline__ void operator()(const f32x4 (&acc)[2][2][4][2], const pg8::Unit& u, int wr, int wc, int fr, int fq) const {
        const int e = u.e, pnl = u.pn - e * 4, cnt = tab[e];
#pragma unroll
        for (int ai = 0; ai < 2; ++ai)
#pragma unroll
            for (int m = 0; m < 4; ++m) {
                const int rank = u.rt * 256 + ai * 128 + wr * 64 + m * 16 + fr;
                if (rank < cnt) {
                    const int id = tokof[(size_t)e * NTOK + rank], tok = id >> 2, k = id & 3;
                    const long long dlt = (k >= 2) ? (long long)(yshi - out) : 0ll; unsigned char* rowp = out + dlt + (size_t)tok * 4096 + (k & 1) * 2048;
#pragma unroll
                    for (int bj = 0; bj < 2; ++bj) { const int col = pnl * 256 + bj * 128 + wc * 32 + 8 * fq;
                        const f32x4 b0 = *(const f32x4*)(bd + e * 1024 + col), b1 = *(const f32x4*)(bd + e * 1024 + col + 4);
                        *(v4u*)(rowp + col * 2) = pack8(acc[ai][bj][m][0] + b0, acc[ai][bj][m][1] + b1); }
                }
            }
    }
};

__device__ __forceinline__ f32x4 ld_bf4(const bf16* p) { const v2u u = *(const v2u*)p; return (f32x4){bf_lo(u.x), bf_hi(u.x), bf_lo(u.y), bf_hi(u.y)}; }

__device__ __forceinline__ void phase6(const Args& A, const Ctx& X) {
    const float* x = A.in[0]; const float* gpost = A.in[5]; const float* gpre2 = A.in[16]; const float* b_router = A.in[19];
    const float* ADA = (const float*)(X.ws + WS_ADA); const float* WRT = (const float*)(X.ws + WS_WRT);
    const bf16* MIXED = (const bf16*)(X.ws + WS_MIXED); bf16* H2 = (bf16*)((unsigned char*)X.out + OUT_H2);
    int* TOPE = (int*)(X.ws + WS_TOPE); float* TOPW = (float*)(X.ws + WS_TOPW); int* RANK = (int*)(X.ws + WS_RANK); int* TOKOF = (int*)(X.ws + WS_TOKOF);
    unsigned* ctl = (unsigned*)(X.ws + WS_CTL);
    LAS float* v_g1 = (LAS float*)X.lds;
    LAS float* v_g2 = v_g1 + 1024;
    LAS float* v_s2 = v_g2 + 1024;
    LAS int* e_of = (LAS int*)(v_s2 + 1024);
    LAS int* lcnt = e_of + 512;
    LAS int* lbase = lcnt + 32;
    const int lane = X.lane;
    for (int ch = blockIdx.x; ch < NTOK / 128; ch += X.G) {
        const int row0 = ch * 128, b = row0 / SEQ;
        __syncthreads();
        for (int j = X.tid; j < 1024; j += 512) { v_g1[j] = ADA[b * 6144 + 2048 + j] * gpost[j]; v_g2[j] = gpre2[j] * (1.f + ADA[b * 6144 + 4096 + j]); v_s2[j] = ADA[b * 6144 + 3072 + j]; }
        if (X.tid < 32) lcnt[X.tid] = 0;
        __syncthreads();
        for (int i = 0; i < 16; ++i) {
            const int rl = X.wave + 8 * i, row = row0 + rl;
            f32x4 mv[4], xv[4]; float ss = 0.f;
#pragma unroll
            for (int j = 0; j < 4; ++j) { const int k = 4 * lane + 256 * j; mv[j] = ld_bf4(MIXED + (size_t)row * 1024 + k); xv[j] = *(const f32x4*)(x + (size_t)row * 1024 + k);
                ss += (mv[j].x * mv[j].x + mv[j].y * mv[j].y) + (mv[j].z * mv[j].z + mv[j].w * mv[j].w); }
            const float r1 = 1.f / sqrtf(wave_sum(ss) * (1.f / DM) + RMS_EPS); float s2 = 0.f;
#pragma unroll
            for (int j = 0; j < 4; ++j) { const int k = 4 * lane + 256 * j; const f32x4 g = *(LAS f32x4*)(v_g1 + k); xv[j] = xv[j] + g * (mv[j] * r1);
                s2 += (xv[j].x * xv[j].x + xv[j].y * xv[j].y) + (xv[j].z * xv[j].z + xv[j].w * xv[j].w); }
            const float r2 = 1.f / sqrtf(wave_sum(s2) * (1.f / DM) + RMS_EPS);
#pragma unroll
            for (int j = 0; j < 4; ++j) { const int k = 4 * lane + 256 * j; const f32x4 g = *(LAS f32x4*)(v_g2 + k), s = *(LAS f32x4*)(v_s2 + k); xv[j] = xv[j] * r2 * g + s;
                v2u o; o.x = pk2(xv[j].x, xv[j].y); o.y = pk2(xv[j].z, xv[j].w); *(v2u*)(H2 + (size_t)row * 1024 + k) = o; }
            float mylogit = -3.0e38f;
#pragma unroll 4
            for (int e = 0; e < 32; ++e) { float p = 0.f;
#pragma unroll
                for (int j = 0; j < 4; ++j) { const f32x4 w = *(const f32x4*)(WRT + e * 1024 + 4 * lane + 256 * j); p += (xv[j].x * w.x + xv[j].y * w.y) + (xv[j].z * w.z + xv[j].w * w.w); }
                p = wave_sum(p) + b_router[e]; if (lane == e) mylogit = p; }
            float tv[4]; int te[4]; float cur = mylogit;
#pragma unroll
            for (int k = 0; k < 4; ++k) { float mx = cur;
#pragma unroll
                for (int o = 1; o < 64; o <<= 1) mx = fmaxf(mx, __shfl_xor(mx, o));
                const unsigned long long bal = __ballot(cur == mx && lane < 32); const int idx = __ffsll((long long)bal) - 1;
                tv[k] = mx; te[k] = idx; if (lane == idx) cur = -3.0e38f; }
            const float e1 = __expf(tv[1] - tv[0]), e2 = __expf(tv[2] - tv[0]), e3 = __expf(tv[3] - tv[0]), inv = 1.f / (1.f + e1 + e2 + e3);
            if (lane == 0) { *(int4*)(TOPE + (size_t)row * 4) = make_int4(te[0], te[1], te[2], te[3]); *(f32x4*)(TOPW + (size_t)row * 4) = (f32x4){inv, e1 * inv, e2 * inv, e3 * inv};
                e_of[rl * 4 + 0] = te[0]; e_of[rl * 4 + 1] = te[1]; e_of[rl * 4 + 2] = te[2]; e_of[rl * 4 + 3] = te[3]; }
        }
        __syncthreads();
        const int e = e_of[X.tid]; const int lr = __hip_atomic_fetch_add(&lcnt[e], 1, __ATOMIC_RELAXED, __HIP_MEMORY_SCOPE_WORKGROUP);
        __syncthreads();
        if (X.tid < 32) lbase[X.tid] = (int)__hip_atomic_fetch_add(ctl + CW_ECNT + 64 * X.tid, (unsigned)lcnt[X.tid], __ATOMIC_RELAXED, __HIP_MEMORY_SCOPE_AGENT);
        __syncthreads();
        { const int rank = lbase[e] + lr, id = (row0 + (X.tid >> 2)) * 4 + (X.tid & 3); RANK[id] = rank; TOKOF[(size_t)e * NTOK + rank] = id; }
    }
}

__device__ __forceinline__ void phase10(const Args& A, const Ctx& X) {
    const float* x = A.in[0]; const float* gpost = A.in[5]; const float* gpost2 = A.in[17];
    const float* ADA = (const float*)(X.ws + WS_ADA); const bf16* MIXED = (const bf16*)(X.ws + WS_MIXED);
    const float* TOPW = (const float*)(X.ws + WS_TOPW);
    LAS float* v_g1 = (LAS float*)X.lds; LAS float* v_g3 = v_g1 + 1024;
    const int lane = X.lane;
    for (int ch = blockIdx.x; ch < NTOK / 128; ch += X.G) {
        const int row0 = ch * 128, b = row0 / SEQ;
        __syncthreads();
        for (int j = X.tid; j < 1024; j += 512) { v_g1[j] = ADA[b * 6144 + 2048 + j] * gpost[j]; v_g3[j] = ADA[b * 6144 + 5120 + j] * gpost2[j]; }
        __syncthreads();
        for (int i = 0; i < 16; ++i) {
            const int row = row0 + X.wave + 8 * i;
            const f32x4 tw = *(const f32x4*)(TOPW + (size_t)row * 4);
            const bf16* y0 = (const bf16*)((const unsigned char*)X.out + (size_t)row * 4096); const bf16* y2 = (const bf16*)(X.ws + WS_YSHI + (size_t)row * 4096);
            f32x4 mv[4], xv[4], yv[4]; float ss = 0.f, sy = 0.f;
#pragma unroll
            for (int j = 0; j < 4; ++j) { const int k = 4 * lane + 256 * j; mv[j] = ld_bf4(MIXED + (size_t)row * 1024 + k); xv[j] = *(const f32x4*)(x + (size_t)row * 1024 + k);
                yv[j] = ld_bf4(y0 + k) * tw.x + ld_bf4(y0 + 1024 + k) * tw.y + ld_bf4(y2 + k) * tw.z + ld_bf4(y2 + 1024 + k) * tw.w;
                ss += (mv[j].x * mv[j].x + mv[j].y * mv[j].y) + (mv[j].z * mv[j].z + mv[j].w * mv[j].w);
                sy += (yv[j].x * yv[j].x + yv[j].y * yv[j].y) + (yv[j].z * yv[j].z + yv[j].w * yv[j].w); }
            const float r1 = 1.f / sqrtf(wave_sum(ss) * (1.f / DM) + RMS_EPS), r3 = 1.f / sqrtf(wave_sum(sy) * (1.f / DM) + RMS_EPS);
            asm volatile("s_waitcnt vmcnt(0)" ::: "memory");
#pragma unroll
            for (int j = 0; j < 4; ++j) { const int k = 4 * lane + 256 * j; const f32x4 g1 = *(LAS f32x4*)(v_g1 + k), g3 = *(LAS f32x4*)(v_g3 + k);
                *(f32x4*)(X.out + (size_t)row * 1024 + k) = xv[j] + g1 * (mv[j] * r1) + g3 * (yv[j] * r3); }
        }
    }
}

constexpr int AL_K = 0, AL_V = 16384, AL_KB = 32768, AL_TBL = 33280, AL_SELM = 35328, AL_IMPW = 36864;
typedef short v4i16_t __attribute__((ext_vector_type(4)));
__device__ __forceinline__ int crow(int r, int hi) { return (r & 3) + 8 * (r >> 2) + 4 * hi; }
__device__ __forceinline__ s16x4 vtr(LAS const unsigned char* p) { return __builtin_bit_cast(s16x4, __builtin_amdgcn_ds_read_tr16_b64_v4i16((LAS v4i16_t*)p)); }

__device__ __forceinline__ void qk_tile(f32x16& p0, f32x16& p1, LAS const unsigned char* Ks, const bf16x8 (&qr)[4], int r32, int hi) {
    LAS const unsigned char* kb = Ks + hi * 1024 + r32 * 16;
    p0 = (f32x16){}; p1 = (f32x16){};
#pragma unroll
    for (int d0 = 0; d0 < 4; ++d0) {
        const bf16x8 b0 = *(LAS const bf16x8*)(kb + d0 * 2048), b1 = *(LAS const bf16x8*)(kb + d0 * 2048 + 512);
        p0 = __builtin_amdgcn_mfma_f32_32x32x16_bf16(b0, qr[d0], p0, 0, 0, 0);
        p1 = __builtin_amdgcn_mfma_f32_32x32x16_bf16(b1, qr[d0], p1, 0, 0, 0);
    }
}
__device__ __forceinline__ void softmax_pv(f32x16& p0, f32x16& p1, float& m, float& l, f32x16 (&o)[2], LAS const unsigned char* Vs, int lane, int hi) {
    float rm = fmaxf(p0[0], p1[0]);
#pragma unroll
    for (int r = 1; r < 16; ++r) rm = fmaxf(rm, fmaxf(p0[r], p1[r]));
    rm = fmaxf(rm, __shfl_xor(rm, 32));
    const float mn = fmaxf(m, rm), alpha = __builtin_amdgcn_exp2f(m - mn);
    m = mn;
    if (!__all(alpha == 1.f)) { l *= alpha;
#pragma unroll
        for (int r = 0; r < 16; ++r) { o[0][r] *= alpha; o[1][r] *= alpha; } }
    float s = 0.f;
#pragma unroll
    for (int r = 0; r < 16; ++r) { p0[r] = __builtin_amdgcn_exp2f(p0[r] - mn); p1[r] = __builtin_amdgcn_exp2f(p1[r] - mn); s += p0[r] + p1[r]; }
    l += s;
    v4u pw[4];
    pw[0] = (v4u){pk2(p0[0], p0[1]), pk2(p0[2], p0[3]), pk2(p0[4], p0[5]), pk2(p0[6], p0[7])};
    pw[1] = (v4u){pk2(p0[8], p0[9]), pk2(p0[10], p0[11]), pk2(p0[12], p0[13]), pk2(p0[14], p0[15])};
    pw[2] = (v4u){pk2(p1[0], p1[1]), pk2(p1[2], p1[3]), pk2(p1[4], p1[5]), pk2(p1[6], p1[7])};
    pw[3] = (v4u){pk2(p1[8], p1[9]), pk2(p1[10], p1[11]), pk2(p1[12], p1[13]), pk2(p1[14], p1[15])};
    LAS const unsigned char* vb = Vs + ((lane >> 4) & 1) * 32 + (lane & 3) * 8 + (4 * hi + ((lane & 15) >> 2)) * 64;
    __builtin_amdgcn_sched_barrier(0);
#pragma unroll
    for (int d0 = 0; d0 < 2; ++d0) {
#pragma unroll
        for (int ks = 0; ks < 4; ++ks) {
            const s16x4 lo = vtr(vb + d0 * 4096 + ks * 1024), hh_ = vtr(vb + d0 * 4096 + ks * 1024 + 512);
            const bf16x8 vf = (bf16x8){lo[0], lo[1], lo[2], lo[3], hh_[0], hh_[1], hh_[2], hh_[3]};
            o[d0] = __builtin_amdgcn_mfma_f32_32x32x16_bf16(vf, __builtin_bit_cast(bf16x8, pw[ks]), o[d0], 0, 0, 0);
        }
        __builtin_amdgcn_sched_barrier(0);
    }
}

template <int MODE>
__device__ __forceinline__ void attn_branch(LAS unsigned char* L, int& buf, const bf16* __restrict__ Kg, const bf16* __restrict__ Vg, const float* __restrict__ KBg,
                                            int jlo, int jhi, const bf16x8 (&qr)[4], int tq, int tqmax, int hh, int qt, unsigned long long selm,
                                            float& m, float& l, f32x16 (&o)[2], float inv, int th) {
    const int tid = threadIdx.x, lane = tid & 63, wid = __builtin_amdgcn_readfirstlane(tid >> 6), r32 = lane & 31, hi = lane >> 5;
    LAS const float* TBL = (LAS const float*)(L + AL_TBL);
    v4u kreg, vreg = (v4u){0u, 0u, 0u, 0u}; float kbreg = 0.f;
#define ATT_GLOAD(j) do { kreg = *(const v4u*)(Kg + (size_t)(j) * 4096 + lane * 64 + wid * 8); \
        if (MODE != 4) vreg = *(const v4u*)(Vg + (size_t)(j) * 4096 + (16 * (wid & 3) + (lane >> 2)) * 64 + (wid >> 2) * 32 + (lane & 3) * 8); \
        if (MODE == 0 && tid < 64) kbreg = KBg[(j) * 64 + tid]; } while (0)
    ATT_GLOAD(jlo);
    float carry = 0.f;
    for (int j = jlo; j <= jhi; ++j) {
        LAS unsigned char* Ks = L + AL_K + buf * 8192; LAS unsigned char* Vs = L + AL_V + buf * 8192; LAS float* KBs = (LAS float*)(L + AL_KB) + buf * 64;
        *(LAS v4u*)(Ks + wid * 1024 + lane * 16) = kreg;
        if (MODE != 4) *(LAS v4u*)(Vs + wid * 1024 + lane * 16) = vreg;
        if (MODE == 0 && tid < 64) KBs[tid] = kbreg;
        __syncthreads();
        if (j < jhi) ATT_GLOAD(j + 1);
        const int key0 = j * 64;
        if (!(MODE == 0 && key0 > tqmax)) {
            f32x16 p0, p1;
            qk_tile(p0, p1, Ks, qr, r32, hi);
            __builtin_amdgcn_sched_barrier(0);
            if (MODE == 0) {
#pragma unroll
                for (int a = 0; a < 4; ++a) { const f32x4 b0 = *(LAS const f32x4*)(KBs + 8 * a + 4 * hi), b1 = *(LAS const f32x4*)(KBs + 32 + 8 * a + 4 * hi);
#pragma unroll
                    for (int i = 0; i < 4; ++i) { p0[4 * a + i] += b0[i]; p1[4 * a + i] += b1[i]; } }
                if (key0 + 63 > tqmax - 31) {
                    int d0 = tq - key0 - 4 * hi; asm volatile("" : "+v"(d0));
#pragma unroll
                    for (int r = 0; r < 16; ++r) { const int C = (r & 3) + 8 * (r >> 2); if (C > d0) p0[r] = NEGBIG; if (C + 32 > d0) p1[r] = NEGBIG; }
                }
            } else {
                const bool general = (MODE == 1 || MODE == 4) ? true : (MODE == 2 ? (j >= qt - 2) : (j >= qt - 2 || j <= qt - 8));
                const bool selbit = (MODE == 2) ? (((selm >> j) & 1ull) != 0ull) : true;
                if (general) {
                    int d0 = (MODE == 1 || MODE == 4) ? tq - 31 - 16 * key0 - 64 * hi : tq - key0 - 4 * hi;
                    asm volatile("" : "+v"(d0));
                    constexpr int CM = (MODE == 1 || MODE == 4) ? 16 : 1;
#pragma unroll
                    for (int r = 0; r < 16; ++r) {
#pragma unroll
                        for (int hblk = 0; hblk < 2; ++hblk) {
                            const int dist = d0 - CM * ((r & 3) + 8 * (r >> 2) + 32 * hblk);
                            bool valid = dist >= 0; if (MODE == 3) valid = valid && dist < 512; if (MODE == 2) valid = valid && selbit;
                            const int idx = min(max(dist, 0), 127);
                            const float bias = TBL[idx * 4 + hh];
                            if (hblk) p1[r] = valid ? p1[r] + bias : NEGBIG; else p0[r] = valid ? p0[r] + bias : NEGBIG;
                        }
                        if ((r & 3) == 3) __builtin_amdgcn_sched_barrier(0);
                    }
                } else {
                    const float bfar = TBL[127 * 4 + hh];
#pragma unroll
                    for (int r = 0; r < 16; ++r) { p0[r] = selbit ? p0[r] + bfar : NEGBIG; p1[r] = selbit ? p1[r] + bfar : NEGBIG; }
                }
            }
            __builtin_amdgcn_sched_barrier(0);
            if (MODE != 4) {
                softmax_pv(p0, p1, m, l, o, Vs, lane, hi);
            } else {
                float S0[4], S1[4], s0[4], s1[4];
#pragma unroll
                for (int r = 0; r < 16; ++r) { p0[r] = __builtin_amdgcn_exp2f(p0[r] - m) * inv; p1[r] = __builtin_amdgcn_exp2f(p1[r] - m) * inv; }
#pragma unroll
                for (int a = 0; a < 4; ++a) { S0[a] = (p0[4 * a] + p0[4 * a + 1]) + (p0[4 * a + 2] + p0[4 * a + 3]); S1[a] = (p1[4 * a] + p1[4 * a + 1]) + (p1[4 * a + 2] + p1[4 * a + 3]); }
                if (hi == 0) {
#pragma unroll
                    for (int a = 0; a < 4; ++a) { s0[a] = p0[4 * a + 3]; s1[a] = p1[4 * a + 3]; }
                } else { s0[0] = carry; s0[1] = p0[3]; s0[2] = p0[7]; s0[3] = p0[11]; s1[0] = p0[15]; s1[1] = p1[3]; s1[2] = p1[7]; s1[3] = p1[11]; carry = p1[15]; }
                LAS float* IW = (LAS float*)(L + AL_IMPW) + ((hh * 64) + (32 * th + r32)) * 64 + 16 * j + hi;
#pragma unroll
                for (int a = 0; a < 4; ++a) { IW[2 * a] = S0[a] + __shfl_xor(s0[a], 32); IW[8 + 2 * a] = S1[a] + __shfl_xor(s1[a], 32); }
            }
        }
        buf ^= 1;
    }
#undef ATT_GLOAD
}

__device__ __forceinline__ void store_ot(bf16* dst  , const f32x16 (&o)[2], float scale, int hi) {
#pragma unroll
    for (int d0 = 0; d0 < 2; ++d0)
#pragma unroll
        for (int a = 0; a < 4; ++a) { v2u w; w.x = pk2(o[d0][4 * a] * scale, o[d0][4 * a + 1] * scale); w.y = pk2(o[d0][4 * a + 2] * scale, o[d0][4 * a + 3] * scale);
            *(v2u*)(dst + 32 * d0 + 8 * a + 4 * hi) = w; }
}

__device__ __forceinline__ void fox_unit(const Args& A, const Ctx& X, int bh, int qb, int& buf) {
    const int lane = X.lane, wid = X.wave, r32 = lane & 31, hi = lane >> 5;
    const int tq = 256 * qb + 32 * wid + r32, tqmax = 256 * qb + 32 * wid + 31;
    const bf16* Q = (const bf16*)(X.ws + WS_FQ) + ((size_t)bh * SEQ + tq) * 64;
    bf16x8 qr[4];
#pragma unroll
    for (int d0 = 0; d0 < 4; ++d0) qr[d0] = *(const bf16x8*)(Q + d0 * 16 + hi * 8);
    float m = NEGBIG, l = 0.f; f32x16 o[2]; o[0] = (f32x16){}; o[1] = (f32x16){};
    attn_branch<0>(X.lds, buf, (const bf16*)(X.ws + WS_FK) + (size_t)bh * SEQ * 64, (const bf16*)(X.ws + WS_FV) + (size_t)bh * SEQ * 64, (const float*)(X.ws + WS_KBIAS) + (size_t)bh * SEQ,
                   0, 4 * qb + 3, qr, tq, tqmax, 0, 0, 0ull, m, l, o, 0.f, 0);
    const float lt = l + __shfl_xor(l, 32);
    const int b = bh >> 3, h = bh & 7;
    store_ot((bf16*)((unsigned char*)X.out + OUT_OFOX) + ((size_t)b * SEQ + tq) * 512 + h * 64, o, 1.f / lt, hi);
}

__device__ __forceinline__ void nsa_unit(const Args& A, const Ctx& X, int bg, int qt, int& buf) {
    const int tid = X.tid, lane = X.lane, wid = X.wave, r32 = lane & 31, hi = lane >> 5, hh = wid >> 1, th = wid & 1;
    const int b = bg >> 1, g = bg & 1, head = 4 * g + hh;
    const int tok = 32 * th + r32, tq = 64 * qt + tok, tqmax = 64 * qt + 32 * th + 31;
    LAS unsigned char* L = X.lds;
    __syncthreads();
    { const float* rel = A.in[15]; LAS float* TBL = (LAS float*)(L + AL_TBL); const int d = tid >> 2, q = tid & 3; TBL[tid] = rel[T5_BUCKET[d] * 8 + 4 * g + q] * LOG2E; }
    { LAS v4u* z = (LAS v4u*)(L + AL_IMPW);
#pragma unroll
      for (int i = 0; i < 8; ++i) z[tid + 512 * i] = (v4u){0u, 0u, 0u, 0u}; }
    const bf16* Q = (const bf16*)(X.ws + WS_NQ) + ((size_t)(b * 8 + head) * SEQ + tq) * 64;
    bf16x8 qr[4];
#pragma unroll
    for (int d0 = 0; d0 < 4; ++d0) qr[d0] = *(const bf16x8*)(Q + d0 * 16 + hi * 8);
    const float* gp = (const float*)(X.ws + WS_GATES) + ((size_t)b * SEQ + tq) * 24 + head * 3;
    const float g_cmp = gp[0], g_slc = gp[1], g_win = gp[2];
    __syncthreads();
    const bf16* KV6 = (const bf16*)(X.ws + WS_KV6);
    const bf16* KC = (const bf16*)(X.ws + WS_KC) + (size_t)bg * 256 * 64; const bf16* VC = (const bf16*)(X.ws + WS_VC) + (size_t)bg * 256 * 64;
    const int nct = (4 * qt + 2) / 64;
    float m = NEGBIG, l = 0.f; f32x16 o[2]; o[0] = (f32x16){}; o[1] = (f32x16){};
#ifndef NSA_NO1
    attn_branch<1>(L, buf, KC, VC, nullptr, 0, nct, qr, tq, tqmax, hh, qt, 0ull, m, l, o, 0.f, th);
#endif
    float lt = l + __shfl_xor(l, 32);
    const float inv_c = (tq >= 31) ? 1.f / lt : 0.f;
    { const float sc = g_cmp * inv_c;
#pragma unroll
      for (int r = 0; r < 16; ++r) { o[0][r] *= sc; o[1][r] *= sc; } }
#ifndef NSA_NO4
    { float m2 = m, l2 = 0.f; f32x16 od[2]; attn_branch<4>(L, buf, KC, VC, nullptr, 0, nct, qr, tq, tqmax, hh, qt, 0ull, m2, l2, od, inv_c, th); }
#endif
    __syncthreads();
    {
        LAS const float* IW = (LAS const float*)(L + AL_IMPW); LAS unsigned long long* SELM = (LAS unsigned long long*)(L + AL_SELM);
        for (int ii = 0; ii < 8; ++ii) {
            const int tk = 8 * wid + ii, j = lane;
            const float imp = ((IW[(0 * 64 + tk) * 64 + j] + IW[(1 * 64 + tk) * 64 + j]) + IW[(2 * 64 + tk) * 64 + j]) + IW[(3 * 64 + tk) * 64 + j];
            const bool forced = (j == 0) || (j == qt) || (j == qt - 1), svalid = (j <= qt);
            const float score = forced ? 1e9f : (svalid ? imp : -1e9f);
            int rank = 0;
#pragma unroll 4
            for (int i = 0; i < 64; ++i) { const float si = __builtin_bit_cast(float, __builtin_amdgcn_readlane(__builtin_bit_cast(int, score), i));
                rank += ((si > score) || (si == score && i < j)) ? 1 : 0; }
            const unsigned long long msk = __ballot(rank < 16);
            if (lane == 0) SELM[tk] = msk;
        }
    }
    __syncthreads();
    const unsigned long long selm = ((LAS const unsigned long long*)(L + AL_SELM))[tok];
    LAS float* ACC = (LAS float*)(L + AL_IMPW) + tid;
#pragma unroll
    for (int r = 0; r < 16; ++r) { ACC[r * 512] = o[0][r]; ACC[(16 + r) * 512] = o[1][r]; }
    m = NEGBIG; l = 0.f; o[0] = (f32x16){}; o[1] = (f32x16){};
#ifndef NSA_NO2
    attn_branch<2>(L, buf, KV6 + 2 * KV6_STRIDE + (size_t)bg * SEQ * 64, KV6 + 3 * KV6_STRIDE + (size_t)bg * SEQ * 64, nullptr, 0, qt, qr, tq, tqmax, hh, qt, selm, m, l, o, 0.f, th);
#endif
    lt = l + __shfl_xor(l, 32);
    { const float sc = g_slc / lt;
#pragma unroll
      for (int r = 0; r < 16; ++r) { ACC[r * 512] += o[0][r] * sc; ACC[(16 + r) * 512] += o[1][r] * sc; } }
    m = NEGBIG; l = 0.f; o[0] = (f32x16){}; o[1] = (f32x16){};
#ifndef NSA_NO3
    attn_branch<3>(L, buf, KV6 + 4 * KV6_STRIDE + (size_t)bg * SEQ * 64, KV6 + 5 * KV6_STRIDE + (size_t)bg * SEQ * 64, nullptr, qt > 8 ? qt - 8 : 0, qt, qr, tq, tqmax, hh, qt, 0ull, m, l, o, 0.f, th);
#endif
    lt = l + __shfl_xor(l, 32);
    { const float sc = g_win / lt;
#pragma unroll
      for (int r = 0; r < 16; ++r) { o[0][r] = ACC[r * 512] + o[0][r] * sc; o[1][r] = ACC[(16 + r) * 512] + o[1][r] * sc; } }
    store_ot((bf16*)((unsigned char*)X.out + OUT_ONSA) + ((size_t)b * SEQ + tq) * 512 + head * 64, o, 1.f, hi);
}

__device__ __forceinline__ void phase3(const Args& A, const Ctx& X) {
    int buf = 0;
#ifndef NO_FOX
    for (int u = X.vcu; u < 1024; u += X.G) { const int rd = u >> 8, v = u & 255, bh = v >> 2, s = v & 3; const int qb = (rd == 0) ? s : (rd == 1) ? 7 - s : (rd == 2) ? 8 + s : 15 - s;
        fox_unit(A, X, bh, qb, buf); }
#endif
#ifndef NO_NSA
    for (int u = X.vcu; u < 1024; u += X.G) { const int rd = u >> 8, v = u & 255, bg = v >> 4, s = v & 15; const int qt = (rd == 0) ? s : (rd == 1) ? 31 - s : (rd == 2) ? 32 + s : 63 - s;
        nsa_unit(A, X, bg, qt, buf); }
#endif
}

#ifndef MK_N_LAUNCHES
#define MK_N_LAUNCHES 11
#endif
constexpr int N_PHASES = 11;

__global__ void __launch_bounds__(512, 2) fwd(Args args) {
    extern __shared__ __attribute__((aligned(16))) unsigned char lds_raw[];
    Ctx X;
    X.out = args.out; X.ws = args.ws;
    X.lds = (LAS unsigned char*)lds_raw;
    X.tid = threadIdx.x; X.lane = X.tid & 63; X.wave = __builtin_amdgcn_readfirstlane(X.tid >> 6);
    X.G = gridDim.x; { const int bx = blockIdx.x; X.vcu = (X.G % 8 == 0) ? (bx % 8) * (X.G / 8) + bx / 8 : bx; }
    volatile LAS unsigned* MISC = (volatile LAS unsigned*)(X.lds + MISC_OFF);
    if (X.tid < 64) MISC[X.tid] = 0u;
    __syncthreads();
    const int lo = args.ph_lo, hi = args.ph_hi;
    unsigned* ctl = (unsigned*)(X.ws + WS_CTL);
    XcdBarrier bar; bar.bar = ctl + CW_BAR; bar.x = 0; bar.st = MISC + 8;
    if (hi - lo > 1) bar = xcd_barrier_post(ctl + CW_BAR, MISC + 8);
#ifndef PHMASK
#define PHMASK 0x7ff
#endif
#define IN(k) ((((PHMASK) >> (k)) & 1) && lo <= (k) && (k) < hi)
#define SEAM(k) do { if (IN(k) && IN((k) + 1)) xcd_barrier(bar); } while (0)
    unsigned char* ws = X.ws;
    const int bid = (int)blockIdx.x;

    if (IN(0)) { phase0a(args, X); SEAM(0); }
    if (IN(1)) { phase0b(args, X); SEAM(1); }
    if (IN(2)) {
        pg8::Gemm g{(const bf16*)((unsigned char*)X.out + OUT_H), (const bf16*)(ws + WS_WIN), 1024};
        pg8::StaticOrder S; S.init(NTOK, NPROJ, X.G, bid, 1024);
        EpiInProj E{ws, args.in[7]};
        pg8::gemm_phase<EpiInProj, pg8::StaticOrder>(X.lds, g, S, E);
        SEAM(2);
    }
    if (IN(3)) { phase2(args, X); SEAM(3); }
    if (IN(4)) { phase3(args, X); SEAM(4); }
    if (IN(5)) {
        pg8::StaticOrder S; S.init(NTOK, 1024, X.G, bid, 512);
        { pg8::Gemm g{(const bf16*)((unsigned char*)X.out + OUT_OFOX), (const bf16*)(ws + WS_WFOX), 512};
          EpiGate<false> E{(bf16*)(ws + WS_GATED), (const bf16*)(ws + WS_SGF)};
          pg8::gemm_phase<EpiGate<false>, pg8::StaticOrder>(X.lds, g, S, E); }
        { pg8::Gemm g{(const bf16*)((unsigned char*)X.out + OUT_ONSA), (const bf16*)(ws + WS_WNSA), 512};
          EpiGate<true> E{(bf16*)(ws + WS_GATED), (const bf16*)(ws + WS_SGN)};
          pg8::gemm_phase<EpiGate<true>, pg8::StaticOrder>(X.lds, g, S, E); }
        SEAM(5);
    }
    if (IN(6)) {
        pg8::Gemm g{(const bf16*)(ws + WS_GATED), (const bf16*)(ws + WS_WMIX), 1024};
        pg8::StaticOrder S; S.init(NTOK, 1024, X.G, bid, 1024);
        EpiPlain E{(bf16*)(ws + WS_MIXED), 1024};
        pg8::gemm_phase<EpiPlain, pg8::StaticOrder>(X.lds, g, S, E);
        SEAM(6);
    }
    if (IN(7)) { phase6(args, X); SEAM(7); }
    if (IN(8)) {
        moe_tables(args, X);
        LAS const int* tab = (LAS const int*)(X.lds + TAB_OFF);
        MoeOrder S{X.G, bid, 8, 0, tab, (const int*)(ws + WS_TOKOF)};
        pg8::Gemm g{(const bf16*)((unsigned char*)X.out + OUT_H2), (const bf16*)(ws + WS_WGU), 1024};
        EpiGateUp E{(bf16*)(ws + WS_ACT), args.in[21], args.in[23], tab};
        pg8::gemm_phase<EpiGateUp, MoeOrder>(X.lds, g, S, E);
        SEAM(8);
    }
    if (IN(9)) {
        moe_tables(args, X);
        LAS const int* tab = (LAS const int*)(X.lds + TAB_OFF);
        MoeOrder S{X.G, bid, 4, 1, tab, (const int*)(ws + WS_TOKOF)};
        pg8::Gemm g{(const bf16*)(ws + WS_ACT), (const bf16*)(ws + WS_WD), 1024};
        EpiDown E{(unsigned char*)X.out, ws + WS_YSHI, args.in[25], tab, (const int*)(ws + WS_TOKOF)};
        pg8::gemm_phase<EpiDown, MoeOrder>(X.lds, g, S, E);
        SEAM(9);
    }
    if (IN(10)) { phase10(args, X); }
#undef IN
#undef SEAM
}

extern "C" void kernel_launch(void* const* d_in, const int* in_sizes, int n_in, void* d_out, int out_size, void* d_ws, size_t ws_size, hipStream_t stream) {
    static int grid = 0;
    if (grid == 0) {
        if (n_in != 26 || in_sizes[0] != NTOK * DM || out_size != NTOK * DM || ws_size < WS_END) {
            fprintf(stderr, "kernel_launch: unexpected shapes / workspace (n_in %d, ws %zu, need %zu); nothing launched\n", n_in, ws_size, (size_t)WS_END); grid = -1; return; }
        int dev = 0, cus = 0, per_cu = 0;
        if (hipGetDevice(&dev) != hipSuccess || hipDeviceGetAttribute(&cus, hipDeviceAttributeMultiprocessorCount, dev) != hipSuccess) { grid = -1; return; }
        if (hipFuncSetAttribute((const void*)fwd, hipFuncAttributeMaxDynamicSharedMemorySize, LDS_BYTES) != hipSuccess) { fprintf(stderr, "kernel_launch: hipFuncSetAttribute failed\n"); grid = -1; return; }
        if (hipOccupancyMaxActiveBlocksPerMultiprocessor(&per_cu, (const void*)fwd, 512, LDS_BYTES) != hipSuccess || per_cu < 1) { fprintf(stderr, "kernel_launch: occupancy query says %d\n", per_cu); }
        (void)hipGetLastError();
        grid = cus;
    }
    if (grid < 0) return;
    if (hipMemsetAsync((char*)d_ws + WS_CTL, 0, CTL_ZERO_BYTES, stream) != hipSuccess) return;
    Args a{};
    for (int i = 0; i < 26; ++i) a.in[i] = (const float*)d_in[i];
    a.out = (float*)d_out; a.ws = (unsigned char*)d_ws;
#if MK_N_LAUNCHES == 1
    a.ph_lo = 0; a.ph_hi = N_PHASES;
    hipLaunchKernelGGL(fwd, dim3(grid), dim3(512), LDS_BYTES, stream, a);
#else
    for (int p = 0; p < N_PHASES; ++p) { a.ph_lo = p; a.ph_hi = p + 1; hipLaunchKernelGGL(fwd, dim3(grid), dim3(512), LDS_BYTES, stream, a); }
#endif
}
```

```cpp
#include <hip/hip_runtime.h>
#include <cstdio>
#include <cstdint>

#define GAS __attribute__((address_space(1)))
#define LAS __attribute__((address_space(3)))
typedef unsigned short bf16;
typedef unsigned v4u __attribute__((ext_vector_type(4)));
typedef unsigned v2u __attribute__((ext_vector_type(2)));
typedef float f32x2 __attribute__((ext_vector_type(2)));
typedef float f32x4 __attribute__((ext_vector_type(4)));
typedef float f32x16 __attribute__((ext_vector_type(16)));
typedef short bf16x8 __attribute__((ext_vector_type(8)));
typedef short s16x4 __attribute__((ext_vector_type(4)));
typedef __bf16 bf16x2_t __attribute__((ext_vector_type(2)));

constexpr int NB = 8, SEQ = 4096, DM = 1024, NTOK = NB * SEQ;
constexpr int NPROJ = 5120;
constexpr int NEXP = 32, TOPK = 4;
constexpr float LOG2E = 1.4426950408889634f;
constexpr float QSCALE = 0.125f * 1.4426950408889634f;
constexpr float RMS_EPS = 1e-6f;
constexpr float NEGBIG = -1e30f;

__device__ __forceinline__ unsigned pk2(float lo, float hi) { f32x2 v = {lo, hi}; bf16x2_t b = __builtin_convertvector(v, bf16x2_t); return __builtin_bit_cast(unsigned, b); }
__device__ __forceinline__ float bf_lo(unsigned u) { return __builtin_bit_cast(float, u << 16); }
__device__ __forceinline__ float bf_hi(unsigned u) { return __builtin_bit_cast(float, u & 0xffff0000u); }
__device__ __forceinline__ float wave_sum(float v) {
#pragma unroll
    for (int o = 1; o < 64; o <<= 1) v += __shfl_xor(v, o);
    return v;
}
__device__ __forceinline__ float sigmoidf_(float x) { return 1.f / (1.f + __expf(-x)); }
#define LDS_WAIT() asm volatile("s_waitcnt lgkmcnt(0)" ::: "memory")
#define VM_WAIT() asm volatile("s_waitcnt vmcnt(0)" ::: "memory")

namespace pg8 {
#define PG8_LAS __attribute__((address_space(3)))
typedef unsigned short bf16_t;
typedef unsigned u32x4 __attribute__((ext_vector_type(4)));
constexpr int BM = 256, BK = 64, HALF = 128, HTB = HALF * BK * 2  , STAGE_BYTES = 8 * HTB, NXCD = 8, WGM = 8;

__host__ __device__ __forceinline__ int lds_byte(int r, int c) { const int st = (r >> 4) * 2 + (c >> 5), rr = r & 15, cc = c & 31, ob = rr * 64 + cc * 2; return st * 1024 + (ob ^ (((ob >> 9) & 1) << 5)); }
__host__ __device__ __forceinline__ void stage_rc(int b, int& R, int& C) { const int st = b / 1024, sb = b % 1024, swz = sb ^ (((sb >> 9) & 1) << 5); R = (st >> 1) * 16 + swz / 64; C = (st & 1) * 32 + (swz % 64) / 2; }
__host__ __device__ __forceinline__ int perm32(int rho) { const int n = rho >> 4, i = rho & 15; return 8 * (i >> 2) + 4 * n + (i & 3); }

struct Unit { int pm, pn, e, rt; };
struct Gemm { const bf16_t* A; const bf16_t* Bt; int K; };

struct StaticOrder {
    int nM, nN, nwg, G, c, lda2;
    __device__ void init(int M, int N, int G_, int c_, int lda_elems) { nM = M / BM; nN = N / BM; nwg = nM * nN; G = G_; c = c_; lda2 = lda_elems * 2; }
    __device__ bool next(int i, Unit& u) const {
        const long L = (long)i * G + c; if (L >= nwg) return false;
        int wgid = (int)L; { const int q = nwg / NXCD, r = nwg % NXCD, xcd = wgid % NXCD, off = wgid / NXCD; wgid = (xcd < r ? xcd * (q + 1) : r * (q + 1) + (xcd - r) * q) + off; }
        const int nig = WGM * nN, gid = wgid / nig, fm = gid * WGM, gsz = (nM - fm) < WGM ? (nM - fm) : WGM;
        u.pm = fm + ((wgid % nig) % gsz); u.pn = (wgid % nig) / gsz; u.e = 0; u.rt = 0; return true;
    }
    __device__ __forceinline__ unsigned a_off(const Unit& u, int r) const { return (unsigned)(u.pm * BM + r) * (unsigned)lda2; }
};

template <class Epi, class Sched, bool ALIGN_EPI = true>
__device__ __forceinline__ void gemm_phase(PG8_LAS unsigned char* lds, const Gemm g, const Sched& S, const Epi& E) {
    const int tid = threadIdx.x, wid = __builtin_amdgcn_readfirstlane(tid >> 6), lane = tid & 63, wr = wid >> 2, wc = wid & 3, fr = lane & 15, fq = lane >> 4;
    const int K = g.K, nt = K / BK;
    int RA[2], CA2[2]; unsigned voffB[2];
#pragma unroll
    for (int i = 0; i < 2; ++i) { int R, C; stage_rc(tid * 16 + i * 8192, R, C); const int Rb = (R & ~31) + perm32(R & 31);
        RA[i] = R; CA2[i] = C * 2; voffB[i] = (unsigned)(Rb * K + C) * 2u; }
    const size_t kstep = (size_t)(BK * 2);
    const size_t hstep = (size_t)HALF * K * 2;
    const size_t tstep = 2 * hstep;
    const unsigned ldsw = (unsigned)wid * 1024u;
    const int aoff = lds_byte(wr * 64 + fr, fq * 8), boff = lds_byte(wc * 32 + fr, fq * 8);
#define PG8_SA(b, h) (((b) * 2 + (h)) * HTB)
#define PG8_SB(b, h) ((4 + (b) * 2 + (h)) * HTB)
#define PG8_STAGE(bufoff, gbase, voff) do { _Pragma("unroll") for (int _i = 0; _i < 2; ++_i) \
        __builtin_amdgcn_global_load_lds((const unsigned*)((const char*)(gbase) + (voff)[_i]), (PG8_LAS unsigned*)(lds + (bufoff) + ldsw + _i * 8192), 16, 0, 0); } while (0)
#define PG8_LDA(dst, b, h) do { _Pragma("unroll") for (int m = 0; m < 4; ++m) _Pragma("unroll") for (int k = 0; k < 2; ++k) dst[m][k] = *(const PG8_LAS bf16x8*)(lds + PG8_SA(b, h) + aoff + m * 2048 + k * 1024); } while (0)
#define PG8_LDB(dst, b, h) do { _Pragma("unroll") for (int n = 0; n < 2; ++n) _Pragma("unroll") for (int k = 0; k < 2; ++k) dst[n][k] = *(const PG8_LAS bf16x8*)(lds + PG8_SB(b, h) + boff + n * 2048 + k * 1024); } while (0)
#define PG8_MMA(ai, bj, At, Bt) do { __builtin_amdgcn_s_setprio(1); _Pragma("unroll") for (int m = 0; m < 4; ++m) _Pragma("unroll") for (int n = 0; n < 2; ++n) _Pragma("unroll") for (int k = 0; k < 2; ++k) \
        acc[ai][bj][m][n] = __builtin_amdgcn_mfma_f32_16x16x32_bf16(Bt[n][k], At[m][k], acc[ai][bj][m][n], 0, 0, 0); __builtin_amdgcn_s_setprio(0); } while (0)
#define PG8_WAIT_V(n) asm volatile("s_waitcnt vmcnt(" #n ")" ::: "memory")
#define PG8_WAIT_L(n) asm volatile("s_waitcnt lgkmcnt(" #n ")" ::: "memory")
#define PG8_BAR __builtin_amdgcn_s_barrier()
#define PG8_SCHED __builtin_amdgcn_sched_barrier(0)
    Unit cur, nxt; int ui = 0;
    if (!S.next(0, cur)) return;
    f32x4 acc[2][2][4][2];
#pragma unroll
    for (int a = 0; a < 2; ++a)
#pragma unroll
        for (int b = 0; b < 2; ++b)
#pragma unroll
            for (int m = 0; m < 4; ++m)
#pragma unroll
                for (int n = 0; n < 2; ++n) acc[a][b][m][n] = (f32x4){0.f, 0.f, 0.f, 0.f};
    bf16x8 At[4][2], B0[2][2], B1[2][2];
    const char* gA = (const char*)g.A;
    unsigned oc0[2], oc1[2], on0[2], on1[2];
#pragma unroll
    for (int i = 0; i < 2; ++i) { oc0[i] = S.a_off(cur, RA[i]) + CA2[i]; oc1[i] = S.a_off(cur, HALF + RA[i]) + CA2[i]; }
    const char* cB = (const char*)g.Bt + (size_t)cur.pn * tstep;
    PG8_STAGE(PG8_SB(0, 0), cB, voffB); PG8_STAGE(PG8_SB(0, 1), cB + hstep, voffB); PG8_STAGE(PG8_SA(0, 0), gA, oc0); PG8_STAGE(PG8_SA(0, 1), gA, oc1);
    if (wr == 1) PG8_BAR;
    PG8_WAIT_V(2); PG8_BAR;
    PG8_STAGE(PG8_SB(1, 0), cB + kstep, voffB); PG8_STAGE(PG8_SA(1, 0), gA + kstep, oc0); PG8_STAGE(PG8_SB(1, 1), cB + hstep + kstep, voffB);
    PG8_WAIT_V(6); PG8_BAR;
    for (;;) {
        const bool has_next = S.next(ui + 1, nxt);
        if (has_next) {
#pragma unroll
            for (int i = 0; i < 2; ++i) { on0[i] = S.a_off(nxt, RA[i]) + CA2[i]; on1[i] = S.a_off(nxt, HALF + RA[i]) + CA2[i]; }
        } else {
#pragma unroll
            for (int i = 0; i < 2; ++i) { on0[i] = oc0[i]; on1[i] = oc1[i]; }
        }
        const char* nB = has_next ? (const char*)g.Bt + (size_t)nxt.pn * tstep : cB;
        for (int t = 0; t < nt; t += 2) {
            const bool last = (t == nt - 2);
            const char* a1 = gA + (size_t)(t + 1) * kstep;
            const char* a2 = last ? gA : gA + (size_t)(t + 2) * kstep; const char* b2 = last ? nB : cB + (size_t)(t + 2) * kstep;
            const char* a3 = a2 + kstep; const char* b3 = b2 + kstep;
            unsigned s0[2], s1[2];
#pragma unroll
            for (int i = 0; i < 2; ++i) { s0[i] = last ? on0[i] : oc0[i]; s1[i] = last ? on1[i] : oc1[i]; }
            PG8_LDB(B0, 0, 0); PG8_LDB(B1, 0, 1); PG8_SCHED; PG8_LDA(At, 0, 0); PG8_STAGE(PG8_SA(1, 1), a1, oc1);
            PG8_WAIT_V(8); PG8_WAIT_L(0); PG8_BAR; PG8_MMA(0, 0, At, B0); PG8_MMA(0, 1, At, B1); PG8_BAR; PG8_SCHED;
            PG8_LDA(At, 0, 1); PG8_STAGE(PG8_SB(0, 0), b2, voffB); PG8_STAGE(PG8_SB(0, 1), b2 + hstep, voffB); PG8_STAGE(PG8_SA(0, 0), a2, s0);
            PG8_WAIT_V(8); PG8_WAIT_L(0); PG8_BAR; PG8_MMA(1, 0, At, B0); PG8_MMA(1, 1, At, B1); PG8_BAR; PG8_SCHED;
            PG8_LDB(B0, 1, 0); PG8_LDB(B1, 1, 1); PG8_SCHED; PG8_LDA(At, 1, 0); PG8_STAGE(PG8_SA(0, 1), a2, s1);
            PG8_WAIT_V(8); PG8_WAIT_L(0); PG8_BAR; PG8_MMA(0, 0, At, B0); PG8_MMA(0, 1, At, B1); PG8_BAR; PG8_SCHED;
            PG8_LDA(At, 1, 1); PG8_STAGE(PG8_SB(1, 0), b3, voffB); PG8_STAGE(PG8_SB(1, 1), b3 + hstep, voffB); PG8_STAGE(PG8_SA(1, 0), a3, s0);
            PG8_WAIT_V(8); PG8_WAIT_L(0); PG8_BAR; PG8_MMA(1, 0, At, B0); PG8_MMA(1, 1, At, B1); PG8_BAR; PG8_SCHED;
        }
        if constexpr (ALIGN_EPI) { if (wr == 0) PG8_BAR; }
        E(acc, cur, wr, wc, fr, fq);
        if (!has_next) break;
#pragma unroll
        for (int a = 0; a < 2; ++a)
#pragma unroll
            for (int b = 0; b < 2; ++b)
#pragma unroll
                for (int m = 0; m < 4; ++m)
#pragma unroll
                    for (int n = 0; n < 2; ++n) acc[a][b][m][n] = (f32x4){0.f, 0.f, 0.f, 0.f};
        cur = nxt; cB = nB; ++ui;
#pragma unroll
        for (int i = 0; i < 2; ++i) { oc0[i] = on0[i]; oc1[i] = on1[i]; }
        if constexpr (ALIGN_EPI) { if (wr == 1) PG8_BAR; }
    }
    PG8_WAIT_V(0);
    if constexpr (!ALIGN_EPI) { if (wr == 0) PG8_BAR; }
    PG8_BAR;
#undef PG8_SA
#undef PG8_SB
#undef PG8_STAGE
#undef PG8_LDA
#undef PG8_LDB
#undef PG8_MMA
#undef PG8_WAIT_V
#undef PG8_WAIT_L
#undef PG8_BAR
#undef PG8_SCHED
}
}

#define XB_TMO      128
#define XB_XCNT(j)  (256  + 64 * (j))
#define XB_XSUB(j)  (1280 + 64 * (j))
#define XB_XGEN(j)  (2304 + 64 * (j))
#define XB_TOP      3328
#define XB_TOPGEN   3392
#define XCD_BAR_WORDS 3456
#define XB_SPIN_CAP (1u << 18)

__device__ __forceinline__ unsigned xb_ld(unsigned* p)              { return __hip_atomic_load(p, __ATOMIC_RELAXED, __HIP_MEMORY_SCOPE_AGENT); }
__device__ __forceinline__ unsigned xb_add(unsigned* p, unsigned v) { return __hip_atomic_fetch_add(p, v, __ATOMIC_RELAXED, __HIP_MEMORY_SCOPE_AGENT); }
__device__ __forceinline__ unsigned xb_xcc_id() { return (unsigned)__builtin_amdgcn_s_getreg((3 << 11) | 20) & 0xFu; }
#define XB_SPIN(cond, bar) do { unsigned _sp = 0; while (cond) { __builtin_amdgcn_s_sleep(1); \
    if ((++_sp & 255u) == 0u) { if (xb_ld(&(bar)[XB_TMO])) break; if (_sp > XB_SPIN_CAP) { atomicAdd(&(bar)[XB_TMO], 1u); break; } } } } while (0)

struct XcdBarrier {
    unsigned* bar; unsigned x;
    volatile LAS unsigned* st;
};

__device__ __forceinline__ XcdBarrier xcd_barrier_post(unsigned* bar, volatile LAS unsigned* st) {
    XcdBarrier b; b.bar = bar; b.x = xb_xcc_id(); b.st = st;
    if (threadIdx.x == 0) (void)xb_add(&bar[XB_XCNT(b.x)], 1u);
    return b;
}
__device__ __forceinline__ void xcd_barrier_complete(unsigned* bar, unsigned x, unsigned& nloc, unsigned& nx) {
    const unsigned G = gridDim.x * gridDim.y * gridDim.z;
    unsigned sum, cnt, mine, sp = 0u;
    for (;;) {
        sum = 0u; cnt = 0u; mine = 0u;
#pragma unroll
        for (unsigned j = 0; j < 16; ++j) { const unsigned c = xb_ld(&bar[XB_XCNT(j)]); sum += c; cnt += (c > 0u) ? 1u : 0u; mine = (j == x) ? c : mine; }
        if (sum == G) break;
        __builtin_amdgcn_s_sleep(1);
        if ((++sp & 255u) == 0u) { if (xb_ld(&bar[XB_TMO])) break; if (sp > XB_SPIN_CAP) { atomicAdd(&bar[XB_TMO], 1u); break; } }
    }
    nloc = mine > 0u ? mine : 1u; nx = cnt > 0u ? cnt : 1u;
}

__device__ __forceinline__ void xcd_barrier(const XcdBarrier& b) {
    asm volatile("s_waitcnt vmcnt(0)" ::: "memory");
    __syncthreads();
    if (threadIdx.x == 0) {
        unsigned* bar = b.bar;
        __builtin_amdgcn_s_waitcnt(0);
        unsigned nloc = b.st[0], nx = b.st[1];
        if (nloc == 0u) { xcd_barrier_complete(bar, b.x, nloc, nx); b.st[0] = nloc; b.st[1] = nx; }
        const unsigned old = xb_add(&bar[XB_XSUB(b.x)], 1u);
        const unsigned gen = old / nloc;
        if (old + 1u == (gen + 1u) * nloc) {
            __builtin_amdgcn_fence(__ATOMIC_RELEASE, "agent");
            asm volatile("s_waitcnt vmcnt(0)" ::: "memory");
            const unsigned og = xb_add(&bar[XB_TOP], 1u);
            const unsigned tg = og / nx;
            if (og + 1u == (tg + 1u) * nx) xb_add(&bar[XB_TOPGEN], 1u);
            else XB_SPIN(xb_ld(&bar[XB_TOPGEN]) == tg, bar);
            __builtin_amdgcn_fence(__ATOMIC_ACQUIRE, "agent");
            xb_add(&bar[XB_XGEN(b.x)], 1u);
            asm volatile("s_waitcnt vmcnt(0)" ::: "memory");
        } else {
            XB_SPIN(xb_ld(&bar[XB_XGEN(b.x)]) == gen, bar);
            __builtin_amdgcn_fence(__ATOMIC_ACQUIRE, "agent");
            asm volatile("s_waitcnt vmcnt(0)" ::: "memory");
        }
    }
    __syncthreads();
}

constexpr size_t MiB = 1u << 20;
constexpr size_t WS_CTL = 0, CTL_ZERO_BYTES = 1 * MiB;
constexpr size_t WS_ADAP = 1 * MiB;
constexpr size_t WS_ADA = 4 * MiB;
constexpr size_t WS_CB = 4 * MiB + 512 * 1024;
constexpr size_t WS_LOGF = 5 * MiB;
constexpr size_t WS_GATES = 6 * MiB;
constexpr size_t WS_KBIAS = 9 * MiB;
constexpr size_t WS_KC = 10 * MiB, WS_VC = 10 * MiB + 512 * 1024;
constexpr size_t WS_WRT = 11 * MiB;
constexpr size_t WS_WCK = 11 * MiB + 256 * 1024, WS_WCV = 11 * MiB + 512 * 1024;
constexpr size_t WS_TOPE = 12 * MiB, WS_TOPW = 12 * MiB + 512 * 1024, WS_RANK = 13 * MiB;
constexpr size_t WS_TOKOF = 14 * MiB;
constexpr size_t WS_WFOX = 18 * MiB, WS_WNSA = 19 * MiB, WS_WMIX = 20 * MiB, WS_WIN = 22 * MiB;
constexpr size_t WS_WD = 32 * MiB;
constexpr size_t WS_WGU = 96 * MiB;
constexpr size_t WS_YSHI = 96 * MiB;
constexpr size_t WS_FQ = 224 * MiB, WS_FK = 256 * MiB, WS_FV = 288 * MiB, WS_NQ = 320 * MiB;
constexpr size_t WS_KV6 = 352 * MiB;
constexpr size_t WS_SGF = 400 * MiB, WS_SGN = 464 * MiB;
constexpr size_t WS_MIXED = 224 * MiB;
constexpr size_t WS_GATED = 288 * MiB;
constexpr size_t WS_ACT = 288 * MiB;
constexpr size_t WS_END = 544 * MiB;
constexpr size_t OUT_H = 0, OUT_OFOX = 64 * MiB, OUT_ONSA = 96 * MiB, OUT_H2 = 0;
constexpr size_t KV6_STRIDE = (size_t)NTOK * 128;

constexpr int CW_TMO = 0;
constexpr int CW_BAR = 4096;
constexpr int CW_ECNT = 32768;

constexpr int RING_BYTES = 131072;
constexpr int MISC_OFF = 131072;
constexpr int TAB_OFF = 131072 + 256;
constexpr int LDS_BYTES = 147456;

__device__ const unsigned char T5_BUCKET[128] = {
 0,1,2,3,4,5,6,7,8,9,10,11,12,13,14,15,16,16,16,17,17,18,18,18,19,19,19,20,20,20,20,21,21,21,21,22,22,22,22,22,23,23,23,23,23,23,24,24,24,24,24,24,25,25,25,25,25,25,25,26,26,26,26,26,26,26,26,
 27,27,27,27,27,27,27,27,27,27,28,28,28,28,28,28,28,28,28,28,29,29,29,29,29,29,29,29,29,29,29,29,30,30,30,30,30,30,30,30,30,30,30,30,30,30,31,31,31,31,31,31,31,31,31,31,31,31,31,31,31};

struct Args { const float* in[26]; float* out; unsigned char* ws; int ph_lo, ph_hi; };
struct Ctx {
    float* out; unsigned char* ws;
    LAS unsigned char* lds; int tid, lane, wave, vcu, G;
};

__device__ __forceinline__ void conv64(const float* __restrict__ W, size_t ldw, int col, int k0, bf16* __restrict__ dst) {
#pragma unroll
    for (int h = 0; h < 2; ++h) {
        float v[32];
#pragma unroll
        for (int kk = 0; kk < 32; ++kk) v[kk] = W[(size_t)(k0 + h * 32 + kk) * ldw + col];
#pragma unroll
        for (int q = 0; q < 4; ++q) { v4u o; o.x = pk2(v[8 * q], v[8 * q + 1]); o.y = pk2(v[8 * q + 2], v[8 * q + 3]); o.z = pk2(v[8 * q + 4], v[8 * q + 5]); o.w = pk2(v[8 * q + 6], v[8 * q + 7]);
            *(v4u*)(dst + h * 32 + q * 8) = o; }
    }
}
__device__ __forceinline__ void conv_item(const float* W, size_t ldw, int col0, int ncb, bf16* WT, int Kd, int dst_row0, int r, int lane) {
    const int cbk = r % ncb, kb = r / ncb;
    conv64(W, ldw, col0 + cbk * 64 + lane, kb * 64, WT + (size_t)(dst_row0 + cbk * 64 + lane) * Kd + kb * 64);
}

__device__ __forceinline__ void phase0a(const Args& A, const Ctx& X) {
    const float* c = A.in[1]; const float* w_ada = A.in[2]; const float* w_in = A.in[6];
    LAS float* sl = (LAS float*)X.lds;
    for (int i = X.tid; i < 8192; i += 512) { const float v = c[i]; sl[i] = v / (1.f + __expf(-v)); }
    __syncthreads();
    const int gw = X.vcu * 8 + X.wave, NGW = X.G * 8, lane = X.lane;
    unsigned char* ws = X.ws;
    bf16* WIN = (bf16*)(ws + WS_WIN);
    constexpr int J_ADA = 96 * 16, J_INA = 24 * 16, J_INB = 20 * 16, J_INC = 32 * 16, J_IND = 256, J_FOX = 16 * 8, J_NSA = 16 * 8, J_MIX = 16 * 16, J_CK = 32, J_CV = 32, J_RT = 32, J_CB = 128;
    constexpr int J_EXP = 32 * 256;
    constexpr int NITEMS = J_ADA + J_INA + J_INB + J_INC + J_IND + J_FOX + J_NSA + J_MIX + J_CK + J_CV + J_RT + J_CB + 3 * J_EXP;
    for (int it = gw; it < NITEMS; it += NGW) {
        int r = it;
        if (r < J_ADA) {
            const int cb = r % 96, ks = r / 96, j = cb * 64 + lane; float acc[8];
#pragma unroll
            for (int b = 0; b < 8; ++b) acc[b] = 0.f;
#pragma unroll 8
            for (int kk = 0; kk < 64; ++kk) { const int k = ks * 64 + kk; const float w = w_ada[(size_t)k * 6144 + j];
#pragma unroll
                for (int b = 0; b < 8; ++b) acc[b] += sl[b * 1024 + k] * w; }
            float* P = (float*)(ws + WS_ADAP);
#pragma unroll
            for (int b = 0; b < 8; ++b) P[(size_t)(ks * 8 + b) * 6144 + j] = acc[b];
            continue; }
        r -= J_ADA;
        if (r < J_INA) { conv_item(w_in, 4896, 0, 24, WIN, 1024, 0, r, lane); continue; } r -= J_INA;
        if (r < J_INB) { conv_item(w_in, 4896, 1544, 20, WIN, 1024, 1536, r, lane); continue; } r -= J_INB;
        if (r < J_INC) { conv_item(w_in, 4896, 2848, 32, WIN, 1024, 2816, r, lane); continue; } r -= J_INC;
        if (r < J_IND) {
            const int row = 4864 + r; const int col = (row < 4872) ? 1536 + (row - 4864) : (row < 4896 ? 2824 + (row - 4872) : -1);
            float v[16];
#pragma unroll
            for (int i = 0; i < 16; ++i) v[i] = (col >= 0) ? w_in[(size_t)(lane * 16 + i) * 4896 + col] : 0.f;
            v4u o0, o1; o0.x = pk2(v[0], v[1]); o0.y = pk2(v[2], v[3]); o0.z = pk2(v[4], v[5]); o0.w = pk2(v[6], v[7]); o1.x = pk2(v[8], v[9]); o1.y = pk2(v[10], v[11]); o1.z = pk2(v[12], v[13]); o1.w = pk2(v[14], v[15]);
            *(v4u*)(WIN + (size_t)row * 1024 + lane * 16) = o0; *(v4u*)(WIN + (size_t)row * 1024 + lane * 16 + 8) = o1;
            continue; }
        r -= J_IND;
        if (r < J_FOX) { conv_item(A.in[12], 1024, 0, 16, (bf16*)(ws + WS_WFOX), 512, 0, r, lane); continue; } r -= J_FOX;
        if (r < J_NSA) { conv_item(A.in[13], 1024, 0, 16, (bf16*)(ws + WS_WNSA), 512, 0, r, lane); continue; } r -= J_NSA;
        if (r < J_MIX) { conv_item(A.in[14], 1024, 0, 16, (bf16*)(ws + WS_WMIX), 1024, 0, r, lane); continue; } r -= J_MIX;
        if (r < J_CK) { conv_item(A.in[10], 64, 0, 1, (bf16*)(ws + WS_WCK), 2048, 0, r, lane); continue; } r -= J_CK;
        if (r < J_CV) { conv_item(A.in[11], 64, 0, 1, (bf16*)(ws + WS_WCV), 2048, 0, r, lane); continue; } r -= J_CV;
        if (r < J_RT) { const float* wr_ = A.in[18]; float* WRT = (float*)(ws + WS_WRT);
#pragma unroll
            for (int i = 0; i < 16; ++i) { const int k = lane + 64 * i; WRT[r * 1024 + k] = wr_[k * 32 + r]; }
            continue; }
        r -= J_RT;
        if (r < J_CB) { const int which = r >> 6, j = r & 63; const float* pe = A.in[8 + which]; const float* wc = A.in[10 + which]; float s = 0.f;
#pragma unroll 8
            for (int i = 0; i < 32; ++i) { const int q = lane * 32 + i; s += pe[q] * wc[q * 64 + j]; }
            s = wave_sum(s); if (lane == 0) ((float*)(ws + WS_CB))[which * 64 + j] = s;
            continue; }
        r -= J_CB;
        if (r < 2 * J_EXP) {
            const int kind = r / J_EXP, q = r % J_EXP, e = q >> 8, rr = q & 255, cbk = rr & 15, kb = rr >> 4;
            const float* W = A.in[kind ? 22 : 20] + (size_t)e * 1048576;
            const int drow = e * 2048 + (cbk >> 1) * 256 + (cbk & 1) * 64 + kind * 128 + lane;
            conv64(W, 1024, cbk * 64 + lane, kb * 64, (bf16*)(ws + WS_WGU) + (size_t)drow * 1024 + kb * 64);
            continue; }
        r -= 2 * J_EXP;
        { const int e = r >> 8, rr = r & 255, cbk = rr & 15, kb = rr >> 4;
          conv64(A.in[24] + (size_t)e * 1048576, 1024, cbk * 64 + lane, kb * 64, (bf16*)(ws + WS_WD) + (size_t)(e * 1024 + cbk * 64 + lane) * 1024 + kb * 64); }
    }
}

__device__ __forceinline__ void phase0b(const Args& A, const Ctx& X) {
    const float* P = (const float*)(X.ws + WS_ADAP); const float* b_ada = A.in[3];
    float* ADA = (float*)(X.ws + WS_ADA);
    for (int gid = blockIdx.x * 512 + X.tid; gid < 8 * 6144; gid += X.G * 512) {
        const int b = gid / 6144, col = gid % 6144; float s = b_ada[col];
#pragma unroll
        for (int ks = 0; ks < 16; ++ks) s += P[(size_t)(ks * 8 + b) * 6144 + col];
        ADA[gid] = s;
    }
    LAS float* gs = (LAS float*)X.lds;
    LAS float* sh = gs + 1024;
    const float* x = A.in[0]; const float* g = A.in[4];
    bf16* H = (bf16*)((unsigned char*)X.out + OUT_H);
    for (int ch = blockIdx.x; ch < NTOK / 128; ch += X.G) {
        const int row0 = ch * 128, b = row0 / SEQ;
        __syncthreads();
        for (int j = X.tid; j < 2048; j += 512) { float s = b_ada[j];
#pragma unroll
            for (int ks = 0; ks < 16; ++ks) s += P[(size_t)(ks * 8 + b) * 6144 + j];
            if (j < 1024) sh[j] = s; else gs[j - 1024] = g[j - 1024] * (1.f + s); }
        __syncthreads();
        for (int i = 0; i < 16; ++i) {
            const int row = row0 + X.wave + 8 * i;
            const f32x4* xr = (const f32x4*)(x + (size_t)row * DM) + X.lane;
            f32x4 v[4]; float ss = 0.f;
#pragma unroll
            for (int j = 0; j < 4; ++j) { v[j] = xr[64 * j]; ss += (v[j].x * v[j].x + v[j].y * v[j].y) + (v[j].z * v[j].z + v[j].w * v[j].w); }
            const float rstd = 1.f / sqrtf(wave_sum(ss) * (1.f / DM) + RMS_EPS);
            v2u* o8 = (v2u*)(H + (size_t)row * DM) + X.lane;
#pragma unroll
            for (int j = 0; j < 4; ++j) { const int k = 4 * X.lane + 256 * j; const f32x4 gg = *(LAS f32x4*)(gs + k), ss4 = *(LAS f32x4*)(sh + k);
                v2u o; o.x = pk2(v[j].x * rstd * gg.x + ss4.x, v[j].y * rstd * gg.y + ss4.y); o.y = pk2(v[j].z * rstd * gg.z + ss4.z, v[j].w * rstd * gg.w + ss4.w); o8[64 * j] = o; }
        }
    }
}

__device__ __forceinline__ void phase2(const Args& A, const Ctx& X) {
    const int lane = X.lane, wid = X.wave, r32 = lane & 31, hi = lane >> 5;
    LAS float* red = (LAS float*)X.lds;
    for (int it = blockIdx.x; it < 256; it += X.G) {
        const int cblk = it & 7, which = (it >> 3) & 1, bg = it >> 4;
        const bf16* src = (const bf16*)(X.ws + WS_KV6) + (size_t)which * KV6_STRIDE + (size_t)bg * SEQ * 64;
        const bf16* WT = (const bf16*)(X.ws + (which ? WS_WCV : WS_WCK));
        const int c0 = cblk * 32, kbase = wid * 256;
        f32x16 acc0 = {}, acc1 = {};
        const bf16* ap = src + (size_t)(16 * (c0 + r32)) * 64 + kbase + hi * 8;
        const bf16* bp0 = WT + (size_t)r32 * 2048 + kbase + hi * 8;
        const bf16* bp1 = WT + (size_t)(32 + r32) * 2048 + kbase + hi * 8;
#pragma unroll
        for (int kk = 0; kk < 16; ++kk) {
            const bf16x8 a = *(const bf16x8*)(ap + kk * 16), b0 = *(const bf16x8*)(bp0 + kk * 16), b1 = *(const bf16x8*)(bp1 + kk * 16);
            acc0 = __builtin_amdgcn_mfma_f32_32x32x16_bf16(a, b0, acc0, 0, 0, 0);
            acc1 = __builtin_amdgcn_mfma_f32_32x32x16_bf16(a, b1, acc1, 0, 0, 0);
        }
        __syncthreads();
#pragma unroll
        for (int r = 0; r < 16; ++r) { const int row = (r & 3) + 8 * (r >> 2) + 4 * hi; red[(wid * 32 + row) * 64 + r32] = acc0[r]; red[(wid * 32 + row) * 64 + 32 + r32] = acc1[r]; }
        __syncthreads();
        { const int c = X.tid >> 4, n4 = (X.tid & 15) * 4; f32x4 s = *(const f32x4*)((const float*)(X.ws + WS_CB) + which * 64 + n4);
#pragma unroll
          for (int w = 0; w < 8; ++w) s += *(LAS f32x4*)(red + (w * 32 + c) * 64 + n4);
          if (c0 + c == 255) s = (f32x4){0.f, 0.f, 0.f, 0.f};
          v2u o; o.x = pk2(s.x, s.y); o.y = pk2(s.z, s.w);
          *(v2u*)((bf16*)(X.ws + (which ? WS_VC : WS_KC)) + ((size_t)bg * 256 + c0 + c) * 64 + n4) = o; }
    }
    for (int sq = blockIdx.x * 8 + wid; sq < 64; sq += X.G * 8) {
        const int b = sq >> 3, h = sq & 7; const float* lf = (const float*)(X.ws + WS_LOGF) + (size_t)b * SEQ * 8 + h;
        float run = 0.f;
        for (int i = 0; i < 64; ++i) run += lf[(size_t)(lane * 64 + i) * 8];
        float incl = run;
#pragma unroll
        for (int o = 1; o < 64; o <<= 1) { const float t = __shfl_up(incl, o); if (lane >= o) incl += t; }
        float pre = incl - run; float* kb = (float*)(X.ws + WS_KBIAS) + (size_t)sq * SEQ + lane * 64;
        for (int i = 0; i < 64; ++i) { pre += lf[(size_t)(lane * 64 + i) * 8]; kb[i] = -pre * LOG2E; }
    }
}

__device__ __forceinline__ v4u pack8(const f32x4 a, const f32x4 b) { v4u w; w.x = pk2(a[0], a[1]); w.y = pk2(a[2], a[3]); w.z = pk2(b[0], b[1]); w.w = pk2(b[2], b[3]); return w; }

struct EpiInProj {
    unsigned char* ws; const float* b_forget;
    __device__ __forceinline__ void operator()(const f32x4 (&acc)[2][2][4][2], const pg8::Unit& u, int wr, int wc, int fr, int fq) const {
        part<0>(acc, u, wr, wc, fr, fq); part<1>(acc, u, wr, wc, fr, fq);
    }
    template <int bj> __device__ __forceinline__ void part(const f32x4 (&acc)[2][2][4][2], const pg8::Unit& u, int wr, int wc, int fr, int fq) const {
        const int row0 = u.pm * 256 + wr * 64 + fr, b = (u.pm * 256) >> 12;
        {
            const int cb = u.pn * 256 + bj * 128 + wc * 32;
            if (cb >= 4896) return;
            if (cb < 4864) {
                bf16* base; int pitch; float scl = 1.f; bool sig = false;
                if (cb < 2048) { const int tt = cb >> 9, head = (cb & 511) >> 6; if (tt == 0 || tt == 3) scl = QSCALE; pitch = 64;
                    base = (bf16*)(ws + WS_FQ) + (size_t)tt * ((size_t)NTOK * 512) + ((size_t)(b * 7 + head) * SEQ) * 64 + (cb & 63) + 8 * fq; }
                else if (cb < 2816) { const int q = cb - 2048, idx6 = q >> 7, grp = (q & 127) >> 6; pitch = 64;
                    base = (bf16*)(ws + WS_KV6) + (size_t)idx6 * KV6_STRIDE + ((size_t)(b + grp) * SEQ) * 64 + (cb & 63) + 8 * fq; }
                else { const int q = cb - 2816, which = q >> 10; pitch = 1024; sig = true; base = (bf16*)(ws + (which ? WS_SGN : WS_SGF)) + (q & 1023) + 8 * fq; }
#pragma unroll
                for (int ai = 0; ai < 2; ++ai)
#pragma unroll
                    for (int m = 0; m < 4; ++m) {
                        const int row = row0 + ai * 128 + m * 16;
                        f32x4 v0 = acc[ai][bj][m][0], v1 = acc[ai][bj][m][1];
                        if (sig) {
#pragma unroll
                            for (int i = 0; i < 4; ++i) { v0[i] = sigmoidf_(v0[i]); v1[i] = sigmoidf_(v1[i]); }
                        } else { v0 = v0 * scl; v1 = v1 * scl; }
                        *(v4u*)(base + (size_t)row * pitch) = pack8(v0, v1);
                    }
            } else {
#pragma unroll
                for (int ai = 0; ai < 2; ++ai)
#pragma unroll
                    for (int m = 0; m < 4; ++m) {
                        const int row = row0 + ai * 128 + m * 16;
                        const f32x4 v0 = acc[ai][bj][m][0], v1 = acc[ai][bj][m][1]; f32x4 o0, o1;
                        if (fq == 0) {
#pragma unroll
                            for (int i = 0; i < 4; ++i) { const float z0 = v0[i] + b_forget[i], z1 = v1[i] + b_forget[4 + i];
                                o0[i] = fminf(z0, 0.f) - log1pf(__expf(-fabsf(z0))); o1[i] = fminf(z1, 0.f) - log1pf(__expf(-fabsf(z1))); }
                        } else {
#pragma unroll
                            for (int i = 0; i < 4; ++i) { o0[i] = sigmoidf_(v0[i]); o1[i] = sigmoidf_(v1[i]); }
                        }
                        float* dst = (fq == 0) ? (float*)(ws + WS_LOGF) + (size_t)row * 8 : (float*)(ws + WS_GATES) + (size_t)row * 24 + 8 * (fq - 1);
                        *(f32x4*)dst = o0; *(f32x4*)(dst + 4) = o1;
                    }
            }
        }
    }
};

template <bool ADD> struct EpiGate {
    bf16* O; const bf16* SG;
    __device__ __forceinline__ void operator()(const f32x4 (&acc)[2][2][4][2], const pg8::Unit& u, int wr, int wc, int fr, int fq) const {
#pragma unroll
        for (int ai = 0; ai < 2; ++ai)
#pragma unroll
            for (int m = 0; m < 4; ++m)
#pragma unroll
                for (int bj = 0; bj < 2; ++bj) {
                    const size_t off = (size_t)(u.pm * 256 + ai * 128 + wr * 64 + m * 16 + fr) * 1024 + u.pn * 256 + bj * 128 + wc * 32 + 8 * fq;
                    const v4u g = *(const v4u*)(SG + off);
                    f32x4 v0 = acc[ai][bj][m][0], v1 = acc[ai][bj][m][1];
                    v0[0] *= bf_lo(g.x); v0[1] *= bf_hi(g.x); v0[2] *= bf_lo(g.y); v0[3] *= bf_hi(g.y); v1[0] *= bf_lo(g.z); v1[1] *= bf_hi(g.z); v1[2] *= bf_lo(g.w); v1[3] *= bf_hi(g.w);
                    if (ADD) { const v4u p = *(const v4u*)(O + off);
                        v0[0] += bf_lo(p.x); v0[1] += bf_hi(p.x); v0[2] += bf_lo(p.y); v0[3] += bf_hi(p.y); v1[0] += bf_lo(p.z); v1[1] += bf_hi(p.z); v1[2] += bf_lo(p.w); v1[3] += bf_hi(p.w); }
                    *(v4u*)(O + off) = pack8(v0, v1);
                }
    }
};

struct EpiPlain {
    bf16* O; int ldc;
    __device__ __forceinline__ void operator()(const f32x4 (&acc)[2][2][4][2], const pg8::Unit& u, int wr, int wc, int fr, int fq) const {
#pragma unroll
        for (int ai = 0; ai < 2; ++ai)
#pragma unroll
            for (int m = 0; m < 4; ++m)
#pragma unroll
                for (int bj = 0; bj < 2; ++bj) {
                    const size_t off = (size_t)(u.pm * 256 + ai * 128 + wr * 64 + m * 16 + fr) * ldc + u.pn * 256 + bj * 128 + wc * 32 + 8 * fq;
                    *(v4u*)(O + off) = pack8(acc[ai][bj][m][0], acc[ai][bj][m][1]);
                }
    }
};

struct MoeOrder {
    int G, c, NP, mode;
    LAS const int* tab; const int* tokof;
    __device__ __forceinline__ bool next(int i, pg8::Unit& u) const {
        const int L = i * G + c, ntile = tab[32 + 32];
        if (L >= ntile * NP) return false;
        const int ti = L / NP, pnl = L % NP; int e = 0;
#pragma unroll 1
        for (int k = 1; k < 32; ++k) e = (tab[32 + k] <= ti) ? k : e;
        u.e = e; u.rt = ti - tab[32 + e]; u.pm = ti; u.pn = e * NP + pnl; return true;
    }
    __device__ __forceinline__ unsigned a_off(const pg8::Unit& u, int r) const {
        const int cnt = tab[u.e]; int rank = u.rt * 256 + r; rank = rank < cnt ? rank : cnt - 1;
        if (mode == 0) { const int id = tokof[(size_t)u.e * NTOK + rank]; return (unsigned)(id >> 2) * 2048u; }
        return (unsigned)(tab[65 + u.e] + rank) * 2048u;
    }
};
__device__ __forceinline__ void moe_tables(const Args& A, const Ctx& X) {
    LAS int* tab = (LAS int*)(X.lds + TAB_OFF);
    __syncthreads();
    if (X.tid == 0) { const unsigned* ctl = (const unsigned*)(X.ws + WS_CTL); int ts = 0, gs = 0;
        for (int e = 0; e < 32; ++e) { const int cnt = (int)__hip_atomic_load(ctl + CW_ECNT + 64 * e, __ATOMIC_RELAXED, __HIP_MEMORY_SCOPE_AGENT); tab[e] = cnt; tab[32 + e] = ts; tab[65 + e] = gs; ts += (cnt + 255) >> 8; gs += cnt; }
        tab[32 + 32] = ts; tab[65 + 32] = gs; }
    __syncthreads();
}

struct EpiGateUp {
    bf16* ACT; const float* bg; const float* bu; LAS const int* tab;
    __device__ __forceinline__ void operator()(const f32x4 (&acc)[2][2][4][2], const pg8::Unit& u, int wr, int wc, int fr, int fq) const {
        const int e = u.e, pnl = u.pn - e * 8, col = pnl * 128 + wc * 32 + 8 * fq, cnt = tab[e], gs = tab[65 + e];
        const f32x4 g0 = *(const f32x4*)(bg + e * 1024 + col), g1 = *(const f32x4*)(bg + e * 1024 + col + 4), u0 = *(const f32x4*)(bu + e * 1024 + col), u1 = *(const f32x4*)(bu + e * 1024 + col + 4);
#pragma unroll
        for (int ai = 0; ai < 2; ++ai)
#pragma unroll
            for (int m = 0; m < 4; ++m) {
                const int rank = u.rt * 256 + ai * 128 + wr * 64 + m * 16 + fr;
                f32x4 a0 = acc[ai][0][m][0] + g0, a1 = acc[ai][0][m][1] + g1, b0 = acc[ai][1][m][0] + u0, b1 = acc[ai][1][m][1] + u1, o0, o1;
#pragma unroll
                for (int i = 0; i < 4; ++i) {
                    float gt = fminf(a0[i], 7.f), up = fminf(fmaxf(b0[i], -7.f), 7.f); o0[i] = gt * sigmoidf_(1.702f * gt) * (up + 1.f);
                    gt = fminf(a1[i], 7.f); up = fminf(fmaxf(b1[i], -7.f), 7.f); o1[i] = gt * sigmoidf_(1.702f * gt) * (up + 1.f); }
                if (rank < cnt) *(v4u*)(ACT + (size_t)(gs + rank) * 1024 + col) = pack8(o0, o1);
            }
    }
};
struct EpiDown {
    unsigned char* out; unsigned char* yshi; const float* bd; LAS const int* tab; const int* tokof;
    __device__ __forceinline__ void operator()(const f32x4 (&acc)[2][2][4][2], const pg8::Unit& u, int wr, int wc, int fr, int fq) const {
        const int e = u.e, pnl = u.pn - e * 4, cnt = tab[e];
#pragma unroll
        for (int ai = 0; ai < 2; ++ai)
#pragma unroll
            for (int m = 0; m < 4; ++m) {
                const int rank = u.rt * 256 + ai * 128 + wr * 64 + m * 16 + fr;
                if (rank < cnt) {
                    const int id = tokof[(size_t)e * NTOK + rank], tok = id >> 2, k = id & 3;
                    const long long dlt = (k >= 2) ? (long long)(yshi - out) : 0ll; unsigned char* rowp = out + dlt + (size_t)tok * 4096 + (k & 1) * 2048;
#pragma unroll
                    for (int bj = 0; bj < 2; ++bj) { const int col = pnl * 256 + bj * 128 + wc * 32 + 8 * fq;
                        const f32x4 b0 = *(const f32x4*)(bd + e * 1024 + col), b1 = *(const f32x4*)(bd + e * 1024 + col + 4);
                        *(v4u*)(rowp + col * 2) = pack8(acc[ai][bj][m][0] + b0, acc[ai][bj][m][1] + b1); }
                }
            }
    }
};

__device__ __forceinline__ f32x4 ld_bf4(const bf16* p) { const v2u u = *(const v2u*)p; return (f32x4){bf_lo(u.x), bf_hi(u.x), bf_lo(u.y), bf_hi(u.y)}; }

__device__ __forceinline__ void phase6(const Args& A, const Ctx& X) {
    const float* x = A.in[0]; const float* gpost = A.in[5]; const float* gpre2 = A.in[16]; const float* b_router = A.in[19];
    const float* ADA = (const float*)(X.ws + WS_ADA); const float* WRT = (const float*)(X.ws + WS_WRT);
    const bf16* MIXED = (const bf16*)(X.ws + WS_MIXED); bf16* H2 = (bf16*)((unsigned char*)X.out + OUT_H2);
    int* TOPE = (int*)(X.ws + WS_TOPE); float* TOPW = (float*)(X.ws + WS_TOPW); int* RANK = (int*)(X.ws + WS_RANK); int* TOKOF = (int*)(X.ws + WS_TOKOF);
    unsigned* ctl = (unsigned*)(X.ws + WS_CTL);
    LAS float* v_g1 = (LAS float*)X.lds;
    LAS float* v_g2 = v_g1 + 1024;
    LAS float* v_s2 = v_g2 + 1024;
    LAS int* e_of = (LAS int*)(v_s2 + 1024);
    LAS int* lcnt = e_of + 512;
    LAS int* lbase = lcnt + 32;
    const int lane = X.lane;
    for (int ch = blockIdx.x; ch < NTOK / 128; ch += X.G) {
        const int row0 = ch * 128, b = row0 / SEQ;
        __syncthreads();
        for (int j = X.tid; j < 1024; j += 512) { v_g1[j] = ADA[b * 6144 + 2048 + j] * gpost[j]; v_g2[j] = gpre2[j] * (1.f + ADA[b * 6144 + 4096 + j]); v_s2[j] = ADA[b * 6144 + 3072 + j]; }
        if (X.tid < 32) lcnt[X.tid] = 0;
        __syncthreads();
        for (int i = 0; i < 16; ++i) {
            const int rl = X.wave + 8 * i, row = row0 + rl;
            f32x4 mv[4], xv[4]; float ss = 0.f;
#pragma unroll
            for (int j = 0; j < 4; ++j) { const int k = 4 * lane + 256 * j; mv[j] = ld_bf4(MIXED + (size_t)row * 1024 + k); xv[j] = *(const f32x4*)(x + (size_t)row * 1024 + k);
                ss += (mv[j].x * mv[j].x + mv[j].y * mv[j].y) + (mv[j].z * mv[j].z + mv[j].w * mv[j].w); }
            const float r1 = 1.f / sqrtf(wave_sum(ss) * (1.f / DM) + RMS_EPS); float s2 = 0.f;
#pragma unroll
            for (int j = 0; j < 4; ++j) { const int k = 4 * lane + 256 * j; const f32x4 g = *(LAS f32x4*)(v_g1 + k); xv[j] = xv[j] + g * (mv[j] * r1);
                s2 += (xv[j].x * xv[j].x + xv[j].y * xv[j].y) + (xv[j].z * xv[j].z + xv[j].w * xv[j].w); }
            const float r2 = 1.f / sqrtf(wave_sum(s2) * (1.f / DM) + RMS_EPS);
#pragma unroll
            for (int j = 0; j < 4; ++j) { const int k = 4 * lane + 256 * j; const f32x4 g = *(LAS f32x4*)(v_g2 + k), s = *(LAS f32x4*)(v_s2 + k); xv[j] = xv[j] * r2 * g + s;
                v2u o; o.x = pk2(xv[j].x, xv[j].y); o.y = pk2(xv[j].z, xv[j].w); *(v2u*)(H2 + (size_t)row * 1024 + k) = o; }
            float mylogit = -3.0e38f;
#pragma unroll 4
            for (int e = 0; e < 32; ++e) { float p = 0.f;
#pragma unroll
                for (int j = 0; j < 4; ++j) { const f32x4 w = *(const f32x4*)(WRT + e * 1024 + 4 * lane + 256 * j); p += (xv[j].x * w.x + xv[j].y * w.y) + (xv[j].z * w.z + xv[j].w * w.w); }
                p = wave_sum(p) + b_router[e]; if (lane == e) mylogit = p; }
            float tv[4]; int te[4]; float cur = mylogit;
#pragma unroll
            for (int k = 0; k < 4; ++k) { float mx = cur;
#pragma unroll
                for (int o = 1; o < 64; o <<= 1) mx = fmaxf(mx, __shfl_xor(mx, o));
                const unsigned long long bal = __ballot(cur == mx && lane < 32); const int idx = __ffsll((long long)bal) - 1;
                tv[k] = mx; te[k] = idx; if (lane == idx) cur = -3.0e38f; }
            const float e1 = __expf(tv[1] - tv[0]), e2 = __expf(tv[2] - tv[0]), e3 = __expf(tv[3] - tv[0]), inv = 1.f / (1.f + e1 + e2 + e3);
            if (lane == 0) { *(int4*)(TOPE + (size_t)row * 4) = make_int4(te[0], te[1], te[2], te[3]); *(f32x4*)(TOPW + (size_t)row * 4) = (f32x4){inv, e1 * inv, e2 * inv, e3 * inv};
                e_of[rl * 4 + 0] = te[0]; e_of[rl * 4 + 1] = te[1]; e_of[rl * 4 + 2] = te[2]; e_of[rl * 4 + 3] = te[3]; }
        }
        __syncthreads();
        const int e = e_of[X.tid]; const int lr = __hip_atomic_fetch_add(&lcnt[e], 1, __ATOMIC_RELAXED, __HIP_MEMORY_SCOPE_WORKGROUP);
        __syncthreads();
        if (X.tid < 32) lbase[X.tid] = (int)__hip_atomic_fetch_add(ctl + CW_ECNT + 64 * X.tid, (unsigned)lcnt[X.tid], __ATOMIC_RELAXED, __HIP_MEMORY_SCOPE_AGENT);
        __syncthreads();
        { const int rank = lbase[e] + lr, id = (row0 + (X.tid >> 2)) * 4 + (X.tid & 3); RANK[id] = rank; TOKOF[(size_t)e * NTOK + rank] = id; }
    }
}

__device__ __forceinline__ void phase10(const Args& A, const Ctx& X) {
    const float* x = A.in[0]; const float* gpost = A.in[5]; const float* gpost2 = A.in[17];
    const float* ADA = (const float*)(X.ws + WS_ADA); const bf16* MIXED = (const bf16*)(X.ws + WS_MIXED);
    const float* TOPW = (const float*)(X.ws + WS_TOPW);
    LAS float* v_g1 = (LAS float*)X.lds; LAS float* v_g3 = v_g1 + 1024;
    const int lane = X.lane;
    for (int ch = blockIdx.x; ch < NTOK / 128; ch += X.G) {
        const int row0 = ch * 128, b = row0 / SEQ;
        __syncthreads();
        for (int j = X.tid; j < 1024; j += 512) { v_g1[j] = ADA[b * 6144 + 2048 + j] * gpost[j]; v_g3[j] = ADA[b * 6144 + 5120 + j] * gpost2[j]; }
        __syncthreads();
        for (int i = 0; i < 16; ++i) {
            const int row = row0 + X.wave + 8 * i;
            const f32x4 tw = *(const f32x4*)(TOPW + (size_t)row * 4);
            const bf16* y0 = (const bf16*)((const unsigned char*)X.out + (size_t)row * 4096); const bf16* y2 = (const bf16*)(X.ws + WS_YSHI + (size_t)row * 4096);
            f32x4 mv[4], xv[4], yv[4]; float ss = 0.f, sy = 0.f;
#pragma unroll
            for (int j = 0; j < 4; ++j) { const int k = 4 * lane + 256 * j; mv[j] = ld_bf4(MIXED + (size_t)row * 1024 + k); xv[j] = *(const f32x4*)(x + (size_t)row * 1024 + k);
                yv[j] = ld_bf4(y0 + k) * tw.x + ld_bf4(y0 + 1024 + k) * tw.y + ld_bf4(y2 + k) * tw.z + ld_bf4(y2 + 1024 + k) * tw.w;
                ss += (mv[j].x * mv[j].x + mv[j].y * mv[j].y) + (mv[j].z * mv[j].z + mv[j].w * mv[j].w);
                sy += (yv[j].x * yv[j].x + yv[j].y * yv[j].y) + (yv[j].z * yv[j].z + yv[j].w * yv[j].w); }
            const float r1 = 1.f / sqrtf(wave_sum(ss) * (1.f / DM) + RMS_EPS), r3 = 1.f / sqrtf(wave_sum(sy) * (1.f / DM) + RMS_EPS);
            asm volatile("s_waitcnt vmcnt(0)" ::: "memory");
#pragma unroll
            for (int j = 0; j < 4; ++j) { const int k = 4 * lane + 256 * j; const f32x4 g1 = *(LAS f32x4*)(v_g1 + k), g3 = *(LAS f32x4*)(v_g3 + k);
                *(f32x4*)(X.out + (size_t)row * 1024 + k) = xv[j] + g1 * (mv[j] * r1) + g3 * (yv[j] * r3); }
        }
    }
}

constexpr int AL_K = 0, AL_V = 16384, AL_KB = 32768, AL_TBL = 33280, AL_SELM = 35328, AL_IMPW = 36864;
typedef short v4i16_t __attribute__((ext_vector_type(4)));
__device__ __forceinline__ int crow(int r, int hi) { return (r & 3) + 8 * (r >> 2) + 4 * hi; }
__device__ __forceinline__ s16x4 vtr(LAS const unsigned char* p) { return __builtin_bit_cast(s16x4, __builtin_amdgcn_ds_read_tr16_b64_v4i16((LAS v4i16_t*)p)); }

__device__ __forceinline__ void qk_tile(f32x16& p0, f32x16& p1, LAS const unsigned char* Ks, const bf16x8 (&qr)[4], int r32, int hi) {
    LAS const unsigned char* kb = Ks + hi * 1024 + r32 * 16;
    p0 = (f32x16){}; p1 = (f32x16){};
#pragma unroll
    for (int d0 = 0; d0 < 4; ++d0) {
        const bf16x8 b0 = *(LAS const bf16x8*)(kb + d0 * 2048), b1 = *(LAS const bf16x8*)(kb + d0 * 2048 + 512);
        p0 = __builtin_amdgcn_mfma_f32_32x32x16_bf16(b0, qr[d0], p0, 0, 0, 0);
        p1 = __builtin_amdgcn_mfma_f32_32x32x16_bf16(b1, qr[d0], p1, 0, 0, 0);
    }
}
__device__ __forceinline__ void softmax_pv(f32x16& p0, f32x16& p1, float& m, float& l, f32x16 (&o)[2], LAS const unsigned char* Vs, int lane, int hi) {
    float rm = fmaxf(p0[0], p1[0]);
#pragma unroll
    for (int r = 1; r < 16; ++r) rm = fmaxf(rm, fmaxf(p0[r], p1[r]));
    rm = fmaxf(rm, __shfl_xor(rm, 32));
    const float mn = fmaxf(m, rm), alpha = __builtin_amdgcn_exp2f(m - mn);
    m = mn;
    if (!__all(alpha == 1.f)) { l *= alpha;
#pragma unroll
        for (int r = 0; r < 16; ++r) { o[0][r] *= alpha; o[1][r] *= alpha; } }
    float s = 0.f;
#pragma unroll
    for (int r = 0; r < 16; ++r) { p0[r] = __builtin_amdgcn_exp2f(p0[r] - mn); p1[r] = __builtin_amdgcn_exp2f(p1[r] - mn); s += p0[r] + p1[r]; }
    l += s;
    v4u pw[4];
    pw[0] = (v4u){pk2(p0[0], p0[1]), pk2(p0[2], p0[3]), pk2(p0[4], p0[5]), pk2(p0[6], p0[7])};
    pw[1] = (v4u){pk2(p0[8], p0[9]), pk2(p0[10], p0[11]), pk2(p0[12], p0[13]), pk2(p0[14], p0[15])};
    pw[2] = (v4u){pk2(p1[0], p1[1]), pk2(p1[2], p1[3]), pk2(p1[4], p1[5]), pk2(p1[6], p1[7])};
    pw[3] = (v4u){pk2(p1[8], p1[9]), pk2(p1[10], p1[11]), pk2(p1[12], p1[13]), pk2(p1[14], p1[15])};
    LAS const unsigned char* vb = Vs + ((lane >> 4) & 1) * 32 + (lane & 3) * 8 + (4 * hi + ((lane & 15) >> 2)) * 64;
    __builtin_amdgcn_sched_barrier(0);
#pragma unroll
    for (int d0 = 0; d0 < 2; ++d0) {
#pragma unroll
        for (int ks = 0; ks < 4; ++ks) {
            const s16x4 lo = vtr(vb + d0 * 4096 + ks * 1024), hh_ = vtr(vb + d0 * 4096 + ks * 1024 + 512);
            const bf16x8 vf = (bf16x8){lo[0], lo[1], lo[2], lo[3], hh_[0], hh_[1], hh_[2], hh_[3]};
            o[d0] = __builtin_amdgcn_mfma_f32_32x32x16_bf16(vf, __builtin_bit_cast(bf16x8, pw[ks]), o[d0], 0, 0, 0);
        }
        __builtin_amdgcn_sched_barrier(0);
    }
}

template <int MODE>
__device__ __forceinline__ void attn_branch(LAS unsigned char* L, int& buf, const bf16* __restrict__ Kg, const bf16* __restrict__ Vg, const float* __restrict__ KBg,
                                            int jlo, int jhi, const bf16x8 (&qr)[4], int tq, int tqmax, int hh, int qt, unsigned long long selm,
                                            float& m, float& l, f32x16 (&o)[2], float inv, int th) {
    const int tid = threadIdx.x, lane = tid & 63, wid = __builtin_amdgcn_readfirstlane(tid >> 6), r32 = lane & 31, hi = lane >> 5;
    LAS const float* TBL = (LAS const float*)(L + AL_TBL);
    v4u kreg, vreg = (v4u){0u, 0u, 0u, 0u}; float kbreg = 0.f;
#define ATT_GLOAD(j) do { kreg = *(const v4u*)(Kg + (size_t)(j) * 4096 + lane * 64 + wid * 8); \
        if (MODE != 4) vreg = *(const v4u*)(Vg + (size_t)(j) * 4096 + (16 * (wid & 3) + (lane >> 2)) * 64 + (wid >> 2) * 32 + (lane & 3) * 8); \
        if (MODE == 0 && tid < 64) kbreg = KBg[(j) * 64 + tid]; } while (0)
    ATT_GLOAD(jlo);
    float carry = 0.f;
    for (int j = jlo; j <= jhi; ++j) {
        LAS unsigned char* Ks = L + AL_K + buf * 8192; LAS unsigned char* Vs = L + AL_V + buf * 8192; LAS float* KBs = (LAS float*)(L + AL_KB) + buf * 64;
        *(LAS v4u*)(Ks + wid * 1024 + lane * 16) = kreg;
        if (MODE != 4) *(LAS v4u*)(Vs + wid * 1024 + lane * 16) = vreg;
        if (MODE == 0 && tid < 64) KBs[tid] = kbreg;
        __syncthreads();
        if (j < jhi) ATT_GLOAD(j + 1);
        const int key0 = j * 64;
        if (!(MODE == 0 && key0 > tqmax)) {
            f32x16 p0, p1;
            qk_tile(p0, p1, Ks, qr, r32, hi);
            __builtin_amdgcn_sched_barrier(0);
            if (MODE == 0) {
#pragma unroll
                for (int a = 0; a < 4; ++a) { const f32x4 b0 = *(LAS const f32x4*)(KBs + 8 * a + 4 * hi), b1 = *(LAS const f32x4*)(KBs + 32 + 8 * a + 4 * hi);
#pragma unroll
                    for (int i = 0; i < 4; ++i) { p0[4 * a + i] += b0[i]; p1[4 * a + i] += b1[i]; } }
                if (key0 + 63 > tqmax - 31) {
                    int d0 = tq - key0 - 4 * hi; asm volatile("" : "+v"(d0));
#pragma unroll
                    for (int r = 0; r < 16; ++r) { const int C = (r & 3) + 8 * (r >> 2); if (C > d0) p0[r] = NEGBIG; if (C + 32 > d0) p1[r] = NEGBIG; }
                }
            } else {
                const bool general = (MODE == 1 || MODE == 4) ? true : (MODE == 2 ? (j >= qt - 2) : (j >= qt - 2 || j <= qt - 8));
                const bool selbit = (MODE == 2) ? (((selm >> j) & 1ull) != 0ull) : true;
                if (general) {
                    int d0 = (MODE == 1 || MODE == 4) ? tq - 31 - 16 * key0 - 64 * hi : tq - key0 - 4 * hi;
                    asm volatile("" : "+v"(d0));
                    constexpr int CM = (MODE == 1 || MODE == 4) ? 16 : 1;
#pragma unroll
                    for (int r = 0; r < 16; ++r) {
#pragma unroll
                        for (int hblk = 0; hblk < 2; ++hblk) {
                            const int dist = d0 - CM * ((r & 3) + 8 * (r >> 2) + 32 * hblk);
                            bool valid = dist >= 0; if (MODE == 3) valid = valid && dist < 512; if (MODE == 2) valid = valid && selbit;
                            const int idx = min(max(dist, 0), 127);
                            const float bias = TBL[idx * 4 + hh];
                            if (hblk) p1[r] = valid ? p1[r] + bias : NEGBIG; else p0[r] = valid ? p0[r] + bias : NEGBIG;
                        }
                        if ((r & 3) == 3) __builtin_amdgcn_sched_barrier(0);
                    }
                } else {
                    const float bfar = TBL[127 * 4 + hh];
#pragma unroll
                    for (int r = 0; r < 16; ++r) { p0[r] = selbit ? p0[r] + bfar : NEGBIG; p1[r] = selbit ? p1[r] + bfar : NEGBIG; }
                }
            }
            __builtin_amdgcn_sched_barrier(0);
            if (MODE != 4) {
                softmax_pv(p0, p1, m, l, o, Vs, lane, hi);
            } else {
                float S0[4], S1[4], s0[4], s1[4];
#pragma unroll
                for (int r = 0; r < 16; ++r) { p0[r] = __builtin_amdgcn_exp2f(p0[r] - m) * inv; p1[r] = __builtin_amdgcn_exp2f(p1[r] - m) * inv; }
#pragma unroll
                for (int a = 0; a < 4; ++a) { S0[a] = (p0[4 * a] + p0[4 * a + 1]) + (p0[4 * a + 2] + p0[4 * a + 3]); S1[a] = (p1[4 * a] + p1[4 * a + 1]) + (p1[4 * a + 2] + p1[4 * a + 3]); }
                if (hi == 0) {
#pragma unroll
                    for (int a = 0; a < 4; ++a) { s0[a] = p0[4 * a + 3]; s1[a] = p1[4 * a + 3]; }
                } else { s0[0] = carry; s0[1] = p0[3]; s0[2] = p0[7]; s0[3] = p0[11]; s1[0] = p0[15]; s1[1] = p1[3]; s1[2] = p1[7]; s1[3] = p1[11]; carry = p1[15]; }
                LAS float* IW = (LAS float*)(L + AL_IMPW) + ((hh * 64) + (32 * th + r32)) * 64 + 16 * j + hi;
#pragma unroll
                for (int a = 0; a < 4; ++a) { IW[2 * a] = S0[a] + __shfl_xor(s0[a], 32); IW[8 + 2 * a] = S1[a] + __shfl_xor(s1[a], 32); }
            }
        }
        buf ^= 1;
    }
#undef ATT_GLOAD
}

__device__ __forceinline__ void store_ot(bf16* dst  , const f32x16 (&o)[2], float scale, int hi) {
#pragma unroll
    for (int d0 = 0; d0 < 2; ++d0)
#pragma unroll
        for (int a = 0; a < 4; ++a) { v2u w; w.x = pk2(o[d0][4 * a] * scale, o[d0][4 * a + 1] * scale); w.y = pk2(o[d0][4 * a + 2] * scale, o[d0][4 * a + 3] * scale);
            *(v2u*)(dst + 32 * d0 + 8 * a + 4 * hi) = w; }
}

__device__ __forceinline__ void fox_unit(const Args& A, const Ctx& X, int bh, int qb, int& buf) {
    const int lane = X.lane, wid = X.wave, r32 = lane & 31, hi = lane >> 5;
    const int tq = 256 * qb + 32 * wid + r32, tqmax = 256 * qb + 32 * wid + 31;
    const bf16* Q = (const bf16*)(X.ws + WS_FQ) + ((size_t)bh * SEQ + tq) * 64;
    bf16x8 qr[4];
#pragma unroll
    for (int d0 = 0; d0 < 4; ++d0) qr[d0] = *(const bf16x8*)(Q + d0 * 16 + hi * 8);
    float m = NEGBIG, l = 0.f; f32x16 o[2]; o[0] = (f32x16){}; o[1] = (f32x16){};
    attn_branch<0>(X.lds, buf, (const bf16*)(X.ws + WS_FK) + (size_t)bh * SEQ * 64, (const bf16*)(X.ws + WS_FV) + (size_t)bh * SEQ * 64, (const float*)(X.ws + WS_KBIAS) + (size_t)bh * SEQ,
                   0, 4 * qb + 3, qr, tq, tqmax, 0, 0, 0ull, m, l, o, 0.f, 0);
    const float lt = l + __shfl_xor(l, 32);
    const int b = bh >> 3, h = bh & 7;
    store_ot((bf16*)((unsigned char*)X.out + OUT_OFOX) + ((size_t)b * SEQ + tq) * 512 + h * 64, o, 1.f / lt, hi);
}

__device__ __forceinline__ void nsa_unit(const Args& A, const Ctx& X, int bg, int qt, int& buf) {
    const int tid = X.tid, lane = X.lane, wid = X.wave, r32 = lane & 31, hi = lane >> 5, hh = wid >> 1, th = wid & 1;
    const int b = bg >> 1, g = bg & 1, head = 4 * g + hh;
    const int tok = 32 * th + r32, tq = 64 * qt + tok, tqmax = 64 * qt + 32 * th + 31;
    LAS unsigned char* L = X.lds;
    __syncthreads();
    { const float* rel = A.in[15]; LAS float* TBL = (LAS float*)(L + AL_TBL); const int d = tid >> 2, q = tid & 3; TBL[tid] = rel[T5_BUCKET[d] * 8 + 4 * g + q] * LOG2E; }
    { LAS v4u* z = (LAS v4u*)(L + AL_IMPW);
#pragma unroll
      for (int i = 0; i < 8; ++i) z[tid + 512 * i] = (v4u){0u, 0u, 0u, 0u}; }
    const bf16* Q = (const bf16*)(X.ws + WS_NQ) + ((size_t)(b * 8 + head) * SEQ + tq) * 64;
    bf16x8 qr[4];
#pragma unroll
    for (int d0 = 0; d0 < 4; ++d0) qr[d0] = *(const bf16x8*)(Q + d0 * 16 + hi * 8);
    const float* gp = (const float*)(X.ws + WS_GATES) + ((size_t)b * SEQ + tq) * 24 + head * 3;
    const float g_cmp = gp[0], g_slc = gp[1], g_win = gp[2];
    __syncthreads();
    const bf16* KV6 = (const bf16*)(X.ws + WS_KV6);
    const bf16* KC = (const bf16*)(X.ws + WS_KC) + (size_t)bg * 256 * 64; const bf16* VC = (const bf16*)(X.ws + WS_VC) + (size_t)bg * 256 * 64;
    const int nct = (4 * qt + 2) / 64;
    float m = NEGBIG, l = 0.f; f32x16 o[2]; o[0] = (f32x16){}; o[1] = (f32x16){};
#ifndef NSA_NO1
    attn_branch<1>(L, buf, KC, VC, nullptr, 0, nct, qr, tq, tqmax, hh, qt, 0ull, m, l, o, 0.f, th);
#endif
    float lt = l + __shfl_xor(l, 32);
    const float inv_c = (tq >= 31) ? 1.f / lt : 0.f;
    { const float sc = g_cmp * inv_c;
#pragma unroll
      for (int r = 0; r < 16; ++r) { o[0][r] *= sc; o[1][r] *= sc; } }
#ifndef NSA_NO4
    { float m2 = m, l2 = 0.f; f32x16 od[2]; attn_branch<4>(L, buf, KC, VC, nullptr, 0, nct, qr, tq, tqmax, hh, qt, 0ull, m2, l2, od, inv_c, th); }
#endif
    __syncthreads();
    {
        LAS const float* IW = (LAS const float*)(L + AL_IMPW); LAS unsigned long long* SELM = (LAS unsigned long long*)(L + AL_SELM);
        for (int ii = 0; ii < 8; ++ii) {
            const int tk = 8 * wid + ii, j = lane;
            const float imp = ((IW[(0 * 64 + tk) * 64 + j] + IW[(1 * 64 + tk) * 64 + j]) + IW[(2 * 64 + tk) * 64 + j]) + IW[(3 * 64 + tk) * 64 + j];
            const bool forced = (j == 0) || (j == qt) || (j == qt - 1), svalid = (j <= qt);
            const float score = forced ? 1e9f : (svalid ? imp : -1e9f);
            int rank = 0;
#pragma unroll 4
            for (int i = 0; i < 64; ++i) { const float si = __builtin_bit_cast(float, __builtin_amdgcn_readlane(__builtin_bit_cast(int, score), i));
                rank += ((si > score) || (si == score && i < j)) ? 1 : 0; }
            const unsigned long long msk = __ballot(rank < 16);
            if (lane == 0) SELM[tk] = msk;
        }
    }
    __syncthreads();
    const unsigned long long selm = ((LAS const unsigned long long*)(L + AL_SELM))[tok];
    LAS float* ACC = (LAS float*)(L + AL_IMPW) + tid;
#pragma unroll
    for (int r = 0; r < 16; ++r) { ACC[r * 512] = o[0][r]; ACC[(16 + r) * 512] = o[1][r]; }
    m = NEGBIG; l = 0.f; o[0] = (f32x16){}; o[1] = (f32x16){};
#ifndef NSA_NO2
    attn_branch<2>(L, buf, KV6 + 2 * KV6_STRIDE + (size_t)bg * SEQ * 64, KV6 + 3 * KV6_STRIDE + (size_t)bg * SEQ * 64, nullptr, 0, qt, qr, tq, tqmax, hh, qt, selm, m, l, o, 0.f, th);
#endif
    lt = l + __shfl_xor(l, 32);
    { const float sc = g_slc / lt;
#pragma unroll
      for (int r = 0; r < 16; ++r) { ACC[r * 512] += o[0][r] * sc; ACC[(16 + r) * 512] += o[1][r] * sc; } }
    m = NEGBIG; l = 0.f; o[0] = (f32x16){}; o[1] = (f32x16){};
#ifndef NSA_NO3
    attn_branch<3>(L, buf, KV6 + 4 * KV6_STRIDE + (size_t)bg * SEQ * 64, KV6 + 5 * KV6_STRIDE + (size_t)bg * SEQ * 64, nullptr, qt > 8 ? qt - 8 : 0, qt, qr, tq, tqmax, hh, qt, 0ull, m, l, o, 0.f, th);
#endif
    lt = l + __shfl_xor(l, 32);
    { const float sc = g_win / lt;
#pragma unroll
      for (int r = 0; r < 16; ++r) { o[0][r] = ACC[r * 512] + o[0][r] * sc; o[1][r] = ACC[(16 + r) * 512] + o[1][r] * sc; } }
    store_ot((bf16*)((unsigned char*)X.out + OUT_ONSA) + ((size_t)b * SEQ + tq) * 512 + head * 64, o, 1.f, hi);
}

__device__ __forceinline__ void phase3(const Args& A, const Ctx& X) {
    int buf = 0;
#ifndef NO_FOX
    for (int u = X.vcu; u < 1024; u += X.G) { const int rd = u >> 8, v = u & 255, bh = v >> 2, s = v & 3; const int qb = (rd == 0) ? s : (rd == 1) ? 7 - s : (rd == 2) ? 8 + s : 15 - s;
        fox_unit(A, X, bh, qb, buf); }
#endif
#ifndef NO_NSA
    for (int u = X.vcu; u < 1024; u += X.G) { const int rd = u >> 8, v = u & 255, bg = v >> 4, s = v & 15; const int qt = (rd == 0) ? s : (rd == 1) ? 31 - s : (rd == 2) ? 32 + s : 63 - s;
        nsa_unit(A, X, bg, qt, buf); }
#endif
}

#ifndef MK_N_LAUNCHES
#define MK_N_LAUNCHES 1
#endif
constexpr int N_PHASES = 11;

__global__ void __launch_bounds__(512, 2) fwd(Args args) {
    extern __shared__ __attribute__((aligned(16))) unsigned char lds_raw[];
    Ctx X;
    X.out = args.out; X.ws = args.ws;
    X.lds = (LAS unsigned char*)lds_raw;
    X.tid = threadIdx.x; X.lane = X.tid & 63; X.wave = __builtin_amdgcn_readfirstlane(X.tid >> 6);
    X.G = gridDim.x; { const int bx = blockIdx.x; X.vcu = (X.G % 8 == 0) ? (bx % 8) * (X.G / 8) + bx / 8 : bx; }
    volatile LAS unsigned* MISC = (volatile LAS unsigned*)(X.lds + MISC_OFF);
    if (X.tid < 64) MISC[X.tid] = 0u;
    __syncthreads();
    const int lo = args.ph_lo, hi = args.ph_hi;
    unsigned* ctl = (unsigned*)(X.ws + WS_CTL);
    XcdBarrier bar; bar.bar = ctl + CW_BAR; bar.x = 0; bar.st = MISC + 8;
    if (hi - lo > 1) bar = xcd_barrier_post(ctl + CW_BAR, MISC + 8);
#ifndef PHMASK
#define PHMASK 0x7ff
#endif
#define IN(k) ((((PHMASK) >> (k)) & 1) && lo <= (k) && (k) < hi)
#define SEAM(k) do { if (IN(k) && IN((k) + 1)) xcd_barrier(bar); } while (0)
    unsigned char* ws = X.ws;
    const int bid = (int)blockIdx.x;

    if (IN(0)) { phase0a(args, X); SEAM(0); }
    if (IN(1)) { phase0b(args, X); SEAM(1); }
    if (IN(2)) {
        pg8::Gemm g{(const bf16*)((unsigned char*)X.out + OUT_H), (const bf16*)(ws + WS_WIN), 1024};
        pg8::StaticOrder S; S.init(NTOK, NPROJ, X.G, bid, 1024);
        EpiInProj E{ws, args.in[7]};
        pg8::gemm_phase<EpiInProj, pg8::StaticOrder>(X.lds, g, S, E);
        SEAM(2);
    }
    if (IN(3)) { phase2(args, X); SEAM(3); }
    if (IN(4)) { phase3(args, X); SEAM(4); }
    if (IN(5)) {
        pg8::StaticOrder S; S.init(NTOK, 1024, X.G, bid, 512);
        { pg8::Gemm g{(const bf16*)((unsigned char*)X.out + OUT_OFOX), (const bf16*)(ws + WS_WFOX), 512};
          EpiGate<false> E{(bf16*)(ws + WS_GATED), (const bf16*)(ws + WS_SGF)};
          pg8::gemm_phase<EpiGate<false>, pg8::StaticOrder>(X.lds, g, S, E); }
        { pg8::Gemm g{(const bf16*)((unsigned char*)X.out + OUT_ONSA), (const bf16*)(ws + WS_WNSA), 512};
          EpiGate<true> E{(bf16*)(ws + WS_GATED), (const bf16*)(ws + WS_SGN)};
          pg8::gemm_phase<EpiGate<true>, pg8::StaticOrder>(X.lds, g, S, E); }
        SEAM(5);
    }
    if (IN(6)) {
        pg8::Gemm g{(const bf16*)(ws + WS_GATED), (const bf16*)(ws + WS_WMIX), 1024};
        pg8::StaticOrder S; S.init(NTOK, 1024, X.G, bid, 1024);
        EpiPlain E{(bf16*)(ws + WS_MIXED), 1024};
        pg8::gemm_phase<EpiPlain, pg8::StaticOrder>(X.lds, g, S, E);
        SEAM(6);
    }
    if (IN(7)) { phase6(args, X); SEAM(7); }
    if (IN(8)) {
        moe_tables(args, X);
        LAS const int* tab = (LAS const int*)(X.lds + TAB_OFF);
        MoeOrder S{X.G, bid, 8, 0, tab, (const int*)(ws + WS_TOKOF)};
        pg8::Gemm g{(const bf16*)((unsigned char*)X.out + OUT_H2), (const bf16*)(ws + WS_WGU), 1024};
        EpiGateUp E{(bf16*)(ws + WS_ACT), args.in[21], args.in[23], tab};
        pg8::gemm_phase<EpiGateUp, MoeOrder>(X.lds, g, S, E);
        SEAM(8);
    }
    if (IN(9)) {
        moe_tables(args, X);
        LAS const int* tab = (LAS const int*)(X.lds + TAB_OFF);
        MoeOrder S{X.G, bid, 4, 1, tab, (const int*)(ws + WS_TOKOF)};
        pg8::Gemm g{(const bf16*)(ws + WS_ACT), (const bf16*)(ws + WS_WD), 1024};
        EpiDown E{(unsigned char*)X.out, ws + WS_YSHI, args.in[25], tab, (const int*)(ws + WS_TOKOF)};
        pg8::gemm_phase<EpiDown, MoeOrder>(X.lds, g, S, E);
        SEAM(9);
    }
    if (IN(10)) { phase10(args, X); }
#undef IN
#undef SEAM
}

extern "C" void kernel_launch(void* const* d_in, const int* in_sizes, int n_in, void* d_out, int out_size, void* d_ws, size_t ws_size, hipStream_t stream) {
    static int grid = 0;
    if (grid == 0) {
        if (n_in != 26 || in_sizes[0] != NTOK * DM || out_size != NTOK * DM || ws_size < WS_END) {
            fprintf(stderr, "kernel_launch: unexpected shapes / workspace (n_in %d, ws %zu, need %zu); nothing launched\n", n_in, ws_size, (size_t)WS_END); grid = -1; return; }
        int dev = 0, cus = 0, per_cu = 0;
        if (hipGetDevice(&dev) != hipSuccess || hipDeviceGetAttribute(&cus, hipDeviceAttributeMultiprocessorCount, dev) != hipSuccess) { grid = -1; return; }
        if (hipFuncSetAttribute((const void*)fwd, hipFuncAttributeMaxDynamicSharedMemorySize, LDS_BYTES) != hipSuccess) { fprintf(stderr, "kernel_launch: hipFuncSetAttribute failed\n"); grid = -1; return; }
        if (hipOccupancyMaxActiveBlocksPerMultiprocessor(&per_cu, (const void*)fwd, 512, LDS_BYTES) != hipSuccess || per_cu < 1) { fprintf(stderr, "kernel_launch: occupancy query says %d\n", per_cu); }
        (void)hipGetLastError();
        grid = cus;
    }
    if (grid < 0) return;
    if (hipMemsetAsync((char*)d_ws + WS_CTL, 0, CTL_ZERO_BYTES, stream) != hipSuccess) return;
    Args a{};
    for (int i = 0; i < 26; ++i) a.in[i] = (const float*)d_in[i];
    a.out = (float*)d_out; a.ws = (unsigned char*)d_ws;
#if MK_N_LAUNCHES == 1
    a.ph_lo = 0; a.ph_hi = N_PHASES;
    hipLaunchKernelGGL(fwd, dim3(grid), dim3(512), LDS_BYTES, stream, a);
#else
    for (int p = 0; p < N_PHASES; ++p) { a.ph_lo = p; a.ph_hi = p + 1; hipLaunchKernelGGL(fwd, dim3(grid), dim3(512), LDS_BYTES, stream, a); }
#endif
}
```

```cpp
#include <hip/hip_runtime.h>
#include <cstdio>
#include <cstdint>

#define GAS __attribute__((address_space(1)))
#define LAS __attribute__((address_space(3)))
typedef unsigned short bf16;
typedef unsigned v4u __attribute__((ext_vector_type(4)));
typedef unsigned v2u __attribute__((ext_vector_type(2)));
typedef float f32x2 __attribute__((ext_vector_type(2)));
typedef float f32x4 __attribute__((ext_vector_type(4)));
typedef float f32x16 __attribute__((ext_vector_type(16)));
typedef short bf16x8 __attribute__((ext_vector_type(8)));
typedef short s16x4 __attribute__((ext_vector_type(4)));
typedef __bf16 bf16x2_t __attribute__((ext_vector_type(2)));

constexpr int NB = 8, SEQ = 4096, DM = 1024, NTOK = NB * SEQ;
constexpr int NPROJ = 5120;
constexpr int NEXP = 32, TOPK = 4;
constexpr float LOG2E = 1.4426950408889634f;
constexpr float QSCALE = 0.125f * 1.4426950408889634f;
constexpr float RMS_EPS = 1e-6f;
constexpr float NEGBIG = -1e30f;

__device__ __forceinline__ unsigned pk2(float lo, float hi) { f32x2 v = {lo, hi}; bf16x2_t b = __builtin_convertvector(v, bf16x2_t); return __builtin_bit_cast(unsigned, b); }
__device__ __forceinline__ float bf_lo(unsigned u) { return __builtin_bit_cast(float, u << 16); }
__device__ __forceinline__ float bf_hi(unsigned u) { return __builtin_bit_cast(float, u & 0xffff0000u); }
__device__ __forceinline__ float wave_sum(float v) {
#pragma unroll
    for (int o = 1; o < 64; o <<= 1) v += __shfl_xor(v, o);
    return v;
}
__device__ __forceinline__ float sigmoidf_(float x) { return 1.f / (1.f + __expf(-x)); }
#define LDS_WAIT() asm volatile("s_waitcnt lgkmcnt(0)" ::: "memory")
#define VM_WAIT() asm volatile("s_waitcnt vmcnt(0)" ::: "memory")

namespace pg8 {
#define PG8_LAS __attribute__((address_space(3)))
typedef unsigned short bf16_t;
typedef unsigned u32x4 __attribute__((ext_vector_type(4)));
constexpr int BM = 256, BK = 64, HALF = 128, HTB = HALF * BK * 2  , STAGE_BYTES = 8 * HTB, NXCD = 8, WGM = 8;

__host__ __device__ __forceinline__ int lds_byte(int r, int c) { const int st = (r >> 4) * 2 + (c >> 5), rr = r & 15, cc = c & 31, ob = rr * 64 + cc * 2; return st * 1024 + (ob ^ (((ob >> 9) & 1) << 5)); }
__host__ __device__ __forceinline__ void stage_rc(int b, int& R, int& C) { const int st = b / 1024, sb = b % 1024, swz = sb ^ (((sb >> 9) & 1) << 5); R = (st >> 1) * 16 + swz / 64; C = (st & 1) * 32 + (swz % 64) / 2; }
__host__ __device__ __forceinline__ int perm32(int rho) { const int n = rho >> 4, i = rho & 15; return 8 * (i >> 2) + 4 * n + (i & 3); }

struct Unit { int pm, pn, e, rt; };
struct Gemm { const bf16_t* A; const bf16_t* Bt; int K; };

struct StaticOrder {
    int nM, nN, nwg, G, c, lda2;
    __device__ void init(int M, int N, int G_, int c_, int lda_elems) { nM = M / BM; nN = N / BM; nwg = nM * nN; G = G_; c = c_; lda2 = lda_elems * 2; }
    __device__ bool next(int i, Unit& u) const {
        const long L = (long)i * G + c; if (L >= nwg) return false;
        int wgid = (int)L; { const int q = nwg / NXCD, r = nwg % NXCD, xcd = wgid % NXCD, off = wgid / NXCD; wgid = (xcd < r ? xcd * (q + 1) : r * (q + 1) + (xcd - r) * q) + off; }
        const int nig = WGM * nN, gid = wgid / nig, fm = gid * WGM, gsz = (nM - fm) < WGM ? (nM - fm) : WGM;
        u.pm = fm + ((wgid % nig) % gsz); u.pn = (wgid % nig) / gsz; u.e = 0; u.rt = 0; return true;
    }
    __device__ __forceinline__ unsigned a_off(const Unit& u, int r) const { return (unsigned)(u.pm * BM + r) * (unsigned)lda2; }
};

template <class Epi, class Sched, bool ALIGN_EPI = true>
__device__ __forceinline__ void gemm_phase(PG8_LAS unsigned char* lds, const Gemm g, const Sched& S, const Epi& E) {
    const int tid = threadIdx.x, wid = __builtin_amdgcn_readfirstlane(tid >> 6), lane = tid & 63, wr = wid >> 2, wc = wid & 3, fr = lane & 15, fq = lane >> 4;
    const int K = g.K, nt = K / BK;
    int RA[2], CA2[2]; unsigned voffB[2];
#pragma unroll
    for (int i = 0; i < 2; ++i) { int R, C; stage_rc(tid * 16 + i * 8192, R, C); const int Rb = (R & ~31) + perm32(R & 31);
        RA[i] = R; CA2[i] = C * 2; voffB[i] = (unsigned)(Rb * K + C) * 2u; }
    const size_t kstep = (size_t)(BK * 2);
    const size_t hstep = (size_t)HALF * K * 2;
    const size_t tstep = 2 * hstep;
    const unsigned ldsw = (unsigned)wid * 1024u;
    const int aoff = lds_byte(wr * 64 + fr, fq * 8), boff = lds_byte(wc * 32 + fr, fq * 8);
#define PG8_SA(b, h) (((b) * 2 + (h)) * HTB)
#define PG8_SB(b, h) ((4 + (b) * 2 + (h)) * HTB)
#define PG8_STAGE(bufoff, gbase, voff) do { _Pragma("unroll") for (int _i = 0; _i < 2; ++_i) \
        __builtin_amdgcn_global_load_lds((const unsigned*)((const char*)(gbase) + (voff)[_i]), (PG8_LAS unsigned*)(lds + (bufoff) + ldsw + _i * 8192), 16, 0, 0); } while (0)
#define PG8_LDA(dst, b, h) do { _Pragma("unroll") for (int m = 0; m < 4; ++m) _Pragma("unroll") for (int k = 0; k < 2; ++k) dst[m][k] = *(const PG8_LAS bf16x8*)(lds + PG8_SA(b, h) + aoff + m * 2048 + k * 1024); } while (0)
#define PG8_LDB(dst, b, h) do { _Pragma("unroll") for (int n = 0; n < 2; ++n) _Pragma("unroll") for (int k = 0; k < 2; ++k) dst[n][k] = *(const PG8_LAS bf16x8*)(lds + PG8_SB(b, h) + boff + n * 2048 + k * 1024); } while (0)
#define PG8_MMA(ai, bj, At, Bt) do { __builtin_amdgcn_s_setprio(1); _Pragma("unroll") for (int m = 0; m < 4; ++m) _Pragma("unroll") for (int n = 0; n < 2; ++n) _Pragma("unroll") for (int k = 0; k < 2; ++k) \
        acc[ai][bj][m][n] = __builtin_amdgcn_mfma_f32_16x16x32_bf16(Bt[n][k], At[m][k], acc[ai][bj][m][n], 0, 0, 0); __builtin_amdgcn_s_setprio(0); } while (0)
#define PG8_WAIT_V(n) asm volatile("s_waitcnt vmcnt(" #n ")" ::: "memory")
#define PG8_WAIT_L(n) asm volatile("s_waitcnt lgkmcnt(" #n ")" ::: "memory")
#define PG8_BAR __builtin_amdgcn_s_barrier()
#define PG8_SCHED __builtin_amdgcn_sched_barrier(0)
    Unit cur, nxt; int ui = 0;
    if (!S.next(0, cur)) return;
    f32x4 acc[2][2][4][2];
#pragma unroll
    for (int a = 0; a < 2; ++a)
#pragma unroll
        for (int b = 0; b < 2; ++b)
#pragma unroll
            for (int m = 0; m < 4; ++m)
#pragma unroll
                for (int n = 0; n < 2; ++n) acc[a][b][m][n] = (f32x4){0.f, 0.f, 0.f, 0.f};
    bf16x8 At[4][2], B0[2][2], B1[2][2];
    const char* gA = (const char*)g.A;
    unsigned oc0[2], oc1[2], on0[2], on1[2];
#pragma unroll
    for (int i = 0; i < 2; ++i) { oc0[i] = S.a_off(cur, RA[i]) + CA2[i]; oc1[i] = S.a_off(cur, HALF + RA[i]) + CA2[i]; }
    const char* cB = (const char*)g.Bt + (size_t)cur.pn * tstep;
    PG8_STAGE(PG8_SB(0, 0), cB, voffB); PG8_STAGE(PG8_SB(0, 1), cB + hstep, voffB); PG8_STAGE(PG8_SA(0, 0), gA, oc0); PG8_STAGE(PG8_SA(0, 1), gA, oc1);
    if (wr == 1) PG8_BAR;
    PG8_WAIT_V(2); PG8_BAR;
    PG8_STAGE(PG8_SB(1, 0), cB + kstep, voffB); PG8_STAGE(PG8_SA(1, 0), gA + kstep, oc0); PG8_STAGE(PG8_SB(1, 1), cB + hstep + kstep, voffB);
    PG8_WAIT_V(6); PG8_BAR;
    for (;;) {
        const bool has_next = S.next(ui + 1, nxt);
        if (has_next) {
#pragma unroll
            for (int i = 0; i < 2; ++i) { on0[i] = S.a_off(nxt, RA[i]) + CA2[i]; on1[i] = S.a_off(nxt, HALF + RA[i]) + CA2[i]; }
        } else {
#pragma unroll
            for (int i = 0; i < 2; ++i) { on0[i] = oc0[i]; on1[i] = oc1[i]; }
        }
        const char* nB = has_next ? (const char*)g.Bt + (size_t)nxt.pn * tstep : cB;
        for (int t = 0; t < nt; t += 2) {
            const bool last = (t == nt - 2);
            const char* a1 = gA + (size_t)(t + 1) * kstep;
            const char* a2 = last ? gA : gA + (size_t)(t + 2) * kstep; const char* b2 = last ? nB : cB + (size_t)(t + 2) * kstep;
            const char* a3 = a2 + kstep; const char* b3 = b2 + kstep;
            unsigned s0[2], s1[2];
#pragma unroll
            for (int i = 0; i < 2; ++i) { s0[i] = last ? on0[i] : oc0[i]; s1[i] = last ? on1[i] : oc1[i]; }
            PG8_LDB(B0, 0, 0); PG8_LDB(B1, 0, 1); PG8_SCHED; PG8_LDA(At, 0, 0); PG8_STAGE(PG8_SA(1, 1), a1, oc1);
            PG8_WAIT_V(8); PG8_WAIT_L(0); PG8_BAR; PG8_MMA(0, 0, At, B0); PG8_MMA(0, 1, At, B1); PG8_BAR; PG8_SCHED;
            PG8_LDA(At, 0, 1); PG8_STAGE(PG8_SB(0, 0), b2, voffB); PG8_STAGE(PG8_SB(0, 1), b2 + hstep, voffB); PG8_STAGE(PG8_SA(0, 0), a2, s0);
            PG8_WAIT_V(8); PG8_WAIT_L(0); PG8_BAR; PG8_MMA(1, 0, At, B0); PG8_MMA(1, 1, At, B1); PG8_BAR; PG8_SCHED;
            PG8_LDB(B0, 1, 0); PG8_LDB(B1, 1, 1); PG8_SCHED; PG8_LDA(At, 1, 0); PG8_STAGE(PG8_SA(0, 1), a2, s1);
            PG8_WAIT_V(8); PG8_WAIT_L(0); PG8_BAR; PG8_MMA(0, 0, At, B0); PG8_MMA(0, 1, At, B1); PG8_BAR; PG8_SCHED;
            PG8_LDA(At, 1, 1); PG8_STAGE(PG8_SB(1, 0), b3, voffB); PG8_STAGE(PG8_SB(1, 1), b3 + hstep, voffB); PG8_STAGE(PG8_SA(1, 0), a3, s0);
            PG8_WAIT_V(8); PG8_WAIT_L(0); PG8_BAR; PG8_MMA(1, 0, At, B0); PG8_MMA(1, 1, At, B1); PG8_BAR; PG8_SCHED;
        }
        if constexpr (ALIGN_EPI) { if (wr == 0) PG8_BAR; }
        E(acc, cur, wr, wc, fr, fq);
        if (!has_next) break;
#pragma unroll
        for (int a = 0; a < 2; ++a)
#pragma unroll
            for (int b = 0; b < 2; ++b)
#pragma unroll
                for (int m = 0; m < 4; ++m)
#pragma unroll
                    for (int n = 0; n < 2; ++n) acc[a][b][m][n] = (f32x4){0.f, 0.f, 0.f, 0.f};
        cur = nxt; cB = nB; ++ui;
#pragma unroll
        for (int i = 0; i < 2; ++i) { oc0[i] = on0[i]; oc1[i] = on1[i]; }
        if constexpr (ALIGN_EPI) { if (wr == 1) PG8_BAR; }
    }
    PG8_WAIT_V(0);
    if constexpr (!ALIGN_EPI) { if (wr == 0) PG8_BAR; }
    PG8_BAR;
#undef PG8_SA
#undef PG8_SB
#undef PG8_STAGE
#undef PG8_LDA
#undef PG8_LDB
#undef PG8_MMA
#undef PG8_WAIT_V
#undef PG8_WAIT_L
#undef PG8_BAR
#undef PG8_SCHED
}
}

#define XB_TMO      128
#define XB_XCNT(j)  (256  + 64 * (j))
#define XB_XSUB(j)  (1280 + 64 * (j))
#define XB_XGEN(j)  (2304 + 64 * (j))
#define XB_TOP      3328
#define XB_TOPGEN   3392
#define XCD_BAR_WORDS 3456
#define XB_SPIN_CAP (1u << 18)

__device__ __forceinline__ unsigned xb_ld(unsigned* p)              { return __hip_atomic_load(p, __ATOMIC_RELAXED, __HIP_MEMORY_SCOPE_AGENT); }
__device__ __forceinline__ unsigned xb_add(unsigned* p, unsigned v) { return __hip_atomic_fetch_add(p, v, __ATOMIC_RELAXED, __HIP_MEMORY_SCOPE_AGENT); }
__device__ __forceinline__ unsigned xb_xcc_id() { return (unsigned)__builtin_amdgcn_s_getreg((3 << 11) | 20) & 0xFu; }
#define XB_SPIN(cond, bar) do { unsigned _sp = 0; while (cond) { __builtin_amdgcn_s_sleep(1); \
    if ((++_sp & 255u) == 0u) { if (xb_ld(&(bar)[XB_TMO])) break; if (_sp > XB_SPIN_CAP) { atomicAdd(&(bar)[XB_TMO], 1u); break; } } } } while (0)

struct XcdBarrier {
    unsigned* bar; unsigned x;
    volatile LAS unsigned* st;
};

__device__ __forceinline__ XcdBarrier xcd_barrier_post(unsigned* bar, volatile LAS unsigned* st) {
    XcdBarrier b; b.bar = bar; b.x = xb_xcc_id(); b.st = st;
    if (threadIdx.x == 0) (void)xb_add(&bar[XB_XCNT(b.x)], 1u);
    return b;
}
__device__ __forceinline__ void xcd_barrier_complete(unsigned* bar, unsigned x, unsigned& nloc, unsigned& nx) {
    const unsigned G = gridDim.x * gridDim.y * gridDim.z;
    unsigned sum, cnt, mine, sp = 0u;
    for (;;) {
        sum = 0u; cnt = 0u; mine = 0u;
#pragma unroll
        for (unsigned j = 0; j < 16; ++j) { const unsigned c = xb_ld(&bar[XB_XCNT(j)]); sum += c; cnt += (c > 0u) ? 1u : 0u; mine = (j == x) ? c : mine; }
        if (sum == G) break;
        __builtin_amdgcn_s_sleep(1);
        if ((++sp & 255u) == 0u) { if (xb_ld(&bar[XB_TMO])) break; if (sp > XB_SPIN_CAP) { atomicAdd(&bar[XB_TMO], 1u); break; } }
    }
    nloc = mine > 0u ? mine : 1u; nx = cnt > 0u ? cnt : 1u;
}

__device__ __forceinline__ void xcd_barrier(const XcdBarrier& b) {
    asm volatile("s_waitcnt vmcnt(0)" ::: "memory");
    __syncthreads();
    if (threadIdx.x == 0) {
        unsigned* bar = b.bar;
        __builtin_amdgcn_s_waitcnt(0);
        unsigned nloc = b.st[0], nx = b.st[1];
        if (nloc == 0u) { xcd_barrier_complete(bar, b.x, nloc, nx); b.st[0] = nloc; b.st[1] = nx; }
        const unsigned old = xb_add(&bar[XB_XSUB(b.x)], 1u);
        const unsigned gen = old / nloc;
        if (old + 1u == (gen + 1u) * nloc) {
            __builtin_amdgcn_fence(__ATOMIC_RELEASE, "agent");
            asm volatile("s_waitcnt vmcnt(0)" ::: "memory");
            const unsigned og = xb_add(&bar[XB_TOP], 1u);
            const unsigned tg = og / nx;
            if (og + 1u == (tg + 1u) * nx) xb_add(&bar[XB_TOPGEN], 1u);
            else XB_SPIN(xb_ld(&bar[XB_TOPGEN]) == tg, bar);
            __builtin_amdgcn_fence(__ATOMIC_ACQUIRE, "agent");
            xb_add(&bar[XB_XGEN(b.x)], 1u);
            asm volatile("s_waitcnt vmcnt(0)" ::: "memory");
        } else {
            XB_SPIN(xb_ld(&bar[XB_XGEN(b.x)]) == gen, bar);
            __builtin_amdgcn_fence(__ATOMIC_ACQUIRE, "agent");
            asm volatile("s_waitcnt vmcnt(0)" ::: "memory");
        }
    }
    __syncthreads();
}

#ifndef DUP_MASK
#define DUP_MASK 0
#endif
#define REP(k) for (int rep_ = 0; rep_ < ((((DUP_MASK) >> (k)) & 1) + 1); ++rep_)

constexpr size_t MiB = 1u << 20;
constexpr size_t WS_CTL = 0, CTL_ZERO_BYTES = 1 * MiB;
constexpr size_t WS_ADAP = 1 * MiB;
constexpr size_t WS_ADA = 4 * MiB;
constexpr size_t WS_CB = 4 * MiB + 512 * 1024;
constexpr size_t WS_LOGF = 5 * MiB;
constexpr size_t WS_GATES = 6 * MiB;
constexpr size_t WS_KBIAS = 9 * MiB;
constexpr size_t WS_KC = 10 * MiB, WS_VC = 10 * MiB + 512 * 1024;
constexpr size_t WS_WRT = 11 * MiB;
constexpr size_t WS_WCK = 11 * MiB + 256 * 1024, WS_WCV = 11 * MiB + 512 * 1024;
constexpr size_t WS_TOPE = 12 * MiB, WS_TOPW = 12 * MiB + 512 * 1024, WS_RANK = 13 * MiB;
constexpr size_t WS_TOKOF = 14 * MiB;
constexpr size_t WS_WFOX = 18 * MiB, WS_WNSA = 19 * MiB, WS_WMIX = 20 * MiB, WS_WIN = 22 * MiB;
constexpr size_t WS_WD = 32 * MiB;
constexpr size_t WS_WGU = 96 * MiB;
constexpr size_t WS_YSHI = 96 * MiB;
constexpr size_t WS_FQ = 224 * MiB, WS_FK = 256 * MiB, WS_FV = 288 * MiB, WS_NQ = 320 * MiB;
constexpr size_t WS_KV6 = 352 * MiB;
constexpr size_t WS_SGF = 400 * MiB, WS_SGN = 464 * MiB;
constexpr size_t WS_MIXED = 224 * MiB;
constexpr size_t WS_GATED = 288 * MiB;
constexpr size_t WS_ACT = 288 * MiB;
constexpr size_t WS_END = 544 * MiB;
constexpr size_t OUT_H = 0, OUT_OFOX = 64 * MiB, OUT_ONSA = 96 * MiB, OUT_H2 = 0, OUT_H2LO = 64 * MiB;
constexpr size_t KV6_STRIDE = (size_t)NTOK * 128;

constexpr int CW_TMO = 0;
constexpr int CW_BAR = 4096;
constexpr int CW_ECNT = 32768;

constexpr int RING_BYTES = 131072;
constexpr int MISC_OFF = 131072;
constexpr int TAB_OFF = 131072 + 256;
constexpr int LDS_BYTES = 147456;

__device__ const unsigned char T5_BUCKET[128] = {
 0,1,2,3,4,5,6,7,8,9,10,11,12,13,14,15,16,16,16,17,17,18,18,18,19,19,19,20,20,20,20,21,21,21,21,22,22,22,22,22,23,23,23,23,23,23,24,24,24,24,24,24,25,25,25,25,25,25,25,26,26,26,26,26,26,26,26,
 27,27,27,27,27,27,27,27,27,27,28,28,28,28,28,28,28,28,28,28,29,29,29,29,29,29,29,29,29,29,29,29,30,30,30,30,30,30,30,30,30,30,30,30,30,30,31,31,31,31,31,31,31,31,31,31,31,31,31,31,31};

struct Args { const float* in[26]; float* out; unsigned char* ws; int ph_lo, ph_hi; };
struct Ctx {
    float* out; unsigned char* ws;
    LAS unsigned char* lds; int tid, lane, wave, vcu, G;
};

__device__ __forceinline__ void conv64(const float* __restrict__ W, size_t ldw, int col, int k0, bf16* __restrict__ dst) {
#pragma unroll
    for (int h = 0; h < 2; ++h) {
        float v[32];
#pragma unroll
        for (int kk = 0; kk < 32; ++kk) v[kk] = W[(size_t)(k0 + h * 32 + kk) * ldw + col];
#pragma unroll
        for (int q = 0; q < 4; ++q) { v4u o; o.x = pk2(v[8 * q], v[8 * q + 1]); o.y = pk2(v[8 * q + 2], v[8 * q + 3]); o.z = pk2(v[8 * q + 4], v[8 * q + 5]); o.w = pk2(v[8 * q + 6], v[8 * q + 7]);
            *(v4u*)(dst + h * 32 + q * 8) = o; }
    }
}
__device__ __forceinline__ void conv_item(const float* W, size_t ldw, int col0, int ncb, bf16* WT, int Kd, int dst_row0, int r, int lane) {
    const int cbk = r % ncb, kb = r / ncb;
    conv64(W, ldw, col0 + cbk * 64 + lane, kb * 64, WT + (size_t)(dst_row0 + cbk * 64 + lane) * Kd + kb * 64);
}

__device__ __forceinline__ void phase0a(const Args& A, const Ctx& X) {
    const float* c = A.in[1]; const float* w_ada = A.in[2]; const float* w_in = A.in[6];
    LAS float* sl = (LAS float*)X.lds;
    for (int i = X.tid; i < 8192; i += 512) { const float v = c[i]; sl[i] = v / (1.f + __expf(-v)); }
    __syncthreads();
    const int gw = X.vcu * 8 + X.wave, NGW = X.G * 8, lane = X.lane;
    unsigned char* ws = X.ws;
    bf16* WIN = (bf16*)(ws + WS_WIN);
    constexpr int J_ADA = 96 * 16, J_INA = 24 * 16, J_INB = 20 * 16, J_INC = 32 * 16, J_IND = 256, J_FOX = 16 * 8, J_NSA = 16 * 8, J_MIX = 16 * 16, J_CK = 32, J_CV = 32, J_RT = 32, J_CB = 128;
    constexpr int J_EXP = 32 * 256;
    constexpr int NITEMS = J_ADA + J_INA + J_INB + J_INC + J_IND + J_FOX + J_NSA + J_MIX + J_CK + J_CV + J_RT + J_CB + 3 * J_EXP;
    for (int it = gw; it < NITEMS; it += NGW) {
        int r = it;
        if (r < J_ADA) {
            const int cb = r % 96, ks = r / 96, j = cb * 64 + lane; float acc[8];
#pragma unroll
            for (int b = 0; b < 8; ++b) acc[b] = 0.f;
#pragma unroll 8
            for (int kk = 0; kk < 64; ++kk) { const int k = ks * 64 + kk; const float w = w_ada[(size_t)k * 6144 + j];
#pragma unroll
                for (int b = 0; b < 8; ++b) acc[b] += sl[b * 1024 + k] * w; }
            float* P = (float*)(ws + WS_ADAP);
#pragma unroll
            for (int b = 0; b < 8; ++b) P[(size_t)(ks * 8 + b) * 6144 + j] = acc[b];
            continue; }
        r -= J_ADA;
        if (r < J_INA) { conv_item(w_in, 4896, 0, 24, WIN, 1024, 0, r, lane); continue; } r -= J_INA;
        if (r < J_INB) { conv_item(w_in, 4896, 1544, 20, WIN, 1024, 1536, r, lane); continue; } r -= J_INB;
        if (r < J_INC) { conv_item(w_in, 4896, 2848, 32, WIN, 1024, 2816, r, lane); continue; } r -= J_INC;
        if (r < J_IND) {
            const int row = 4864 + r; const int col = (row < 4872) ? 1536 + (row - 4864) : (row < 4896 ? 2824 + (row - 4872) : -1);
            float v[16];
#pragma unroll
            for (int i = 0; i < 16; ++i) v[i] = (col >= 0) ? w_in[(size_t)(lane * 16 + i) * 4896 + col] : 0.f;
            v4u o0, o1; o0.x = pk2(v[0], v[1]); o0.y = pk2(v[2], v[3]); o0.z = pk2(v[4], v[5]); o0.w = pk2(v[6], v[7]); o1.x = pk2(v[8], v[9]); o1.y = pk2(v[10], v[11]); o1.z = pk2(v[12], v[13]); o1.w = pk2(v[14], v[15]);
            *(v4u*)(WIN + (size_t)row * 1024 + lane * 16) = o0; *(v4u*)(WIN + (size_t)row * 1024 + lane * 16 + 8) = o1;
            continue; }
        r -= J_IND;
        if (r < J_FOX) { conv_item(A.in[12], 1024, 0, 16, (bf16*)(ws + WS_WFOX), 512, 0, r, lane); continue; } r -= J_FOX;
        if (r < J_NSA) { conv_item(A.in[13], 1024, 0, 16, (bf16*)(ws + WS_WNSA), 512, 0, r, lane); continue; } r -= J_NSA;
        if (r < J_MIX) { conv_item(A.in[14], 1024, 0, 16, (bf16*)(ws + WS_WMIX), 1024, 0, r, lane); continue; } r -= J_MIX;
        if (r < J_CK) { conv_item(A.in[10], 64, 0, 1, (bf16*)(ws + WS_WCK), 2048, 0, r, lane); continue; } r -= J_CK;
        if (r < J_CV) { conv_item(A.in[11], 64, 0, 1, (bf16*)(ws + WS_WCV), 2048, 0, r, lane); continue; } r -= J_CV;
        if (r < J_RT) { const float* wr_ = A.in[18]; bf16* WRH = (bf16*)(ws + WS_WRT); bf16* WRL = WRH + 32 * 1024;
#pragma unroll
            for (int i = 0; i < 16; ++i) { const int k = lane + 64 * i; const float w = wr_[k * 32 + r]; const unsigned h = pk2(w, 0.f) & 0xffffu; const float hf = bf_lo(h);
                WRH[r * 1024 + k] = (bf16)h; WRL[r * 1024 + k] = (bf16)(pk2(w - hf, 0.f) & 0xffffu); }
            continue; }
        r -= J_RT;
        if (r < J_CB) { const int which = r >> 6, j = r & 63; const float* pe = A.in[8 + which]; const float* wc = A.in[10 + which]; float s = 0.f;
#pragma unroll 8
            for (int i = 0; i < 32; ++i) { const int q = lane * 32 + i; s += pe[q] * wc[q * 64 + j]; }
            s = wave_sum(s); if (lane == 0) ((float*)(ws + WS_CB))[which * 64 + j] = s;
            continue; }
        r -= J_CB;
        if (r < 2 * J_EXP) {
            const int kind = r / J_EXP, q = r % J_EXP, e = q >> 8, rr = q & 255, cbk = rr & 15, kb = rr >> 4;
            const float* W = A.in[kind ? 22 : 20] + (size_t)e * 1048576;
            const int drow = e * 2048 + (cbk >> 1) * 256 + (cbk & 1) * 64 + kind * 128 + lane;
            conv64(W, 1024, cbk * 64 + lane, kb * 64, (bf16*)(ws + WS_WGU) + (size_t)drow * 1024 + kb * 64);
            continue; }
        r -= 2 * J_EXP;
        { const int e = r >> 8, rr = r & 255, cbk = rr & 15, kb = rr >> 4;
          conv64(A.in[24] + (size_t)e * 1048576, 1024, cbk * 64 + lane, kb * 64, (bf16*)(ws + WS_WD) + (size_t)(e * 1024 + cbk * 64 + lane) * 1024 + kb * 64); }
    }
}

__device__ __forceinline__ void phase0b(const Args& A, const Ctx& X) {
    const float* P = (const float*)(X.ws + WS_ADAP); const float* b_ada = A.in[3];
    float* ADA = (float*)(X.ws + WS_ADA);
    for (int gid = blockIdx.x * 512 + X.tid; gid < 8 * 6144; gid += X.G * 512) {
        const int b = gid / 6144, col = gid % 6144; float s = b_ada[col];
#pragma unroll
        for (int ks = 0; ks < 16; ++ks) s += P[(size_t)(ks * 8 + b) * 6144 + col];
        ADA[gid] = s;
    }
    LAS float* gs = (LAS float*)X.lds;
    LAS float* sh = gs + 1024;
    const float* x = A.in[0]; const float* g = A.in[4];
    bf16* H = (bf16*)((unsigned char*)X.out + OUT_H);
    for (int ch = blockIdx.x; ch < NTOK / 128; ch += X.G) {
        const int row0 = ch * 128, b = row0 / SEQ;
        __syncthreads();
        for (int j = X.tid; j < 2048; j += 512) { float s = b_ada[j];
#pragma unroll
            for (int ks = 0; ks < 16; ++ks) s += P[(size_t)(ks * 8 + b) * 6144 + j];
            if (j < 1024) sh[j] = s; else gs[j - 1024] = g[j - 1024] * (1.f + s); }
        __syncthreads();
        for (int i = 0; i < 16; ++i) {
            const int row = row0 + X.wave + 8 * i;
            const f32x4* xr = (const f32x4*)(x + (size_t)row * DM) + X.lane;
            f32x4 v[4]; float ss = 0.f;
#pragma unroll
            for (int j = 0; j < 4; ++j) { v[j] = xr[64 * j]; ss += (v[j].x * v[j].x + v[j].y * v[j].y) + (v[j].z * v[j].z + v[j].w * v[j].w); }
            const float rstd = 1.f / sqrtf(wave_sum(ss) * (1.f / DM) + RMS_EPS);
            v2u* o8 = (v2u*)(H + (size_t)row * DM) + X.lane;
#pragma unroll
            for (int j = 0; j < 4; ++j) { const int k = 4 * X.lane + 256 * j; const f32x4 gg = *(LAS f32x4*)(gs + k), ss4 = *(LAS f32x4*)(sh + k);
                v2u o; o.x = pk2(v[j].x * rstd * gg.x + ss4.x, v[j].y * rstd * gg.y + ss4.y); o.y = pk2(v[j].z * rstd * gg.z + ss4.z, v[j].w * rstd * gg.w + ss4.w); o8[64 * j] = o; }
        }
    }
}

__device__ __forceinline__ void phase2(const Args& A, const Ctx& X) {
    const int lane = X.lane, wid = X.wave, r32 = lane & 31, hi = lane >> 5;
    LAS float* red = (LAS float*)X.lds;
    for (int it = blockIdx.x; it < 256; it += X.G) {
        const int cblk = it & 7, which = (it >> 3) & 1, bg = it >> 4;
        const bf16* src = (const bf16*)(X.ws + WS_KV6) + (size_t)which * KV6_STRIDE + (size_t)bg * SEQ * 64;
        const bf16* WT = (const bf16*)(X.ws + (which ? WS_WCV : WS_WCK));
        const int c0 = cblk * 32, kbase = wid * 256;
        f32x16 acc0 = {}, acc1 = {};
        const bf16* ap = src + (size_t)(16 * (c0 + r32)) * 64 + kbase + hi * 8;
        const bf16* bp0 = WT + (size_t)r32 * 2048 + kbase + hi * 8;
        const bf16* bp1 = WT + (size_t)(32 + r32) * 2048 + kbase + hi * 8;
#pragma unroll
        for (int kk = 0; kk < 16; ++kk) {
            const bf16x8 a = *(const bf16x8*)(ap + kk * 16), b0 = *(const bf16x8*)(bp0 + kk * 16), b1 = *(const bf16x8*)(bp1 + kk * 16);
            acc0 = __builtin_amdgcn_mfma_f32_32x32x16_bf16(a, b0, acc0, 0, 0, 0);
            acc1 = __builtin_amdgcn_mfma_f32_32x32x16_bf16(a, b1, acc1, 0, 0, 0);
        }
        __syncthreads();
#pragma unroll
        for (int r = 0; r < 16; ++r) { const int row = (r & 3) + 8 * (r >> 2) + 4 * hi; red[(wid * 32 + row) * 64 + r32] = acc0[r]; red[(wid * 32 + row) * 64 + 32 + r32] = acc1[r]; }
        __syncthreads();
        { const int c = X.tid >> 4, n4 = (X.tid & 15) * 4; f32x4 s = *(const f32x4*)((const float*)(X.ws + WS_CB) + which * 64 + n4);
#pragma unroll
          for (int w = 0; w < 8; ++w) s += *(LAS f32x4*)(red + (w * 32 + c) * 64 + n4);
          if (c0 + c == 255) s = (f32x4){0.f, 0.f, 0.f, 0.f};
          v2u o; o.x = pk2(s.x, s.y); o.y = pk2(s.z, s.w);
          *(v2u*)((bf16*)(X.ws + (which ? WS_VC : WS_KC)) + ((size_t)bg * 256 + c0 + c) * 64 + n4) = o; }
    }
    for (int sq = blockIdx.x; sq < 64; sq += X.G) {
        const int b = sq >> 3, h = sq & 7; const float* lf = (const float*)(X.ws + WS_LOGF) + (size_t)b * SEQ * 8 + h;
        float v[8];
#pragma unroll
        for (int i = 0; i < 8; ++i) v[i] = lf[(size_t)(X.tid * 8 + i) * 8];
#pragma unroll
        for (int i = 1; i < 8; ++i) v[i] += v[i - 1];
        float incl = v[7];
#pragma unroll
        for (int o = 1; o < 64; o <<= 1) { const float t = __shfl_up(incl, o); if (lane >= o) incl += t; }
        __syncthreads();
        if (lane == 63) red[wid] = incl;
        __syncthreads();
        float pre = incl - v[7];
        for (int w = 0; w < wid; ++w) pre += red[w];
        float* kb = (float*)(X.ws + WS_KBIAS) + (size_t)sq * SEQ + X.tid * 8;
        *(f32x4*)kb = (f32x4){-(pre + v[0]) * LOG2E, -(pre + v[1]) * LOG2E, -(pre + v[2]) * LOG2E, -(pre + v[3]) * LOG2E};
        *(f32x4*)(kb + 4) = (f32x4){-(pre + v[4]) * LOG2E, -(pre + v[5]) * LOG2E, -(pre + v[6]) * LOG2E, -(pre + v[7]) * LOG2E};
    }
}

__device__ __forceinline__ v4u pack8(const f32x4 a, const f32x4 b) { v4u w; w.x = pk2(a[0], a[1]); w.y = pk2(a[2], a[3]); w.z = pk2(b[0], b[1]); w.w = pk2(b[2], b[3]); return w; }

struct EpiInProj {
    unsigned char* ws; const float* b_forget;
    __device__ __forceinline__ void operator()(const f32x4 (&acc)[2][2][4][2], const pg8::Unit& u, int wr, int wc, int fr, int fq) const {
        part<0>(acc, u, wr, wc, fr, fq); part<1>(acc, u, wr, wc, fr, fq);
    }
    template <int bj> __device__ __forceinline__ void part(const f32x4 (&acc)[2][2][4][2], const pg8::Unit& u, int wr, int wc, int fr, int fq) const {
        const int row0 = u.pm * 256 + wr * 64 + fr, b = (u.pm * 256) >> 12;
        {
            const int cb = u.pn * 256 + bj * 128 + wc * 32;
            if (cb >= 4896) return;
            if (cb < 4864) {
                bf16* base; int pitch; float scl = 1.f; bool sig = false;
                if (cb < 2048) { const int tt = cb >> 9, head = (cb & 511) >> 6; if (tt == 0 || tt == 3) scl = QSCALE; pitch = 64;
                    base = (bf16*)(ws + WS_FQ) + (size_t)tt * ((size_t)NTOK * 512) + ((size_t)(b * 7 + head) * SEQ) * 64 + (cb & 63) + 8 * fq; }
                else if (cb < 2816) { const int q = cb - 2048, idx6 = q >> 7, grp = (q & 127) >> 6; pitch = 64;
                    base = (bf16*)(ws + WS_KV6) + (size_t)idx6 * KV6_STRIDE + ((size_t)(b + grp) * SEQ) * 64 + (cb & 63) + 8 * fq; }
                else { const int q = cb - 2816, which = q >> 10; pitch = 1024; sig = true; base = (bf16*)(ws + (which ? WS_SGN : WS_SGF)) + (q & 1023) + 8 * fq; }
#pragma unroll
                for (int ai = 0; ai < 2; ++ai)
#pragma unroll
                    for (int m = 0; m < 4; ++m) {
                        const int row = row0 + ai * 128 + m * 16;
                        f32x4 v0 = acc[ai][bj][m][0], v1 = acc[ai][bj][m][1];
                        if (sig) {
#pragma unroll
                            for (int i = 0; i < 4; ++i) { v0[i] = sigmoidf_(v0[i]); v1[i] = sigmoidf_(v1[i]); }
                        } else { v0 = v0 * scl; v1 = v1 * scl; }
                        *(v4u*)(base + (size_t)row * pitch) = pack8(v0, v1);
                    }
            } else {
#pragma unroll
                for (int ai = 0; ai < 2; ++ai)
#pragma unroll
                    for (int m = 0; m < 4; ++m) {
                        const int row = row0 + ai * 128 + m * 16;
                        const f32x4 v0 = acc[ai][bj][m][0], v1 = acc[ai][bj][m][1]; f32x4 o0, o1;
                        if (fq == 0) {
#pragma unroll
                            for (int i = 0; i < 4; ++i) { const float z0 = v0[i] + b_forget[i], z1 = v1[i] + b_forget[4 + i];
                                o0[i] = fminf(z0, 0.f) - log1pf(__expf(-fabsf(z0))); o1[i] = fminf(z1, 0.f) - log1pf(__expf(-fabsf(z1))); }
                        } else {
#pragma unroll
                            for (int i = 0; i < 4; ++i) { o0[i] = sigmoidf_(v0[i]); o1[i] = sigmoidf_(v1[i]); }
                        }
                        float* dst = (fq == 0) ? (float*)(ws + WS_LOGF) + (size_t)row * 8 : (float*)(ws + WS_GATES) + (size_t)row * 24 + 8 * (fq - 1);
                        *(f32x4*)dst = o0; *(f32x4*)(dst + 4) = o1;
                    }
            }
        }
    }
};

template <bool ADD> struct EpiGate {
    bf16* O; const bf16* SG;
    __device__ __forceinline__ void operator()(const f32x4 (&acc)[2][2][4][2], const pg8::Unit& u, int wr, int wc, int fr, int fq) const {
#pragma unroll
        for (int ai = 0; ai < 2; ++ai)
#pragma unroll
            for (int m = 0; m < 4; ++m)
#pragma unroll
                for (int bj = 0; bj < 2; ++bj) {
                    const size_t off = (size_t)(u.pm * 256 + ai * 128 + wr * 64 + m * 16 + fr) * 1024 + u.pn * 256 + bj * 128 + wc * 32 + 8 * fq;
                    const v4u g = *(const v4u*)(SG + off);
                    f32x4 v0 = acc[ai][bj][m][0], v1 = acc[ai][bj][m][1];
                    v0[0] *= bf_lo(g.x); v0[1] *= bf_hi(g.x); v0[2] *= bf_lo(g.y); v0[3] *= bf_hi(g.y); v1[0] *= bf_lo(g.z); v1[1] *= bf_hi(g.z); v1[2] *= bf_lo(g.w); v1[3] *= bf_hi(g.w);
                    if (ADD) { const v4u p = *(const v4u*)(O + off);
                        v0[0] += bf_lo(p.x); v0[1] += bf_hi(p.x); v0[2] += bf_lo(p.y); v0[3] += bf_hi(p.y); v1[0] += bf_lo(p.z); v1[1] += bf_hi(p.z); v1[2] += bf_lo(p.w); v1[3] += bf_hi(p.w); }
                    *(v4u*)(O + off) = pack8(v0, v1);
                }
    }
};

struct EpiPlain {
    bf16* O; int ldc;
    __device__ __forceinline__ void operator()(const f32x4 (&acc)[2][2][4][2], const pg8::Unit& u, int wr, int wc, int fr, int fq) const {
#pragma unroll
        for (int ai = 0; ai < 2; ++ai)
#pragma unroll
            for (int m = 0; m < 4; ++m)
#pragma unroll
                for (int bj = 0; bj < 2; ++bj) {
                    const size_t off = (size_t)(u.pm * 256 + ai * 128 + wr * 64 + m * 16 + fr) * ldc + u.pn * 256 + bj * 128 + wc * 32 + 8 * fq;
                    *(v4u*)(O + off) = pack8(acc[ai][bj][m][0], acc[ai][bj][m][1]);
                }
    }
};

struct MoeOrder {
    int G, c, NP, mode;
    LAS const int* tab; const int* tokof;
    __device__ __forceinline__ bool next(int i, pg8::Unit& u) const {
        const int L = i * G + c, ntile = tab[32 + 32];
        if (L >= ntile * NP) return false;
        const int ti = L / NP, pnl = L % NP; int e = 0;
#pragma unroll 1
        for (int k = 1; k < 32; ++k) e = (tab[32 + k] <= ti) ? k : e;
        u.e = e; u.rt = ti - tab[32 + e]; u.pm = ti; u.pn = e * NP + pnl; return true;
    }
    __device__ __forceinline__ unsigned a_off(const pg8::Unit& u, int r) const {
        const int cnt = tab[u.e]; int rank = u.rt * 256 + r; rank = rank < cnt ? rank : cnt - 1;
        if (mode == 0) { const int id = tokof[(size_t)u.e * NTOK + rank]; return (unsigned)(id >> 2) * 2048u; }
        return (unsigned)(tab[65 + u.e] + rank) * 2048u;
    }
};
__device__ __forceinline__ void moe_tables(const Args& A, const Ctx& X) {
    LAS int* tab = (LAS int*)(X.lds + TAB_OFF);
    __syncthreads();
    if (X.tid == 0) { const unsigned* ctl = (const unsigned*)(X.ws + WS_CTL); int ts = 0, gs = 0;
        for (int e = 0; e < 32; ++e) { const int cnt = (int)__hip_atomic_load(ctl + CW_ECNT + 64 * e, __ATOMIC_RELAXED, __HIP_MEMORY_SCOPE_AGENT); tab[e] = cnt; tab[32 + e] = ts; tab[65 + e] = gs; ts += (cnt + 255) >> 8; gs += cnt; }
        tab[32 + 32] = ts; tab[65 + 32] = gs; }
    __syncthreads();
}

struct EpiGateUp {
    bf16* ACT; const float* bg; const float* bu; LAS const int* tab;
    __device__ __forceinline__ void operator()(const f32x4 (&acc)[2][2][4][2], const pg8::Unit& u, int wr, int wc, int fr, int fq) const {
        const int e = u.e, pnl = u.pn - e * 8, col = pnl * 128 + wc * 32 + 8 * fq, cnt = tab[e], gs = tab[65 + e];
        const f32x4 g0 = *(const f32x4*)(bg + e * 1024 + col), g1 = *(const f32x4*)(bg + e * 1024 + col + 4), u0 = *(const f32x4*)(bu + e * 1024 + col), u1 = *(const f32x4*)(bu + e * 1024 + col + 4);
#pragma unroll
        for (int ai = 0; ai < 2; ++ai)
#pragma unroll
            for (int m = 0; m < 4; ++m) {
                const int rank = u.rt * 256 + ai * 128 + wr * 64 + m * 16 + fr;
                f32x4 a0 = acc[ai][0][m][0] + g0, a1 = acc[ai][0][m][1] + g1, b0 = acc[ai][1][m][0] + u0, b1 = acc[ai][1][m][1] + u1, o0, o1;
#pragma unroll
                for (int i = 0; i < 4; ++i) {
                    float gt = fminf(a0[i], 7.f), up = fminf(fmaxf(b0[i], -7.f), 7.f); o0[i] = gt * sigmoidf_(1.702f * gt) * (up + 1.f);
                    gt = fminf(a1[i], 7.f); up = fminf(fmaxf(b1[i], -7.f), 7.f); o1[i] = gt * sigmoidf_(1.702f * gt) * (up + 1.f); }
                if (rank < cnt) *(v4u*)(ACT + (size_t)(gs + rank) * 1024 + col) = pack8(o0, o1);
            }
    }
};
struct EpiDown {
    unsigned char* out; unsigned char* yshi; const float* bd; LAS const int* tab; const int* tokof;
    __device__ __forceinline__ void operator()(const f32x4 (&acc)[2][2][4][2], const pg8::Unit& u, int wr, int wc, int fr, int fq) const {
        const int e = u.e, pnl = u.pn - e * 4, cnt = tab[e];
#pragma unroll
        for (int ai = 0; ai < 2; ++ai)
#pragma unroll
            for (int m = 0; m < 4; ++m) {
                const int rank = u.rt * 256 + ai * 128 + wr * 64 + m * 16 + fr;
                if (rank < cnt) {
                    const int id = tokof[(size_t)e * NTOK + rank], tok = id >> 2, k = id & 3;
                    const long long dlt = (k >= 2) ? (long long)(yshi - out) : 0ll; unsigned char* rowp = out + dlt + (size_t)tok * 4096 + (k & 1) * 2048;
#pragma unroll
                    for (int bj = 0; bj < 2; ++bj) { const int col = pnl * 256 + bj * 128 + wc * 32 + 8 * fq;
                        const f32x4 b0 = *(const f32x4*)(bd + e * 1024 + col), b1 = *(const f32x4*)(bd + e * 1024 + col + 4);
                        *(v4u*)(rowp + col * 2) = pack8(acc[ai][bj][m][0] + b0, acc[ai][bj][m][1] + b1); }
                }
            }
    }
};

__device__ __forceinline__ f32x4 ld_bf4(const bf16* p) { const v2u u = *(const v2u*)p; return (f32x4){bf_lo(u.x), bf_hi(u.x), bf_lo(u.y), bf_hi(u.y)}; }

__device__ __forceinline__ void top4_of8(const float (&v)[8], const int (&id)[8], float (&ov)[4], int (&oi)[4]) {
    unsigned taken = 0u;
#pragma unroll
    for (int k = 0; k < 4; ++k) { float best = -3.4e38f; int bi = 0x7fffffff, bp = 0;
#pragma unroll
        for (int c = 0; c < 8; ++c) { const bool free_ = ((taken >> c) & 1u) == 0u; const bool better = free_ && ((v[c] > best) || (v[c] == best && id[c] < bi)); best = better ? v[c] : best; bi = better ? id[c] : bi; bp = better ? c : bp; }
        ov[k] = best; oi[k] = bi; taken |= 1u << bp; }
}

__device__ __forceinline__ void phase6(const Args& A, const Ctx& X) {
    const float* x = A.in[0]; const float* gpost = A.in[5]; const float* gpre2 = A.in[16]; const float* b_router = A.in[19];
    const float* ADA = (const float*)(X.ws + WS_ADA);
    const bf16* WRH = (const bf16*)(X.ws + WS_WRT); const bf16* WRL = WRH + 32 * 1024;
    const bf16* MIXED = (const bf16*)(X.ws + WS_MIXED); bf16* H2 = (bf16*)((unsigned char*)X.out + OUT_H2); bf16* H2L = (bf16*)((unsigned char*)X.out + OUT_H2LO);
    int* TOPE = (int*)(X.ws + WS_TOPE); float* TOPW = (float*)(X.ws + WS_TOPW); int* RANK = (int*)(X.ws + WS_RANK); int* TOKOF = (int*)(X.ws + WS_TOKOF);
    unsigned* ctl = (unsigned*)(X.ws + WS_CTL);
    LAS float* v_g1 = (LAS float*)X.lds;
    LAS float* v_g2 = v_g1 + 1024;
    LAS float* v_s2 = v_g2 + 1024;
    LAS int* e_of = (LAS int*)(v_s2 + 1024);
    LAS int* lcnt = e_of + 512;
    LAS int* lbase = lcnt + 32;
    const int lane = X.lane;
    for (int ch = blockIdx.x; ch < NTOK / 128; ch += X.G) {
        const int row0 = ch * 128, b = row0 / SEQ;
        __syncthreads();
        for (int j = X.tid; j < 1024; j += 512) { v_g1[j] = ADA[b * 6144 + 2048 + j] * gpost[j]; v_g2[j] = gpre2[j] * (1.f + ADA[b * 6144 + 4096 + j]); v_s2[j] = ADA[b * 6144 + 3072 + j]; }
        if (X.tid < 32) lcnt[X.tid] = 0;
        __syncthreads();
        const int wrow0 = row0 + X.wave * 16;
        for (int i = 0; i < 16; ++i) {
            const int row = wrow0 + i;
            f32x4 mv[4], xv[4]; float ss = 0.f;
#pragma unroll
            for (int j = 0; j < 4; ++j) { const int k = 4 * lane + 256 * j; mv[j] = ld_bf4(MIXED + (size_t)row * 1024 + k); xv[j] = *(const f32x4*)(x + (size_t)row * 1024 + k);
                ss += (mv[j].x * mv[j].x + mv[j].y * mv[j].y) + (mv[j].z * mv[j].z + mv[j].w * mv[j].w); }
            const float r1 = 1.f / sqrtf(wave_sum(ss) * (1.f / DM) + RMS_EPS); float s2 = 0.f;
#pragma unroll
            for (int j = 0; j < 4; ++j) { const int k = 4 * lane + 256 * j; const f32x4 g = *(LAS f32x4*)(v_g1 + k); xv[j] = xv[j] + g * (mv[j] * r1);
                s2 += (xv[j].x * xv[j].x + xv[j].y * xv[j].y) + (xv[j].z * xv[j].z + xv[j].w * xv[j].w); }
            const float r2 = 1.f / sqrtf(wave_sum(s2) * (1.f / DM) + RMS_EPS);
#pragma unroll
            for (int j = 0; j < 4; ++j) { const int k = 4 * lane + 256 * j; const f32x4 g = *(LAS f32x4*)(v_g2 + k), s = *(LAS f32x4*)(v_s2 + k); xv[j] = xv[j] * r2 * g + s;
                v2u o; o.x = pk2(xv[j].x, xv[j].y); o.y = pk2(xv[j].z, xv[j].w); *(v2u*)(H2 + (size_t)row * 1024 + k) = o;
                v2u ol; ol.x = pk2(xv[j].x - bf_lo(o.x), xv[j].y - bf_hi(o.x)); ol.y = pk2(xv[j].z - bf_lo(o.y), xv[j].w - bf_hi(o.y)); *(v2u*)(H2L + (size_t)row * 1024 + k) = ol; }
        }
        asm volatile("s_waitcnt vmcnt(0)" ::: "memory");
        f32x4 acc0 = {0.f, 0.f, 0.f, 0.f}, acc1 = {0.f, 0.f, 0.f, 0.f};
        { const int q = lane >> 4, t16 = lane & 15;
          const bf16* bh_p = H2 + (size_t)(wrow0 + t16) * 1024 + 8 * q; const bf16* bl_p = H2L + (size_t)(wrow0 + t16) * 1024 + 8 * q;
          const bf16* ah_p = WRH + (size_t)t16 * 1024 + 8 * q; const bf16* al_p = WRL + (size_t)t16 * 1024 + 8 * q;
#pragma unroll 4
          for (int kk = 0; kk < 32; ++kk) {
              const bf16x8 bh = __builtin_nontemporal_load((const bf16x8*)(bh_p + 32 * kk)), bl = __builtin_nontemporal_load((const bf16x8*)(bl_p + 32 * kk));
              const bf16x8 ah0 = *(const bf16x8*)(ah_p + 32 * kk), al0 = *(const bf16x8*)(al_p + 32 * kk), ah1 = *(const bf16x8*)(ah_p + 16 * 1024 + 32 * kk), al1 = *(const bf16x8*)(al_p + 16 * 1024 + 32 * kk);
              acc0 = __builtin_amdgcn_mfma_f32_16x16x32_bf16(ah0, bh, acc0, 0, 0, 0); acc0 = __builtin_amdgcn_mfma_f32_16x16x32_bf16(al0, bh, acc0, 0, 0, 0); acc0 = __builtin_amdgcn_mfma_f32_16x16x32_bf16(ah0, bl, acc0, 0, 0, 0);
              acc1 = __builtin_amdgcn_mfma_f32_16x16x32_bf16(ah1, bh, acc1, 0, 0, 0); acc1 = __builtin_amdgcn_mfma_f32_16x16x32_bf16(al1, bh, acc1, 0, 0, 0); acc1 = __builtin_amdgcn_mfma_f32_16x16x32_bf16(ah1, bl, acc1, 0, 0, 0);
          }
          float cv[8]; int ci[8];
#pragma unroll
          for (int r = 0; r < 4; ++r) { ci[r] = 4 * q + r; cv[r] = acc0[r] + b_router[4 * q + r]; ci[4 + r] = 16 + 4 * q + r; cv[4 + r] = acc1[r] + b_router[16 + 4 * q + r]; }
          float tv[4]; int te[4];
          top4_of8(cv, ci, tv, te);
#pragma unroll
          for (int st = 16; st <= 32; st <<= 1) {
#pragma unroll
              for (int k = 0; k < 4; ++k) { cv[k] = tv[k]; ci[k] = te[k]; cv[4 + k] = __shfl_xor(tv[k], st); ci[4 + k] = __shfl_xor(te[k], st); }
              top4_of8(cv, ci, tv, te);
          }
          const float e1 = __expf(tv[1] - tv[0]), e2 = __expf(tv[2] - tv[0]), e3 = __expf(tv[3] - tv[0]), inv = 1.f / (1.f + e1 + e2 + e3);
          if (lane < 16) { const int row = wrow0 + lane, rl = X.wave * 16 + lane;
              *(int4*)(TOPE + (size_t)row * 4) = make_int4(te[0], te[1], te[2], te[3]); *(f32x4*)(TOPW + (size_t)row * 4) = (f32x4){inv, e1 * inv, e2 * inv, e3 * inv};
              e_of[rl * 4 + 0] = te[0]; e_of[rl * 4 + 1] = te[1]; e_of[rl * 4 + 2] = te[2]; e_of[rl * 4 + 3] = te[3]; }
        }
        __syncthreads();
        const int e = e_of[X.tid]; const int lr = __hip_atomic_fetch_add(&lcnt[e], 1, __ATOMIC_RELAXED, __HIP_MEMORY_SCOPE_WORKGROUP);
        __syncthreads();
        if (X.tid < 32) lbase[X.tid] = (int)__hip_atomic_fetch_add(ctl + CW_ECNT + 64 * X.tid, (unsigned)lcnt[X.tid], __ATOMIC_RELAXED, __HIP_MEMORY_SCOPE_AGENT);
        __syncthreads();
        { const int rank = lbase[e] + lr, id = (row0 + (X.tid >> 2)) * 4 + (X.tid & 3); RANK[id] = rank; TOKOF[(size_t)e * NTOK + rank] = id; }
    }
}

__device__ __forceinline__ void phase10(const Args& A, const Ctx& X) {
    const float* x = A.in[0]; const float* gpost = A.in[5]; const float* gpost2 = A.in[17];
    const float* ADA = (const float*)(X.ws + WS_ADA); const bf16* MIXED = (const bf16*)(X.ws + WS_MIXED);
    const float* TOPW = (const float*)(X.ws + WS_TOPW);
    LAS float* v_g1 = (LAS float*)X.lds; LAS float* v_g3 = v_g1 + 1024;
    const int lane = X.lane;
    for (int ch = blockIdx.x; ch < NTOK / 128; ch += X.G) {
        const int row0 = ch * 128, b = row0 / SEQ;
        __syncthreads();
        for (int j = X.tid; j < 1024; j += 512) { v_g1[j] = ADA[b * 6144 + 2048 + j] * gpost[j]; v_g3[j] = ADA[b * 6144 + 5120 + j] * gpost2[j]; }
        __syncthreads();
        for (int i = 0; i < 16; ++i) {
            const int row = row0 + X.wave + 8 * i;
            const f32x4 tw = *(const f32x4*)(TOPW + (size_t)row * 4);
            const bf16* y0 = (const bf16*)((const unsigned char*)X.out + (size_t)row * 4096); const bf16* y2 = (const bf16*)(X.ws + WS_YSHI + (size_t)row * 4096);
            f32x4 mv[4], xv[4], yv[4]; float ss = 0.f, sy = 0.f;
#pragma unroll
            for (int j = 0; j < 4; ++j) { const int k = 4 * lane + 256 * j; mv[j] = ld_bf4(MIXED + (size_t)row * 1024 + k); xv[j] = *(const f32x4*)(x + (size_t)row * 1024 + k);
                yv[j] = ld_bf4(y0 + k) * tw.x + ld_bf4(y0 + 1024 + k) * tw.y + ld_bf4(y2 + k) * tw.z + ld_bf4(y2 + 1024 + k) * tw.w;
                ss += (mv[j].x * mv[j].x + mv[j].y * mv[j].y) + (mv[j].z * mv[j].z + mv[j].w * mv[j].w);
                sy += (yv[j].x * yv[j].x + yv[j].y * yv[j].y) + (yv[j].z * yv[j].z + yv[j].w * yv[j].w); }
            const float r1 = 1.f / sqrtf(wave_sum(ss) * (1.f / DM) + RMS_EPS), r3 = 1.f / sqrtf(wave_sum(sy) * (1.f / DM) + RMS_EPS);
            asm volatile("s_waitcnt vmcnt(0)" ::: "memory");
#pragma unroll
            for (int j = 0; j < 4; ++j) { const int k = 4 * lane + 256 * j; const f32x4 g1 = *(LAS f32x4*)(v_g1 + k), g3 = *(LAS f32x4*)(v_g3 + k);
                *(f32x4*)(X.out + (size_t)row * 1024 + k) = xv[j] + g1 * (mv[j] * r1) + g3 * (yv[j] * r3); }
        }
    }
}

constexpr int AL_K = 0, AL_V = 16384, AL_KB = 32768, AL_TBL = 33280, AL_SELM = 35328, AL_IMPW = 36864;
typedef short v4i16_t __attribute__((ext_vector_type(4)));
__device__ __forceinline__ int crow(int r, int hi) { return (r & 3) + 8 * (r >> 2) + 4 * hi; }
__device__ __forceinline__ s16x4 vtr(LAS const unsigned char* p) { return __builtin_bit_cast(s16x4, __builtin_amdgcn_ds_read_tr16_b64_v4i16((LAS v4i16_t*)p)); }

__device__ __forceinline__ void qk_tile(f32x16& p0, f32x16& p1, LAS const unsigned char* Ks, const bf16x8 (&qr)[4], int r32, int hi) {
    LAS const unsigned char* kb = Ks + hi * 1024 + r32 * 16;
    p0 = (f32x16){}; p1 = (f32x16){};
#pragma unroll
    for (int d0 = 0; d0 < 4; ++d0) {
        const bf16x8 b0 = *(LAS const bf16x8*)(kb + d0 * 2048), b1 = *(LAS const bf16x8*)(kb + d0 * 2048 + 512);
        p0 = __builtin_amdgcn_mfma_f32_32x32x16_bf16(b0, qr[d0], p0, 0, 0, 0);
        p1 = __builtin_amdgcn_mfma_f32_32x32x16_bf16(b1, qr[d0], p1, 0, 0, 0);
    }
}
__device__ __forceinline__ void softmax_pv(f32x16& p0, f32x16& p1, float& m, float& l, f32x16 (&o)[2], LAS const unsigned char* Vs, int lane, int hi) {
    float rm = fmaxf(p0[0], p1[0]);
#pragma unroll
    for (int r = 1; r < 16; ++r) rm = fmaxf(rm, fmaxf(p0[r], p1[r]));
    rm = fmaxf(rm, __shfl_xor(rm, 32));
    const float mn = fmaxf(m, rm), alpha = __builtin_amdgcn_exp2f(m - mn);
    m = mn;
    if (!__all(alpha == 1.f)) { l *= alpha;
#pragma unroll
        for (int r = 0; r < 16; ++r) { o[0][r] *= alpha; o[1][r] *= alpha; } }
    float s = 0.f;
#pragma unroll
    for (int r = 0; r < 16; ++r) { p0[r] = __builtin_amdgcn_exp2f(p0[r] - mn); p1[r] = __builtin_amdgcn_exp2f(p1[r] - mn); s += p0[r] + p1[r]; }
    l += s;
    v4u pw[4];
    pw[0] = (v4u){pk2(p0[0], p0[1]), pk2(p0[2], p0[3]), pk2(p0[4], p0[5]), pk2(p0[6], p0[7])};
    pw[1] = (v4u){pk2(p0[8], p0[9]), pk2(p0[10], p0[11]), pk2(p0[12], p0[13]), pk2(p0[14], p0[15])};
    pw[2] = (v4u){pk2(p1[0], p1[1]), pk2(p1[2], p1[3]), pk2(p1[4], p1[5]), pk2(p1[6], p1[7])};
    pw[3] = (v4u){pk2(p1[8], p1[9]), pk2(p1[10], p1[11]), pk2(p1[12], p1[13]), pk2(p1[14], p1[15])};
    LAS const unsigned char* vb = Vs + ((lane >> 4) & 1) * 32 + (lane & 3) * 8 + (4 * hi + ((lane & 15) >> 2)) * 64;
    __builtin_amdgcn_sched_barrier(0);
#pragma unroll
    for (int d0 = 0; d0 < 2; ++d0) {
#pragma unroll
        for (int ks = 0; ks < 4; ++ks) {
            const s16x4 lo = vtr(vb + d0 * 4096 + ks * 1024), hh_ = vtr(vb + d0 * 4096 + ks * 1024 + 512);
            const bf16x8 vf = (bf16x8){lo[0], lo[1], lo[2], lo[3], hh_[0], hh_[1], hh_[2], hh_[3]};
            o[d0] = __builtin_amdgcn_mfma_f32_32x32x16_bf16(vf, __builtin_bit_cast(bf16x8, pw[ks]), o[d0], 0, 0, 0);
        }
        __builtin_amdgcn_sched_barrier(0);
    }
}

template <int MODE>
__device__ __forceinline__ void attn_branch(LAS unsigned char* L, int& buf, const bf16* __restrict__ Kg, const bf16* __restrict__ Vg, const float* __restrict__ KBg,
                                            int jlo, int jhi, const bf16x8 (&qr)[4], int tq, int tqmax, int hh, int qt, unsigned long long selm,
                                            float& m, float& l, f32x16 (&o)[2], float inv, int th) {
    const int tid = threadIdx.x, lane = tid & 63, wid = __builtin_amdgcn_readfirstlane(tid >> 6), r32 = lane & 31, hi = lane >> 5;
    LAS const float* TBL = (LAS const float*)(L + AL_TBL);
    v4u kreg, vreg = (v4u){0u, 0u, 0u, 0u}; float kbreg = 0.f;
#define ATT_GLOAD(j) do { kreg = *(const v4u*)(Kg + (size_t)(j) * 4096 + lane * 64 + wid * 8); \
        if (MODE != 4) vreg = *(const v4u*)(Vg + (size_t)(j) * 4096 + (16 * (wid & 3) + (lane >> 2)) * 64 + (wid >> 2) * 32 + (lane & 3) * 8); \
        if (MODE == 0 && tid < 64) kbreg = KBg[(j) * 64 + tid]; } while (0)
    ATT_GLOAD(jlo);
    float carry = 0.f;
    for (int j = jlo; j <= jhi; ++j) {
        LAS unsigned char* Ks = L + AL_K + buf * 8192; LAS unsigned char* Vs = L + AL_V + buf * 8192; LAS float* KBs = (LAS float*)(L + AL_KB) + buf * 64;
        *(LAS v4u*)(Ks + wid * 1024 + lane * 16) = kreg;
        if (MODE != 4) *(LAS v4u*)(Vs + wid * 1024 + lane * 16) = vreg;
        if (MODE == 0 && tid < 64) KBs[tid] = kbreg;
        __syncthreads();
        if (j < jhi) ATT_GLOAD(j + 1);
        const int key0 = j * 64;
        if (!(MODE == 0 && key0 > tqmax)) {
            f32x16 p0, p1;
            qk_tile(p0, p1, Ks, qr, r32, hi);
            __builtin_amdgcn_sched_barrier(0);
            if (MODE == 0) {
#pragma unroll
                for (int a = 0; a < 4; ++a) { const f32x4 b0 = *(LAS const f32x4*)(KBs + 8 * a + 4 * hi), b1 = *(LAS const f32x4*)(KBs + 32 + 8 * a + 4 * hi);
#pragma unroll
                    for (int i = 0; i < 4; ++i) { p0[4 * a + i] += b0[i]; p1[4 * a + i] += b1[i]; } }
                if (key0 + 63 > tqmax - 31) {
                    int d0 = tq - key0 - 4 * hi; asm volatile("" : "+v"(d0));
#pragma unroll
                    for (int r = 0; r < 16; ++r) { const int C = (r & 3) + 8 * (r >> 2); if (C > d0) p0[r] = NEGBIG; if (C + 32 > d0) p1[r] = NEGBIG; }
                }
            } else {
                const bool general = (MODE == 1 || MODE == 4) ? true : (MODE == 2 ? (j >= qt - 2) : (j >= qt - 2 || j <= qt - 8));
                const bool selbit = (MODE == 2) ? (((selm >> j) & 1ull) != 0ull) : true;
                if (general) {
                    int d0 = (MODE == 1 || MODE == 4) ? tq - 31 - 16 * key0 - 64 * hi : tq - key0 - 4 * hi;
                    asm volatile("" : "+v"(d0));
                    constexpr int CM = (MODE == 1 || MODE == 4) ? 16 : 1;
#pragma unroll
                    for (int r = 0; r < 16; ++r) {
#pragma unroll
                        for (int hblk = 0; hblk < 2; ++hblk) {
                            const int dist = d0 - CM * ((r & 3) + 8 * (r >> 2) + 32 * hblk);
                            bool valid = dist >= 0; if (MODE == 3) valid = valid && dist < 512; if (MODE == 2) valid = valid && selbit;
                            const int idx = min(max(dist, 0), 127);
                            const float bias = TBL[idx * 4 + hh];
                            if (hblk) p1[r] = valid ? p1[r] + bias : NEGBIG; else p0[r] = valid ? p0[r] + bias : NEGBIG;
                        }
                        if ((r & 3) == 3) __builtin_amdgcn_sched_barrier(0);
                    }
                } else {
                    const float bfar = TBL[127 * 4 + hh];
#pragma unroll
                    for (int r = 0; r < 16; ++r) { p0[r] = selbit ? p0[r] + bfar : NEGBIG; p1[r] = selbit ? p1[r] + bfar : NEGBIG; }
                }
            }
            __builtin_amdgcn_sched_barrier(0);
            if (MODE != 4) {
                softmax_pv(p0, p1, m, l, o, Vs, lane, hi);
            } else {
                float S0[4], S1[4], s0[4], s1[4];
#pragma unroll
                for (int r = 0; r < 16; ++r) { p0[r] = __builtin_amdgcn_exp2f(p0[r] - m) * inv; p1[r] = __builtin_amdgcn_exp2f(p1[r] - m) * inv; }
#pragma unroll
                for (int a = 0; a < 4; ++a) { S0[a] = (p0[4 * a] + p0[4 * a + 1]) + (p0[4 * a + 2] + p0[4 * a + 3]); S1[a] = (p1[4 * a] + p1[4 * a + 1]) + (p1[4 * a + 2] + p1[4 * a + 3]); }
                if (hi == 0) {
#pragma unroll
                    for (int a = 0; a < 4; ++a) { s0[a] = p0[4 * a + 3]; s1[a] = p1[4 * a + 3]; }
                } else { s0[0] = carry; s0[1] = p0[3]; s0[2] = p0[7]; s0[3] = p0[11]; s1[0] = p0[15]; s1[1] = p1[3]; s1[2] = p1[7]; s1[3] = p1[11]; carry = p1[15]; }
                LAS float* IW = (LAS float*)(L + AL_IMPW) + ((hh * 64) + (32 * th + r32)) * 64 + 16 * j + hi;
#pragma unroll
                for (int a = 0; a < 4; ++a) { IW[2 * a] = S0[a] + __shfl_xor(s0[a], 32); IW[8 + 2 * a] = S1[a] + __shfl_xor(s1[a], 32); }
            }
        }
        buf ^= 1;
    }
#undef ATT_GLOAD
}

__device__ __forceinline__ void store_ot(bf16* dst  , const f32x16 (&o)[2], float scale, int hi) {
#pragma unroll
    for (int d0 = 0; d0 < 2; ++d0)
#pragma unroll
        for (int a = 0; a < 4; ++a) { v2u w; w.x = pk2(o[d0][4 * a] * scale, o[d0][4 * a + 1] * scale); w.y = pk2(o[d0][4 * a + 2] * scale, o[d0][4 * a + 3] * scale);
            *(v2u*)(dst + 32 * d0 + 8 * a + 4 * hi) = w; }
}

__device__ __forceinline__ void fox_unit(const Args& A, const Ctx& X, int bh, int qb, int& buf) {
    const int lane = X.lane, wid = X.wave, r32 = lane & 31, hi = lane >> 5;
    const int tq = 256 * qb + 32 * wid + r32, tqmax = 256 * qb + 32 * wid + 31;
    const bf16* Q = (const bf16*)(X.ws + WS_FQ) + ((size_t)bh * SEQ + tq) * 64;
    bf16x8 qr[4];
#pragma unroll
    for (int d0 = 0; d0 < 4; ++d0) qr[d0] = *(const bf16x8*)(Q + d0 * 16 + hi * 8);
    float m = NEGBIG, l = 0.f; f32x16 o[2]; o[0] = (f32x16){}; o[1] = (f32x16){};
    attn_branch<0>(X.lds, buf, (const bf16*)(X.ws + WS_FK) + (size_t)bh * SEQ * 64, (const bf16*)(X.ws + WS_FV) + (size_t)bh * SEQ * 64, (const float*)(X.ws + WS_KBIAS) + (size_t)bh * SEQ,
                   0, 4 * qb + 3, qr, tq, tqmax, 0, 0, 0ull, m, l, o, 0.f, 0);
    const float lt = l + __shfl_xor(l, 32);
    const int b = bh >> 3, h = bh & 7;
    store_ot((bf16*)((unsigned char*)X.out + OUT_OFOX) + ((size_t)b * SEQ + tq) * 512 + h * 64, o, 1.f / lt, hi);
}

__device__ __forceinline__ void nsa_unit(const Args& A, const Ctx& X, int bg, int qt, int& buf) {
    const int tid = X.tid, lane = X.lane, wid = X.wave, r32 = lane & 31, hi = lane >> 5, hh = wid >> 1, th = wid & 1;
    const int b = bg >> 1, g = bg & 1, head = 4 * g + hh;
    const int tok = 32 * th + r32, tq = 64 * qt + tok, tqmax = 64 * qt + 32 * th + 31;
    LAS unsigned char* L = X.lds;
    __syncthreads();
    { const float* rel = A.in[15]; LAS float* TBL = (LAS float*)(L + AL_TBL); const int d = tid >> 2, q = tid & 3; TBL[tid] = rel[T5_BUCKET[d] * 8 + 4 * g + q] * LOG2E; }
    { LAS v4u* z = (LAS v4u*)(L + AL_IMPW);
#pragma unroll
      for (int i = 0; i < 8; ++i) z[tid + 512 * i] = (v4u){0u, 0u, 0u, 0u}; }
    const bf16* Q = (const bf16*)(X.ws + WS_NQ) + ((size_t)(b * 8 + head) * SEQ + tq) * 64;
    bf16x8 qr[4];
#pragma unroll
    for (int d0 = 0; d0 < 4; ++d0) qr[d0] = *(const bf16x8*)(Q + d0 * 16 + hi * 8);
    const float* gp = (const float*)(X.ws + WS_GATES) + ((size_t)b * SEQ + tq) * 24 + head * 3;
    const float g_cmp = gp[0], g_slc = gp[1], g_win = gp[2];
    __syncthreads();
    const bf16* KV6 = (const bf16*)(X.ws + WS_KV6);
    const bf16* KC = (const bf16*)(X.ws + WS_KC) + (size_t)bg * 256 * 64; const bf16* VC = (const bf16*)(X.ws + WS_VC) + (size_t)bg * 256 * 64;
    const int nct = (4 * qt + 2) / 64;
    float m = NEGBIG, l = 0.f; f32x16 o[2]; o[0] = (f32x16){}; o[1] = (f32x16){};
#ifndef NSA_NO1
    attn_branch<1>(L, buf, KC, VC, nullptr, 0, nct, qr, tq, tqmax, hh, qt, 0ull, m, l, o, 0.f, th);
#endif
    float lt = l + __shfl_xor(l, 32);
    const float inv_c = (tq >= 31) ? 1.f / lt : 0.f;
    { const float sc = g_cmp * inv_c;
#pragma unroll
      for (int r = 0; r < 16; ++r) { o[0][r] *= sc; o[1][r] *= sc; } }
#ifndef NSA_NO4
    { float m2 = m, l2 = 0.f; f32x16 od[2]; attn_branch<4>(L, buf, KC, VC, nullptr, 0, nct, qr, tq, tqmax, hh, qt, 0ull, m2, l2, od, inv_c, th); }
#endif
    __syncthreads();
    {
        LAS const float* IW = (LAS const float*)(L + AL_IMPW); LAS unsigned long long* SELM = (LAS unsigned long long*)(L + AL_SELM);
        for (int ii = 0; ii < 8; ++ii) {
            const int tk = 8 * wid + ii, j = lane;
            const float imp = ((IW[(0 * 64 + tk) * 64 + j] + IW[(1 * 64 + tk) * 64 + j]) + IW[(2 * 64 + tk) * 64 + j]) + IW[(3 * 64 + tk) * 64 + j];
            const bool forced = (j == 0) || (j == qt) || (j == qt - 1), svalid = (j <= qt);
            const float score = forced ? 1e9f : (svalid ? imp : -1e9f);
            int rank = 0;
#pragma unroll 4
            for (int i = 0; i < 64; ++i) { const float si = __builtin_bit_cast(float, __builtin_amdgcn_readlane(__builtin_bit_cast(int, score), i));
                rank += ((si > score) || (si == score && i < j)) ? 1 : 0; }
            const unsigned long long msk = __ballot(rank < 16);
            if (lane == 0) SELM[tk] = msk;
        }
    }
    __syncthreads();
    const unsigned long long selm = ((LAS const unsigned long long*)(L + AL_SELM))[tok];
    LAS float* ACC = (LAS float*)(L + AL_IMPW) + tid;
#pragma unroll
    for (int r = 0; r < 16; ++r) { ACC[r * 512] = o[0][r]; ACC[(16 + r) * 512] = o[1][r]; }
    m = NEGBIG; l = 0.f; o[0] = (f32x16){}; o[1] = (f32x16){};
#ifndef NSA_NO2
    attn_branch<2>(L, buf, KV6 + 2 * KV6_STRIDE + (size_t)bg * SEQ * 64, KV6 + 3 * KV6_STRIDE + (size_t)bg * SEQ * 64, nullptr, 0, qt, qr, tq, tqmax, hh, qt, selm, m, l, o, 0.f, th);
#endif
    lt = l + __shfl_xor(l, 32);
    { const float sc = g_slc / lt;
#pragma unroll
      for (int r = 0; r < 16; ++r) { ACC[r * 512] += o[0][r] * sc; ACC[(16 + r) * 512] += o[1][r] * sc; } }
    m = NEGBIG; l = 0.f; o[0] = (f32x16){}; o[1] = (f32x16){};
#ifndef NSA_NO3
    attn_branch<3>(L, buf, KV6 + 4 * KV6_STRIDE + (size_t)bg * SEQ * 64, KV6 + 5 * KV6_STRIDE + (size_t)bg * SEQ * 64, nullptr, qt > 8 ? qt - 8 : 0, qt, qr, tq, tqmax, hh, qt, 0ull, m, l, o, 0.f, th);
#endif
    lt = l + __shfl_xor(l, 32);
    { const float sc = g_win / lt;
#pragma unroll
      for (int r = 0; r < 16; ++r) { o[0][r] = ACC[r * 512] + o[0][r] * sc; o[1][r] = ACC[(16 + r) * 512] + o[1][r] * sc; } }
    store_ot((bf16*)((unsigned char*)X.out + OUT_ONSA) + ((size_t)b * SEQ + tq) * 512 + head * 64, o, 1.f, hi);
}

__device__ __forceinline__ void phase3(const Args& A, const Ctx& X) {
    int buf = 0;
#ifndef NO_FOX
    REP(16) for (int u = X.vcu; u < 1024; u += X.G) { const int rd = u >> 8, v = u & 255, bh = v >> 2, s = v & 3; const int qb = (rd == 0) ? s : (rd == 1) ? 7 - s : (rd == 2) ? 8 + s : 15 - s;
        fox_unit(A, X, bh, qb, buf); }
#endif
#ifndef NO_NSA
    REP(17)
    for (int u = X.vcu; u < 1024; u += X.G) { const int rd = u >> 8, v = u & 255, bg = v >> 4, s = v & 15; const int qt = (rd == 0) ? s : (rd == 1) ? 31 - s : (rd == 2) ? 32 + s : 63 - s;
        nsa_unit(A, X, bg, qt, buf); }
#endif
}

#ifndef MK_N_LAUNCHES
#define MK_N_LAUNCHES 1
#endif
constexpr int N_PHASES = 11;

__global__ void __launch_bounds__(512, 2) fwd(Args args) {
    extern __shared__ __attribute__((aligned(16))) unsigned char lds_raw[];
    Ctx X;
    X.out = args.out; X.ws = args.ws;
    X.lds = (LAS unsigned char*)lds_raw;
    X.tid = threadIdx.x; X.lane = X.tid & 63; X.wave = __builtin_amdgcn_readfirstlane(X.tid >> 6);
    X.G = gridDim.x; { const int bx = blockIdx.x; X.vcu = (X.G % 8 == 0) ? (bx % 8) * (X.G / 8) + bx / 8 : bx; }
    volatile LAS unsigned* MISC = (volatile LAS unsigned*)(X.lds + MISC_OFF);
    if (X.tid < 64) MISC[X.tid] = 0u;
    __syncthreads();
    const int lo = args.ph_lo, hi = args.ph_hi;
    unsigned* ctl = (unsigned*)(X.ws + WS_CTL);
    XcdBarrier bar; bar.bar = ctl + CW_BAR; bar.x = 0; bar.st = MISC + 8;
    if (hi - lo > 1) bar = xcd_barrier_post(ctl + CW_BAR, MISC + 8);
#ifndef PHMASK
#define PHMASK 0x7ff
#endif
#define IN(k) ((((PHMASK) >> (k)) & 1) && lo <= (k) && (k) < hi)
#define SEAM(k) do { if (IN(k) && IN((k) + 1)) xcd_barrier(bar); } while (0)
    unsigned char* ws = X.ws;
    const int bid = (int)blockIdx.x;

    if (IN(0)) { REP(0) phase0a(args, X); SEAM(0); }
    if (IN(1)) { REP(1) phase0b(args, X); SEAM(1); }
    if (IN(2)) {
        pg8::Gemm g{(const bf16*)((unsigned char*)X.out + OUT_H), (const bf16*)(ws + WS_WIN), 1024};
        pg8::StaticOrder S; S.init(NTOK, NPROJ, X.G, bid, 1024);
        EpiInProj E{ws, args.in[7]};
        pg8::gemm_phase<EpiInProj, pg8::StaticOrder>(X.lds, g, S, E);
        if constexpr (((DUP_MASK) >> 2) & 1) pg8::gemm_phase<EpiInProj, pg8::StaticOrder>(X.lds, g, S, E);
        SEAM(2);
    }
    if (IN(3)) { REP(3) phase2(args, X); SEAM(3); }
    if (IN(4)) { REP(4) phase3(args, X); SEAM(4); }
    if (IN(5)) {
        pg8::StaticOrder S; S.init(NTOK, 1024, X.G, bid, 512);
        {
        { pg8::Gemm g{(const bf16*)((unsigned char*)X.out + OUT_OFOX), (const bf16*)(ws + WS_WFOX), 512};
          EpiGate<false> E{(bf16*)(ws + WS_GATED), (const bf16*)(ws + WS_SGF)};
          pg8::gemm_phase<EpiGate<false>, pg8::StaticOrder>(X.lds, g, S, E); }
        { pg8::Gemm g{(const bf16*)((unsigned char*)X.out + OUT_ONSA), (const bf16*)(ws + WS_WNSA), 512};
          EpiGate<true> E{(bf16*)(ws + WS_GATED), (const bf16*)(ws + WS_SGN)};
          pg8::gemm_phase<EpiGate<true>, pg8::StaticOrder>(X.lds, g, S, E); }
        }
        SEAM(5);
    }
    if (IN(6)) {
        pg8::Gemm g{(const bf16*)(ws + WS_GATED), (const bf16*)(ws + WS_WMIX), 1024};
        pg8::StaticOrder S; S.init(NTOK, 1024, X.G, bid, 1024);
        EpiPlain E{(bf16*)(ws + WS_MIXED), 1024};
        pg8::gemm_phase<EpiPlain, pg8::StaticOrder>(X.lds, g, S, E);
        if constexpr (((DUP_MASK) >> 6) & 1) pg8::gemm_phase<EpiPlain, pg8::StaticOrder>(X.lds, g, S, E);
        SEAM(6);
    }
    if (IN(7)) { phase6(args, X); SEAM(7); }
    if (IN(8)) {
        moe_tables(args, X);
        LAS const int* tab = (LAS const int*)(X.lds + TAB_OFF);
        MoeOrder S{X.G, bid, 8, 0, tab, (const int*)(ws + WS_TOKOF)};
        pg8::Gemm g{(const bf16*)((unsigned char*)X.out + OUT_H2), (const bf16*)(ws + WS_WGU), 1024};
        EpiGateUp E{(bf16*)(ws + WS_ACT), args.in[21], args.in[23], tab};
        REP(8) pg8::gemm_phase<EpiGateUp, MoeOrder>(X.lds, g, S, E);
        SEAM(8);
    }
    if (IN(9)) {
        moe_tables(args, X);
        LAS const int* tab = (LAS const int*)(X.lds + TAB_OFF);
        MoeOrder S{X.G, bid, 4, 1, tab, (const int*)(ws + WS_TOKOF)};
        pg8::Gemm g{(const bf16*)(ws + WS_ACT), (const bf16*)(ws + WS_WD), 1024};
        EpiDown E{(unsigned char*)X.out, ws + WS_YSHI, args.in[25], tab, (const int*)(ws + WS_TOKOF)};
        REP(9) pg8::gemm_phase<EpiDown, MoeOrder>(X.lds, g, S, E);
        SEAM(9);
    }
    if (IN(10)) { phase10(args, X); }
#undef IN
#undef SEAM
}

extern "C" void kernel_launch(void* const* d_in, const int* in_sizes, int n_in, void* d_out, int out_size, void* d_ws, size_t ws_size, hipStream_t stream) {
    static int grid = 0;
    if (grid == 0) {
        if (n_in != 26 || in_sizes[0] != NTOK * DM || out_size != NTOK * DM || ws_size < WS_END) {
            fprintf(stderr, "kernel_launch: unexpected shapes / workspace (n_in %d, ws %zu, need %zu); nothing launched\n", n_in, ws_size, (size_t)WS_END); grid = -1; return; }
        int dev = 0, cus = 0, per_cu = 0;
        if (hipGetDevice(&dev) != hipSuccess || hipDeviceGetAttribute(&cus, hipDeviceAttributeMultiprocessorCount, dev) != hipSuccess) { grid = -1; return; }
        if (hipFuncSetAttribute((const void*)fwd, hipFuncAttributeMaxDynamicSharedMemorySize, LDS_BYTES) != hipSuccess) { fprintf(stderr, "kernel_launch: hipFuncSetAttribute failed\n"); grid = -1; return; }
        if (hipOccupancyMaxActiveBlocksPerMultiprocessor(&per_cu, (const void*)fwd, 512, LDS_BYTES) != hipSuccess || per_cu < 1) { fprintf(stderr, "kernel_launch: occupancy query says %d\n", per_cu); }
        (void)hipGetLastError();
        grid = cus;
    }
    if (grid < 0) return;
    if (hipMemsetAsync((char*)d_ws + WS_CTL, 0, CTL_ZERO_BYTES, stream) != hipSuccess) return;
    Args a{};
    for (int i = 0; i < 26; ++i) a.in[i] = (const float*)d_in[i];
    a.out = (float*)d_out; a.ws = (unsigned char*)d_ws;
#if MK_N_LAUNCHES == 1
    a.ph_lo = 0; a.ph_hi = N_PHASES;
    hipLaunchKernelGGL(fwd, dim3(grid), dim3(512), LDS_BYTES, stream, a);
#else
    for (int p = 0; p < N_PHASES; ++p) { a.ph_lo = p; a.ph_hi = p + 1; hipLaunchKernelGGL(fwd, dim3(grid), dim3(512), LDS_BYTES, stream, a); }
#endif
}
```

```cpp
#include <hip/hip_runtime.h>
#include <cstdio>
#include <cstdint>

#define GAS __attribute__((address_space(1)))
#define LAS __attribute__((address_space(3)))
typedef unsigned short bf16;
typedef unsigned v4u __attribute__((ext_vector_type(4)));
typedef unsigned v2u __attribute__((ext_vector_type(2)));
typedef float f32x2 __attribute__((ext_vector_type(2)));
typedef float f32x4 __attribute__((ext_vector_type(4)));
typedef float f32x16 __attribute__((ext_vector_type(16)));
typedef short bf16x8 __attribute__((ext_vector_type(8)));
typedef short s16x4 __attribute__((ext_vector_type(4)));
typedef __bf16 bf16x2_t __attribute__((ext_vector_type(2)));

constexpr int NB = 8, SEQ = 4096, DM = 1024, NTOK = NB * SEQ;
constexpr int NPROJ = 5120;
constexpr int NEXP = 32, TOPK = 4;
constexpr float LOG2E = 1.4426950408889634f;
constexpr float QSCALE = 0.125f * 1.4426950408889634f;
constexpr float RMS_EPS = 1e-6f;
constexpr float NEGBIG = -1e30f;

__device__ __forceinline__ unsigned pk2(float lo, float hi) { f32x2 v = {lo, hi}; bf16x2_t b = __builtin_convertvector(v, bf16x2_t); return __builtin_bit_cast(unsigned, b); }
__device__ __forceinline__ float bf_lo(unsigned u) { return __builtin_bit_cast(float, u << 16); }
__device__ __forceinline__ float bf_hi(unsigned u) { return __builtin_bit_cast(float, u & 0xffff0000u); }
__device__ __forceinline__ float wave_sum(float v) {
    int t;
    t = __builtin_amdgcn_update_dpp(0, __builtin_bit_cast(int, v), 0xB1, 0xF, 0xF, false); v += __builtin_bit_cast(float, t);
    t = __builtin_amdgcn_update_dpp(0, __builtin_bit_cast(int, v), 0x4E, 0xF, 0xF, false); v += __builtin_bit_cast(float, t);
    t = __builtin_amdgcn_update_dpp(0, __builtin_bit_cast(int, v), 0x141, 0xF, 0xF, false); v += __builtin_bit_cast(float, t);
    t = __builtin_amdgcn_update_dpp(0, __builtin_bit_cast(int, v), 0x140, 0xF, 0xF, false); v += __builtin_bit_cast(float, t);
    const int vi = __builtin_bit_cast(int, v);
    const float r0 = __builtin_bit_cast(float, __builtin_amdgcn_readlane(vi, 0)), r1 = __builtin_bit_cast(float, __builtin_amdgcn_readlane(vi, 16)),
                r2 = __builtin_bit_cast(float, __builtin_amdgcn_readlane(vi, 32)), r3 = __builtin_bit_cast(float, __builtin_amdgcn_readlane(vi, 48));
    return (r0 + r1) + (r2 + r3);
}
__device__ __forceinline__ float sigmoidf_(float x) { return __builtin_amdgcn_rcpf(1.f + __builtin_amdgcn_exp2f(-1.4426950408889634f * x)); }
#define LDS_WAIT() asm volatile("s_waitcnt lgkmcnt(0)" ::: "memory")
#define VM_WAIT() asm volatile("s_waitcnt vmcnt(0)" ::: "memory")

namespace pg8 {
#define PG8_LAS __attribute__((address_space(3)))
typedef unsigned short bf16_t;
typedef unsigned u32x4 __attribute__((ext_vector_type(4)));
constexpr int BM = 256, BK = 64, HALF = 128, HTB = HALF * BK * 2  , STAGE_BYTES = 8 * HTB, NXCD = 8, WGM = 8;

__host__ __device__ __forceinline__ int lds_byte(int r, int c) { const int st = (r >> 4) * 2 + (c >> 5), rr = r & 15, cc = c & 31, ob = rr * 64 + cc * 2; return st * 1024 + (ob ^ (((ob >> 9) & 1) << 5)); }
__host__ __device__ __forceinline__ void stage_rc(int b, int& R, int& C) { const int st = b / 1024, sb = b % 1024, swz = sb ^ (((sb >> 9) & 1) << 5); R = (st >> 1) * 16 + swz / 64; C = (st & 1) * 32 + (swz % 64) / 2; }
__host__ __device__ __forceinline__ int perm32(int rho) { const int n = rho >> 4, i = rho & 15; return 8 * (i >> 2) + 4 * n + (i & 3); }

struct Unit { int pm, pn, e, rt, ord; };
struct Gemm { const bf16_t* A; const bf16_t* Bt; int K; };

struct StaticOrder {
    int nM, nN, nwg, G, c, lda2;
    __device__ void init(int M, int N, int G_, int c_, int lda_elems) { nM = M / BM; nN = N / BM; nwg = nM * nN; G = G_; c = c_; lda2 = lda_elems * 2; }
    __device__ bool next(int i, Unit& u) const {
        const long L = (long)i * G + c; if (L >= nwg) return false;
        int wgid = (int)L; { const int q = nwg / NXCD, r = nwg % NXCD, xcd = wgid % NXCD, off = wgid / NXCD; wgid = (xcd < r ? xcd * (q + 1) : r * (q + 1) + (xcd - r) * q) + off; }
        const int nig = WGM * nN, gid = wgid / nig, fm = gid * WGM, gsz = (nM - fm) < WGM ? (nM - fm) : WGM;
        u.pm = fm + ((wgid % nig) % gsz); u.pn = (wgid % nig) / gsz; u.e = 0; u.rt = 0; u.ord = i; return true;
    }
    __device__ __forceinline__ unsigned a_off(const Unit& u, int r) const { return (unsigned)(u.pm * BM + r) * (unsigned)lda2; }
};

template <class Epi, class Sched, bool ALIGN_EPI = true>
__device__ __forceinline__ void gemm_phase(PG8_LAS unsigned char* lds, const Gemm g, const Sched& S, const Epi& E) {
    const int tid = threadIdx.x, wid = __builtin_amdgcn_readfirstlane(tid >> 6), lane = tid & 63, wr = wid >> 2, wc = wid & 3, fr = lane & 15, fq = lane >> 4;
    const int K = g.K, nt = K / BK;
    int RA[2], CA2[2]; unsigned voffB[2];
#pragma unroll
    for (int i = 0; i < 2; ++i) { int R, C; stage_rc(tid * 16 + i * 8192, R, C); const int Rb = (R & ~31) + perm32(R & 31);
        RA[i] = R; CA2[i] = C * 2; voffB[i] = (unsigned)(Rb * K + C) * 2u; }
    const size_t kstep = (size_t)(BK * 2);
    const size_t hstep = (size_t)HALF * K * 2;
    const size_t tstep = 2 * hstep;
    const unsigned ldsw = (unsigned)wid * 1024u;
    const int aoff = lds_byte(wr * 64 + fr, fq * 8), boff = lds_byte(wc * 32 + fr, fq * 8);
#define PG8_SA(b, h) (((b) * 2 + (h)) * HTB)
#define PG8_SB(b, h) ((4 + (b) * 2 + (h)) * HTB)
#define PG8_STAGE(bufoff, gbase, voff) do { _Pragma("unroll") for (int _i = 0; _i < 2; ++_i) \
        __builtin_amdgcn_global_load_lds((const unsigned*)((const char*)(gbase) + (voff)[_i]), (PG8_LAS unsigned*)(lds + (bufoff) + ldsw + _i * 8192), 16, 0, 0); } while (0)
#define PG8_LDA(dst, b, h) do { _Pragma("unroll") for (int m = 0; m < 4; ++m) _Pragma("unroll") for (int k = 0; k < 2; ++k) dst[m][k] = *(const PG8_LAS bf16x8*)(lds + PG8_SA(b, h) + aoff + m * 2048 + k * 1024); } while (0)
#define PG8_LDB(dst, b, h) do { _Pragma("unroll") for (int n = 0; n < 2; ++n) _Pragma("unroll") for (int k = 0; k < 2; ++k) dst[n][k] = *(const PG8_LAS bf16x8*)(lds + PG8_SB(b, h) + boff + n * 2048 + k * 1024); } while (0)
#define PG8_MMA(ai, bj, At, Bt) do { __builtin_amdgcn_s_setprio(1); _Pragma("unroll") for (int m = 0; m < 4; ++m) _Pragma("unroll") for (int n = 0; n < 2; ++n) _Pragma("unroll") for (int k = 0; k < 2; ++k) \
        acc[ai][bj][m][n] = __builtin_amdgcn_mfma_f32_16x16x32_bf16(Bt[n][k], At[m][k], acc[ai][bj][m][n], 0, 0, 0); __builtin_amdgcn_s_setprio(0); } while (0)
#define PG8_WAIT_V(n) asm volatile("s_waitcnt vmcnt(" #n ")" ::: "memory")
#define PG8_WAIT_L(n) asm volatile("s_waitcnt lgkmcnt(" #n ")" ::: "memory")
#define PG8_BAR __builtin_amdgcn_s_barrier()
#define PG8_SCHED __builtin_amdgcn_sched_barrier(0)
    Unit cur, nxt; int ui = 0;
    if (!S.next(0, cur)) return;
    f32x4 acc[2][2][4][2];
#pragma unroll
    for (int a = 0; a < 2; ++a)
#pragma unroll
        for (int b = 0; b < 2; ++b)
#pragma unroll
            for (int m = 0; m < 4; ++m)
#pragma unroll
                for (int n = 0; n < 2; ++n) acc[a][b][m][n] = (f32x4){0.f, 0.f, 0.f, 0.f};
    bf16x8 At[4][2], B0[2][2], B1[2][2];
    const char* gA = (const char*)g.A;
    unsigned oc0[2], oc1[2], on0[2], on1[2];
#pragma unroll
    for (int i = 0; i < 2; ++i) { oc0[i] = S.a_off(cur, RA[i]) + CA2[i]; oc1[i] = S.a_off(cur, HALF + RA[i]) + CA2[i]; }
    const char* cB = (const char*)g.Bt + (size_t)cur.pn * tstep;
    PG8_STAGE(PG8_SB(0, 0), cB, voffB); PG8_STAGE(PG8_SB(0, 1), cB + hstep, voffB); PG8_STAGE(PG8_SA(0, 0), gA, oc0); PG8_STAGE(PG8_SA(0, 1), gA, oc1);
    if (wr == 1) PG8_BAR;
    PG8_WAIT_V(2); PG8_BAR;
    PG8_STAGE(PG8_SB(1, 0), cB + kstep, voffB); PG8_STAGE(PG8_SA(1, 0), gA + kstep, oc0); PG8_STAGE(PG8_SB(1, 1), cB + hstep + kstep, voffB);
    PG8_WAIT_V(6); PG8_BAR;
    for (;;) {
        const bool has_next = S.next(ui + 1, nxt);
        if (has_next) {
#pragma unroll
            for (int i = 0; i < 2; ++i) { on0[i] = S.a_off(nxt, RA[i]) + CA2[i]; on1[i] = S.a_off(nxt, HALF + RA[i]) + CA2[i]; }
        } else {
#pragma unroll
            for (int i = 0; i < 2; ++i) { on0[i] = oc0[i]; on1[i] = oc1[i]; }
        }
        const char* nB = has_next ? (const char*)g.Bt + (size_t)nxt.pn * tstep : cB;
        for (int t = 0; t < nt; t += 2) {
            const bool last = (t == nt - 2);
            const char* a1 = gA + (size_t)(t + 1) * kstep;
            const char* a2 = last ? gA : gA + (size_t)(t + 2) * kstep; const char* b2 = last ? nB : cB + (size_t)(t + 2) * kstep;
            const char* a3 = a2 + kstep; const char* b3 = b2 + kstep;
            unsigned s0[2], s1[2];
#pragma unroll
            for (int i = 0; i < 2; ++i) { s0[i] = last ? on0[i] : oc0[i]; s1[i] = last ? on1[i] : oc1[i]; }
            PG8_LDB(B0, 0, 0); PG8_LDB(B1, 0, 1); PG8_SCHED; PG8_LDA(At, 0, 0); PG8_STAGE(PG8_SA(1, 1), a1, oc1);
            PG8_WAIT_V(8); PG8_WAIT_L(0); PG8_BAR; PG8_MMA(0, 0, At, B0); PG8_MMA(0, 1, At, B1); PG8_BAR; PG8_SCHED;
            PG8_LDA(At, 0, 1); PG8_STAGE(PG8_SB(0, 0), b2, voffB); PG8_STAGE(PG8_SB(0, 1), b2 + hstep, voffB); PG8_STAGE(PG8_SA(0, 0), a2, s0);
            PG8_WAIT_V(8); PG8_WAIT_L(0); PG8_BAR; PG8_MMA(1, 0, At, B0); PG8_MMA(1, 1, At, B1); PG8_BAR; PG8_SCHED;
            PG8_LDB(B0, 1, 0); PG8_LDB(B1, 1, 1); PG8_SCHED; PG8_LDA(At, 1, 0); PG8_STAGE(PG8_SA(0, 1), a2, s1);
            PG8_WAIT_V(8); PG8_WAIT_L(0); PG8_BAR; PG8_MMA(0, 0, At, B0); PG8_MMA(0, 1, At, B1); PG8_BAR; PG8_SCHED;
            PG8_LDA(At, 1, 1); PG8_STAGE(PG8_SB(1, 0), b3, voffB); PG8_STAGE(PG8_SB(1, 1), b3 + hstep, voffB); PG8_STAGE(PG8_SA(1, 0), a3, s0);
            PG8_WAIT_V(8); PG8_WAIT_L(0); PG8_BAR; PG8_MMA(1, 0, At, B0); PG8_MMA(1, 1, At, B1); PG8_BAR; PG8_SCHED;
        }
        if constexpr (ALIGN_EPI) { if (wr == 0) PG8_BAR; }
        E(acc, cur, wr, wc, fr, fq);
        if (!has_next) break;
#pragma unroll
        for (int a = 0; a < 2; ++a)
#pragma unroll
            for (int b = 0; b < 2; ++b)
#pragma unroll
                for (int m = 0; m < 4; ++m)
#pragma unroll
                    for (int n = 0; n < 2; ++n) acc[a][b][m][n] = (f32x4){0.f, 0.f, 0.f, 0.f};
        cur = nxt; cB = nB; ++ui;
#pragma unroll
        for (int i = 0; i < 2; ++i) { oc0[i] = on0[i]; oc1[i] = on1[i]; }
        if constexpr (ALIGN_EPI) { if (wr == 1) PG8_BAR; }
    }
    PG8_WAIT_V(0);
    if constexpr (!ALIGN_EPI) { if (wr == 0) PG8_BAR; }
    PG8_BAR;
#undef PG8_SA
#undef PG8_SB
#undef PG8_STAGE
#undef PG8_LDA
#undef PG8_LDB
#undef PG8_MMA
#undef PG8_WAIT_V
#undef PG8_WAIT_L
#undef PG8_BAR
#undef PG8_SCHED
}
}

#define XB_TMO      128
#define XB_XCNT(j)  (256  + 64 * (j))
#define XB_XSUB(j)  (1280 + 64 * (j))
#define XB_XGEN(j)  (2304 + 64 * (j))
#define XB_TOP      3328
#define XB_TOPGEN   3392
#define XCD_BAR_WORDS 3456
#define XB_SPIN_CAP (1u << 18)

__device__ __forceinline__ unsigned xb_ld(unsigned* p)              { return __hip_atomic_load(p, __ATOMIC_RELAXED, __HIP_MEMORY_SCOPE_AGENT); }
__device__ __forceinline__ unsigned xb_add(unsigned* p, unsigned v) { return __hip_atomic_fetch_add(p, v, __ATOMIC_RELAXED, __HIP_MEMORY_SCOPE_AGENT); }
__device__ __forceinline__ unsigned xb_xcc_id() { return (unsigned)__builtin_amdgcn_s_getreg((3 << 11) | 20) & 0xFu; }
#define XB_SPIN(cond, bar) do { unsigned _sp = 0; while (cond) { __builtin_amdgcn_s_sleep(1); \
    if ((++_sp & 255u) == 0u) { if (xb_ld(&(bar)[XB_TMO])) break; if (_sp > XB_SPIN_CAP) { atomicAdd(&(bar)[XB_TMO], 1u); break; } } } } while (0)

struct XcdBarrier {
    unsigned* bar; unsigned x;
    volatile LAS unsigned* st;
};

__device__ __forceinline__ XcdBarrier xcd_barrier_post(unsigned* bar, volatile LAS unsigned* st) {
    XcdBarrier b; b.bar = bar; b.x = xb_xcc_id(); b.st = st;
    if (threadIdx.x == 0) (void)xb_add(&bar[XB_XCNT(b.x)], 1u);
    return b;
}
__device__ __forceinline__ void xcd_barrier_complete(unsigned* bar, unsigned x, unsigned& nloc, unsigned& nx) {
    const unsigned G = gridDim.x * gridDim.y * gridDim.z;
    unsigned sum, cnt, mine, sp = 0u;
    for (;;) {
        sum = 0u; cnt = 0u; mine = 0u;
#pragma unroll
        for (unsigned j = 0; j < 16; ++j) { const unsigned c = xb_ld(&bar[XB_XCNT(j)]); sum += c; cnt += (c > 0u) ? 1u : 0u; mine = (j == x) ? c : mine; }
        if (sum == G) break;
        __builtin_amdgcn_s_sleep(1);
        if ((++sp & 255u) == 0u) { if (xb_ld(&bar[XB_TMO])) break; if (sp > XB_SPIN_CAP) { atomicAdd(&bar[XB_TMO], 1u); break; } }
    }
    nloc = mine > 0u ? mine : 1u; nx = cnt > 0u ? cnt : 1u;
}

__device__ __forceinline__ void xcd_barrier(const XcdBarrier& b) {
    asm volatile("s_waitcnt vmcnt(0)" ::: "memory");
    __syncthreads();
    if (threadIdx.x == 0) {
        unsigned* bar = b.bar;
        __builtin_amdgcn_s_waitcnt(0);
        unsigned nloc = b.st[0], nx = b.st[1];
        if (nloc == 0u) { xcd_barrier_complete(bar, b.x, nloc, nx); b.st[0] = nloc; b.st[1] = nx; }
        const unsigned old = xb_add(&bar[XB_XSUB(b.x)], 1u);
        const unsigned gen = old / nloc;
        if (old + 1u == (gen + 1u) * nloc) {
            __builtin_amdgcn_fence(__ATOMIC_RELEASE, "agent");
            asm volatile("s_waitcnt vmcnt(0)" ::: "memory");
            const unsigned og = xb_add(&bar[XB_TOP], 1u);
            const unsigned tg = og / nx;
            if (og + 1u == (tg + 1u) * nx) xb_add(&bar[XB_TOPGEN], 1u);
            else XB_SPIN(xb_ld(&bar[XB_TOPGEN]) == tg, bar);
            __builtin_amdgcn_fence(__ATOMIC_ACQUIRE, "agent");
            xb_add(&bar[XB_XGEN(b.x)], 1u);
            asm volatile("s_waitcnt vmcnt(0)" ::: "memory");
        } else {
            XB_SPIN(xb_ld(&bar[XB_XGEN(b.x)]) == gen, bar);
            __builtin_amdgcn_fence(__ATOMIC_ACQUIRE, "agent");
            asm volatile("s_waitcnt vmcnt(0)" ::: "memory");
        }
    }
    __syncthreads();
}

#ifndef DUP_MASK
#define DUP_MASK 0
#endif
#define REP(k) for (int rep_ = 0; rep_ < ((((DUP_MASK) >> (k)) & 1) + 1); ++rep_)

constexpr size_t MiB = 1u << 20;
constexpr size_t WS_CTL = 0, CTL_ZERO_BYTES = 1 * MiB;
constexpr size_t WS_ADAP = 1 * MiB;
constexpr size_t WS_ADA = 4 * MiB;
constexpr size_t WS_DUMMY = 4 * MiB + 768 * 1024;
constexpr size_t WS_CB = 4 * MiB + 512 * 1024;
constexpr size_t WS_LOGF = 5 * MiB;
constexpr size_t WS_GATES = 6 * MiB;
constexpr size_t WS_KBIAS = 9 * MiB;
constexpr size_t WS_KC = 10 * MiB, WS_VC = 10 * MiB + 512 * 1024;
constexpr size_t WS_WRT = 11 * MiB;
constexpr size_t WS_WCK = 11 * MiB + 256 * 1024, WS_WCV = 11 * MiB + 512 * 1024;
constexpr size_t WS_TOPE = 12 * MiB, WS_TOPW = 12 * MiB + 512 * 1024, WS_RANK = 13 * MiB;
constexpr size_t WS_KX = 14 * MiB;
constexpr size_t WS_TOKOF = 14 * MiB;
constexpr size_t WS_WFOX = 18 * MiB, WS_WNSA = 19 * MiB, WS_WMIX = 20 * MiB, WS_WIN = 22 * MiB;
constexpr size_t WS_WD = 32 * MiB;
constexpr size_t WS_WGU = 96 * MiB;
constexpr size_t WS_YSHI = 96 * MiB;
constexpr size_t WS_FQ = 224 * MiB, WS_FK = 256 * MiB, WS_FV = 288 * MiB, WS_NQ = 320 * MiB;
constexpr size_t WS_KV6 = 352 * MiB;
constexpr size_t WS_SGF = 400 * MiB, WS_SGN = 464 * MiB;
constexpr size_t WS_MIXED = 224 * MiB;
constexpr size_t WS_GATED = 288 * MiB;
constexpr size_t WS_ACT = 288 * MiB;
constexpr size_t WS_END = 544 * MiB;
constexpr size_t OUT_H = 0, OUT_OFOX = 64 * MiB, OUT_ONSA = 96 * MiB, OUT_H2 = 0, OUT_H2LO = 64 * MiB;
constexpr size_t KV6_STRIDE = (size_t)NTOK * 128;

constexpr int CW_TMO = 0;
constexpr int CW_BAR = 4096;
constexpr int CW_NSAQ = 3072;
constexpr int CW_ECNT = 32768;

constexpr int RING_BYTES = 131072;
constexpr int MISC_OFF = 143872;
constexpr int TAB_OFF = 143872 + 256;
constexpr int ROWTAB_OFF = 143872 + 1024;
constexpr int LDS_BYTES = 163840;

__device__ const unsigned char T5_BUCKET[128] = {
 0,1,2,3,4,5,6,7,8,9,10,11,12,13,14,15,16,16,16,17,17,18,18,18,19,19,19,20,20,20,20,21,21,21,21,22,22,22,22,22,23,23,23,23,23,23,24,24,24,24,24,24,25,25,25,25,25,25,25,26,26,26,26,26,26,26,26,
 27,27,27,27,27,27,27,27,27,27,28,28,28,28,28,28,28,28,28,28,29,29,29,29,29,29,29,29,29,29,29,29,30,30,30,30,30,30,30,30,30,30,30,30,30,30,31,31,31,31,31,31,31,31,31,31,31,31,31,31,31};

struct Args { const float* in[26]; float* out; unsigned char* ws; int ph_lo, ph_hi; };
struct Ctx {
    float* out; unsigned char* ws;
    LAS unsigned char* lds; int tid, lane, wave, vcu, G;
};

__device__ __forceinline__ void conv64(const float* __restrict__ W, size_t ldw, int col, int k0, bf16* __restrict__ dst) {
#pragma unroll
    for (int h = 0; h < 2; ++h) {
        float v[32];
#pragma unroll
        for (int kk = 0; kk < 32; ++kk) v[kk] = W[(size_t)(k0 + h * 32 + kk) * ldw + col];
#pragma unroll
        for (int q = 0; q < 4; ++q) { v4u o; o.x = pk2(v[8 * q], v[8 * q + 1]); o.y = pk2(v[8 * q + 2], v[8 * q + 3]); o.z = pk2(v[8 * q + 4], v[8 * q + 5]); o.w = pk2(v[8 * q + 6], v[8 * q + 7]);
            *(v4u*)(dst + h * 32 + q * 8) = o; }
    }
}
__device__ __forceinline__ void conv_item(const float* W, size_t ldw, int col0, int ncb, bf16* WT, int Kd, int dst_row0, int r, int lane) {
    const int cbk = r % ncb, kb = r / ncb;
    conv64(W, ldw, col0 + cbk * 64 + lane, kb * 64, WT + (size_t)(dst_row0 + cbk * 64 + lane) * Kd + kb * 64);
}

#define CV_LOADH(V, src, ldw, h) do { const unsigned vo_ = (unsigned)((2 * (lane >> 4) * (ldw) + (lane & 15) * 4) * 4); const float* sh_ = (src) + (size_t)(32 * (h)) * (ldw); \
        _Pragma("unroll") for (int i_ = 0; i_ < 8; ++i_) V[i_] = __builtin_nontemporal_load((const f32x4*)((const char*)(sh_ + (size_t)(8 * (i_ >> 1) + (i_ & 1)) * (ldw)) + vo_)); } while (0)
#define CV_LDSW(V, h) do { LAS unsigned* T32_ = (LAS unsigned*)TT; const int a_ = lane & 15, b_ = lane >> 4; \
        _Pragma("unroll") for (int m_ = 0; m_ < 4; ++m_) { _Pragma("unroll") for (int c_ = 0; c_ < 4; ++c_) T32_[(4 * a_ + c_) * 32 + ((((4 * (h) + m_) ^ (a_ & 7)) << 2) | b_)] = pk2(V[2 * m_][c_], V[2 * m_ + 1][c_]); } } while (0)
#define CV_OUT(dst, Kd) do { _Pragma("unroll") for (int j_ = 0; j_ < 8; ++j_) { const v4u o_ = *(LAS const v4u*)((LAS const unsigned char*)TT + lane * 128 + ((j_ ^ ((lane >> 2) & 7)) << 4)); *(v4u*)((dst) + (size_t)lane * (Kd) + 8 * j_) = o_; } } while (0)
#define CONV_SMALL(W, ldw, col0, ncb, WT, Kd, dst_row0, r) do { const int cb_ = (r) % (ncb), kb_ = (r) / (ncb); f32x4 V0_[8], V1_[8]; \
        const float* src_ = (W) + (size_t)(kb_ * 64) * (ldw) + (col0) + cb_ * 64; CV_LOADH(V0_, src_, (ldw), 0); CV_LOADH(V1_, src_, (ldw), 1); \
        bf16* dst_ = (WT) + (size_t)((dst_row0) + cb_ * 64) * (Kd) + kb_ * 64; CV_LDSW(V0_, 0); CV_LDSW(V1_, 1); CV_OUT(dst_, (Kd)); } while (0)
__device__ __forceinline__ void exp_src_dst(const Args& A, unsigned char* ws, int q, const float*& src, bf16*& dst) {
    const int mat = q >> 8, rr = q & 255, cb = rr & 15, kb = rr >> 4, kind = mat >> 5, e = mat & 31, n = cb * 64;
    const float* W = (kind == 0 ? A.in[20] : (kind == 1 ? A.in[22] : A.in[24])) + (size_t)e * 1048576;
    src = W + (size_t)(kb * 64) * 1024 + n;
    const int drow = (kind == 2) ? e * 1024 + n : e * 2048 + (n >> 7) * 256 + (n & 127) + kind * 128;
    dst = (bf16*)(ws + (kind == 2 ? WS_WD : WS_WGU)) + (size_t)drow * 1024 + kb * 64;
}

__device__ __forceinline__ void phase0a(const Args& A, const Ctx& X) {
    const float* c = A.in[1]; const float* w_ada = A.in[2]; const float* w_in = A.in[6];
    LAS float* sl = (LAS float*)X.lds;
    for (int i = X.tid; i < 8192; i += 512) { const float v = c[i]; sl[i] = v / (1.f + __expf(-v)); }
    __syncthreads();
    const int gw = X.vcu * 8 + X.wave, NGW = X.G * 8, lane = X.lane;
    unsigned char* ws = X.ws;
    bf16* WIN = (bf16*)(ws + WS_WIN);
    LAS bf16* TT = (LAS bf16*)(X.lds + 32768 + X.wave * 8192);
    constexpr int J_ADA = 24 * 16, J_INA = 24 * 16, J_INB = 20 * 16, J_INC = 32 * 16, J_IND = 256, J_FOX = 16 * 8, J_NSA = 16 * 8, J_MIX = 16 * 16, J_CK = 32, J_CV = 32, J_RT = 32, J_CB = 128;
    constexpr int NITEMS = J_ADA + J_INA + J_INB + J_INC + J_IND + J_FOX + J_NSA + J_MIX + J_CK + J_CV + J_RT + J_CB;
    for (int it = gw; it < NITEMS; it += NGW) {
        int r = it;
        if (r < J_ADA) {
            const int cb = r % 24, ks = r / 24, j = cb * 256 + lane * 4; f32x4 acc[8];
#pragma unroll
            for (int b = 0; b < 8; ++b) acc[b] = (f32x4){0.f, 0.f, 0.f, 0.f};
            for (int k4 = 0; k4 < 4; ++k4) {
                f32x4 w[16];
#pragma unroll
                for (int kk = 0; kk < 16; ++kk) w[kk] = __builtin_nontemporal_load((const f32x4*)(w_ada + (size_t)(ks * 64 + k4 * 16 + kk) * 6144 + j));
#pragma unroll
                for (int kk = 0; kk < 16; ++kk) {
#pragma unroll
                    for (int b = 0; b < 8; ++b) acc[b] += w[kk] * sl[b * 1024 + ks * 64 + k4 * 16 + kk]; }
            }
            float* P = (float*)(ws + WS_ADAP);
#pragma unroll
            for (int b = 0; b < 8; ++b) *(f32x4*)(P + (size_t)(ks * 8 + b) * 6144 + j) = acc[b];
            continue; }
        r -= J_ADA;
        if (r < J_INA) { CONV_SMALL(w_in, 4896, 0, 24, WIN, 1024, 0, r); continue; } r -= J_INA;
        if (r < J_INB) { CONV_SMALL(w_in, 4896, 1544, 20, WIN, 1024, 1536, r); continue; } r -= J_INB;
        if (r < J_INC) { CONV_SMALL(w_in, 4896, 2848, 32, WIN, 1024, 2816, r); continue; } r -= J_INC;
        if (r < J_IND) {
            const int row = 4864 + r; const int col = (row < 4872) ? 1536 + (row - 4864) : (row < 4896 ? 2824 + (row - 4872) : -1);
            float v[16];
#pragma unroll
            for (int i = 0; i < 16; ++i) v[i] = w_in[(size_t)(lane * 16 + i) * 4896 + (col >= 0 ? col : 0)];
#pragma unroll
            for (int i = 0; i < 16; ++i) v[i] = (col >= 0) ? v[i] : 0.f;
            v4u o0, o1; o0.x = pk2(v[0], v[1]); o0.y = pk2(v[2], v[3]); o0.z = pk2(v[4], v[5]); o0.w = pk2(v[6], v[7]); o1.x = pk2(v[8], v[9]); o1.y = pk2(v[10], v[11]); o1.z = pk2(v[12], v[13]); o1.w = pk2(v[14], v[15]);
            *(v4u*)(WIN + (size_t)row * 1024 + lane * 16) = o0; *(v4u*)(WIN + (size_t)row * 1024 + lane * 16 + 8) = o1;
            continue; }
        r -= J_IND;
        if (r < J_FOX) { CONV_SMALL(A.in[12], 1024, 0, 16, (bf16*)(ws + WS_WFOX), 512, 0, r); continue; } r -= J_FOX;
        if (r < J_NSA) { CONV_SMALL(A.in[13], 1024, 0, 16, (bf16*)(ws + WS_WNSA), 512, 0, r); continue; } r -= J_NSA;
        if (r < J_MIX) { CONV_SMALL(A.in[14], 1024, 0, 16, (bf16*)(ws + WS_WMIX), 1024, 0, r); continue; } r -= J_MIX;
        if (r < J_CK) { CONV_SMALL(A.in[10], 64, 0, 1, (bf16*)(ws + WS_WCK), 2048, 0, r); continue; } r -= J_CK;
        if (r < J_CV) { CONV_SMALL(A.in[11], 64, 0, 1, (bf16*)(ws + WS_WCV), 2048, 0, r); continue; } r -= J_CV;
        if (r < J_RT) { const float* wr_ = A.in[18]; bf16* WRH = (bf16*)(ws + WS_WRT); bf16* WRL = WRH + 32 * 1024;
#pragma unroll
            for (int i = 0; i < 16; ++i) { const int k = lane + 64 * i; const float w = wr_[k * 32 + r]; const unsigned h = pk2(w, 0.f) & 0xffffu; const float hf = bf_lo(h);
                WRH[r * 1024 + k] = (bf16)h; WRL[r * 1024 + k] = (bf16)(pk2(w - hf, 0.f) & 0xffffu); }
            continue; }
        r -= J_RT;
        { const int which = r >> 6, j = r & 63; const float* pe = A.in[8 + which]; const float* wc = A.in[10 + which]; float s = 0.f;
#pragma unroll 8
            for (int i = 0; i < 32; ++i) { const int q = lane * 32 + i; s += pe[q] * wc[q * 64 + j]; }
            s = wave_sum(s); if (lane == 0) ((float*)(ws + WS_CB))[which * 64 + j] = s; }
    }
}

__device__ __forceinline__ void phase0b(const Args& A, const Ctx& X) {
    const float* P = (const float*)(X.ws + WS_ADAP); const float* b_ada = A.in[3];
    float* ADA = (float*)(X.ws + WS_ADA);
    for (int gid = blockIdx.x * 512 + X.tid; gid < 8 * 6144; gid += X.G * 512) {
        const int b = gid / 6144, col = gid % 6144; float s = b_ada[col];
#pragma unroll
        for (int ks = 0; ks < 16; ++ks) s += P[(size_t)(ks * 8 + b) * 6144 + col];
        ADA[gid] = s;
    }
    LAS float* gs = (LAS float*)X.lds;
    LAS float* sh = gs + 1024;
    const float* x = A.in[0]; const float* g = A.in[4];
    bf16* H = (bf16*)((unsigned char*)X.out + OUT_H);
    for (int ch = blockIdx.x; ch < NTOK / 128; ch += X.G) {
        const int row0 = ch * 128, b = row0 / SEQ;
        __syncthreads();
        for (int j = X.tid; j < 2048; j += 512) { float s = b_ada[j];
#pragma unroll
            for (int ks = 0; ks < 16; ++ks) s += P[(size_t)(ks * 8 + b) * 6144 + j];
            if (j < 1024) sh[j] = s; else gs[j - 1024] = g[j - 1024] * (1.f + s); }
        __syncthreads();
#define P0_ROW(V, ROW) do { float ss = 0.f; \
            _Pragma("unroll") for (int j = 0; j < 4; ++j) ss += (V[j].x * V[j].x + V[j].y * V[j].y) + (V[j].z * V[j].z + V[j].w * V[j].w); \
            const float rstd = 1.f / sqrtf(wave_sum(ss) * (1.f / DM) + RMS_EPS); v2u* o8 = (v2u*)(H + (size_t)(ROW) * DM) + X.lane; \
            _Pragma("unroll") for (int j = 0; j < 4; ++j) { const int k = 4 * X.lane + 256 * j; const f32x4 gg = *(LAS f32x4*)(gs + k), ss4 = *(LAS f32x4*)(sh + k); \
                v2u o; o.x = pk2(V[j].x * rstd * gg.x + ss4.x, V[j].y * rstd * gg.y + ss4.y); o.y = pk2(V[j].z * rstd * gg.z + ss4.z, V[j].w * rstd * gg.w + ss4.w); o8[64 * j] = o; } } while (0)
#define P0_LOAD(V, ROW) do { const f32x4* xr_ = (const f32x4*)(x + (size_t)(ROW) * DM) + X.lane; _Pragma("unroll") for (int j = 0; j < 4; ++j) V[j] = __builtin_nontemporal_load(xr_ + 64 * j); } while (0)
        { f32x4 vA[4], vB[4]; const int wrow0 = row0 + X.wave;
          for (int i = 0; i < 16; ++i) { P0_LOAD(vA, wrow0 + 8 * i); P0_ROW(vA, wrow0 + 8 * i); } (void)vB; }
#undef P0_ROW
#undef P0_LOAD
    }
}

__device__ __forceinline__ void phase2(const Args& A, const Ctx& X) {
    const int lane = X.lane, wid = X.wave, r32 = lane & 31, hi = lane >> 5;
    LAS float* red = (LAS float*)X.lds;
    for (int it = blockIdx.x; it < 256; it += X.G) {
        const int cblk = it & 7, which = (it >> 3) & 1, bg = it >> 4;
        const bf16* src = (const bf16*)(X.ws + WS_KV6) + (size_t)which * KV6_STRIDE + (size_t)bg * SEQ * 64;
        const bf16* WT = (const bf16*)(X.ws + (which ? WS_WCV : WS_WCK));
        const int c0 = cblk * 32, kbase = wid * 256;
        f32x16 acc0 = {}, acc1 = {};
        const bf16* ap = src + (size_t)(16 * (c0 + r32)) * 64 + kbase + hi * 8;
        const bf16* bp0 = WT + (size_t)r32 * 2048 + kbase + hi * 8;
        const bf16* bp1 = WT + (size_t)(32 + r32) * 2048 + kbase + hi * 8;
#pragma unroll
        for (int kk = 0; kk < 16; ++kk) {
            const bf16x8 a = *(const bf16x8*)(ap + kk * 16), b0 = *(const bf16x8*)(bp0 + kk * 16), b1 = *(const bf16x8*)(bp1 + kk * 16);
            acc0 = __builtin_amdgcn_mfma_f32_32x32x16_bf16(a, b0, acc0, 0, 0, 0);
            acc1 = __builtin_amdgcn_mfma_f32_32x32x16_bf16(a, b1, acc1, 0, 0, 0);
        }
        __syncthreads();
#pragma unroll
        for (int r = 0; r < 16; ++r) { const int row = (r & 3) + 8 * (r >> 2) + 4 * hi; red[(wid * 32 + row) * 64 + r32] = acc0[r]; red[(wid * 32 + row) * 64 + 32 + r32] = acc1[r]; }
        __syncthreads();
        { const int c = X.tid >> 4, n4 = (X.tid & 15) * 4; f32x4 s = *(const f32x4*)((const float*)(X.ws + WS_CB) + which * 64 + n4);
#pragma unroll
          for (int w = 0; w < 8; ++w) s += *(LAS f32x4*)(red + (w * 32 + c) * 64 + n4);
          if (c0 + c == 255) s = (f32x4){0.f, 0.f, 0.f, 0.f};
          v2u o; o.x = pk2(s.x, s.y); o.y = pk2(s.z, s.w);
          *(v2u*)((bf16*)(X.ws + (which ? WS_VC : WS_KC)) + ((size_t)bg * 256 + c0 + c) * 64 + n4) = o; }
    }
    for (int sq = blockIdx.x; sq < 64; sq += X.G) {
        const int b = sq >> 3, h = sq & 7; const float* lf = (const float*)(X.ws + WS_LOGF) + (size_t)b * SEQ * 8 + h;
        float v[8];
#pragma unroll
        for (int i = 0; i < 8; ++i) v[i] = lf[(size_t)(X.tid * 8 + i) * 8];
#pragma unroll
        for (int i = 1; i < 8; ++i) v[i] += v[i - 1];
        float incl = v[7];
#pragma unroll
        for (int o = 1; o < 64; o <<= 1) { const float t = __shfl_up(incl, o); if (lane >= o) incl += t; }
        __syncthreads();
        if (lane == 63) red[wid] = incl;
        __syncthreads();
        float pre = incl - v[7];
        for (int w = 0; w < wid; ++w) pre += red[w];
        float* kb = (float*)(X.ws + WS_KBIAS) + (size_t)sq * SEQ + X.tid * 8;
        *(f32x4*)kb = (f32x4){-(pre + v[0]) * LOG2E, -(pre + v[1]) * LOG2E, -(pre + v[2]) * LOG2E, -(pre + v[3]) * LOG2E};
        *(f32x4*)(kb + 4) = (f32x4){-(pre + v[4]) * LOG2E, -(pre + v[5]) * LOG2E, -(pre + v[6]) * LOG2E, -(pre + v[7]) * LOG2E};
        { v4u* kx = (v4u*)((bf16*)(X.ws + WS_KX) + ((size_t)sq * SEQ + X.tid * 8) * 8);
#pragma unroll
          for (int i = 0; i < 8; ++i) { const float b0 = -(pre + v[i]) * LOG2E; const unsigned h = pk2(b0, 0.f) & 0xffffu; const float r1 = b0 - bf_lo(h); const unsigned md = pk2(r1, 0.f) & 0xffffu; const float r2 = r1 - bf_lo(md);
              kx[i] = (v4u){h | (md << 16), pk2(r2, 0.f) & 0xffffu, 0u, 0u}; } }
    }
}

__device__ __forceinline__ v4u pack8(const f32x4 a, const f32x4 b) { v4u w; w.x = pk2(a[0], a[1]); w.y = pk2(a[2], a[3]); w.z = pk2(b[0], b[1]); w.w = pk2(b[2], b[3]); return w; }

struct EpiInProj {
    unsigned char* ws; const float* b_forget;
    __device__ __forceinline__ void operator()(const f32x4 (&acc)[2][2][4][2], const pg8::Unit& u, int wr, int wc, int fr, int fq) const {
        part<0>(acc, u, wr, wc, fr, fq); part<1>(acc, u, wr, wc, fr, fq);
    }
    template <int bj> __device__ __forceinline__ void part(const f32x4 (&acc)[2][2][4][2], const pg8::Unit& u, int wr, int wc, int fr, int fq) const {
        const int row0 = u.pm * 256 + wr * 64 + fr, b = (u.pm * 256) >> 12;
        {
            const int cb = u.pn * 256 + bj * 128 + wc * 32;
            if (cb >= 4896) return;
            if (cb < 4864) {
                bf16* base; int pitch; float scl = 1.f; bool sig = false;
                if (cb < 2048) { const int tt = cb >> 9, head = (cb & 511) >> 6; if (tt == 0 || tt == 3) scl = QSCALE; pitch = 64;
                    base = (bf16*)(ws + WS_FQ) + (size_t)tt * ((size_t)NTOK * 512) + ((size_t)(b * 7 + head) * SEQ) * 64 + (cb & 63) + 8 * fq; }
                else if (cb < 2816) { const int q = cb - 2048, idx6 = q >> 7, grp = (q & 127) >> 6; pitch = 64;
                    base = (bf16*)(ws + WS_KV6) + (size_t)idx6 * KV6_STRIDE + ((size_t)(b + grp) * SEQ) * 64 + (cb & 63) + 8 * fq; }
                else { const int q = cb - 2816, which = q >> 10; pitch = 1024; sig = true; base = (bf16*)(ws + (which ? WS_SGN : WS_SGF)) + (q & 1023) + 8 * fq; }
#pragma unroll
                for (int ai = 0; ai < 2; ++ai)
#pragma unroll
                    for (int m = 0; m < 4; ++m) {
                        const int row = row0 + ai * 128 + m * 16;
                        f32x4 v0 = acc[ai][bj][m][0], v1 = acc[ai][bj][m][1];
                        if (sig) {
#pragma unroll
                            for (int i = 0; i < 4; ++i) { v0[i] = sigmoidf_(v0[i]); v1[i] = sigmoidf_(v1[i]); }
                        } else { v0 = v0 * scl; v1 = v1 * scl; }
                        *(v4u*)(base + (size_t)row * pitch) = pack8(v0, v1);
                    }
            } else {
#pragma unroll
                for (int ai = 0; ai < 2; ++ai)
#pragma unroll
                    for (int m = 0; m < 4; ++m) {
                        const int row = row0 + ai * 128 + m * 16;
                        const f32x4 v0 = acc[ai][bj][m][0], v1 = acc[ai][bj][m][1]; f32x4 o0, o1;
                        if (fq == 0) {
#pragma unroll
                            for (int i = 0; i < 4; ++i) { const float z0 = v0[i] + b_forget[i], z1 = v1[i] + b_forget[4 + i];
                                o0[i] = fminf(z0, 0.f) - log1pf(__expf(-fabsf(z0))); o1[i] = fminf(z1, 0.f) - log1pf(__expf(-fabsf(z1))); }
                        } else {
#pragma unroll
                            for (int i = 0; i < 4; ++i) { o0[i] = sigmoidf_(v0[i]); o1[i] = sigmoidf_(v1[i]); }
                        }
                        float* dst = (fq == 0) ? (float*)(ws + WS_LOGF) + (size_t)row * 8 : (float*)(ws + WS_GATES) + (size_t)row * 24 + 8 * (fq - 1);
                        *(f32x4*)dst = o0; *(f32x4*)(dst + 4) = o1;
                    }
            }
        }
    }
};

template <bool ADD> struct EpiGate {
    bf16* O; const bf16* SG;
    __device__ __forceinline__ void operator()(const f32x4 (&acc)[2][2][4][2], const pg8::Unit& u, int wr, int wc, int fr, int fq) const {
        const size_t off0 = (size_t)(u.pm * 256 + wr * 64 + fr) * 1024 + u.pn * 256 + wc * 32 + 8 * fq;
#pragma unroll
        for (int ai = 0; ai < 2; ++ai) {
            v4u g[4][2], p[4][2];
#pragma unroll
            for (int m = 0; m < 4; ++m)
#pragma unroll
                for (int bj = 0; bj < 2; ++bj) { const size_t off = off0 + (size_t)(ai * 128 + m * 16) * 1024 + bj * 128; g[m][bj] = __builtin_nontemporal_load((const v4u*)(SG + off)); if (ADD) p[m][bj] = *(const v4u*)(O + off); }
#pragma unroll
            for (int m = 0; m < 4; ++m)
#pragma unroll
                for (int bj = 0; bj < 2; ++bj) {
                    const size_t off = off0 + (size_t)(ai * 128 + m * 16) * 1024 + bj * 128; const v4u gg = g[m][bj];
                    f32x4 v0 = acc[ai][bj][m][0], v1 = acc[ai][bj][m][1];
                    v0[0] *= bf_lo(gg.x); v0[1] *= bf_hi(gg.x); v0[2] *= bf_lo(gg.y); v0[3] *= bf_hi(gg.y); v1[0] *= bf_lo(gg.z); v1[1] *= bf_hi(gg.z); v1[2] *= bf_lo(gg.w); v1[3] *= bf_hi(gg.w);
                    if (ADD) { const v4u pp = p[m][bj];
                        v0[0] += bf_lo(pp.x); v0[1] += bf_hi(pp.x); v0[2] += bf_lo(pp.y); v0[3] += bf_hi(pp.y); v1[0] += bf_lo(pp.z); v1[1] += bf_hi(pp.z); v1[2] += bf_lo(pp.w); v1[3] += bf_hi(pp.w); }
                    *(v4u*)(O + off) = pack8(v0, v1);
                }
        }
    }
};

struct EpiPlain {
    bf16* O; int ldc;
    __device__ __forceinline__ void operator()(const f32x4 (&acc)[2][2][4][2], const pg8::Unit& u, int wr, int wc, int fr, int fq) const {
#pragma unroll
        for (int ai = 0; ai < 2; ++ai)
#pragma unroll
            for (int m = 0; m < 4; ++m)
#pragma unroll
                for (int bj = 0; bj < 2; ++bj) {
                    const size_t off = (size_t)(u.pm * 256 + ai * 128 + wr * 64 + m * 16 + fr) * ldc + u.pn * 256 + bj * 128 + wc * 32 + 8 * fq;
                    *(v4u*)(O + off) = pack8(acc[ai][bj][m][0], acc[ai][bj][m][1]);
                }
    }
};

struct MoeOrder {
    int G, c, NP, mode;
    LAS const int* tab; LAS const int* rowtab;
    __device__ __forceinline__ bool next(int i, pg8::Unit& u) const {
        const int ntile = tab[32 + 32], x = c & 7, y = c >> 3, per = G >> 3, nx = (ntile - x + 7) >> 3;
        const int U = i * per + y;
        if (U >= nx * NP) return false;
        const int ti = x + 8 * (U / NP), pnl = U % NP; int e = 0;
#pragma unroll 1
        for (int k = 1; k < 32; ++k) e = (tab[32 + k] <= ti) ? k : e;
        u.e = e; u.rt = ti - tab[32 + e]; u.pm = ti; u.pn = e * NP + pnl; u.ord = i; return true;
    }
    __device__ __forceinline__ unsigned a_off(const pg8::Unit& u, int r) const {
        if (mode == 0) return (unsigned)(rowtab[u.ord * 256 + r] >> 2) * 2048u;
        const int cnt = tab[u.e]; int rank = u.rt * 256 + r; rank = rank < cnt ? rank : cnt - 1;
        return (unsigned)(tab[65 + u.e] + rank) * 2048u;
    }
};
__device__ __forceinline__ void moe_tables(const Args& A, const Ctx& X) {
    LAS int* tab = (LAS int*)(X.lds + TAB_OFF);
    __syncthreads();
    if (X.tid == 0) { const unsigned* ctl = (const unsigned*)(X.ws + WS_CTL); int ts = 0, gs = 0;
        for (int e = 0; e < 32; ++e) { const int cnt = (int)__hip_atomic_load(ctl + CW_ECNT + 64 * e, __ATOMIC_RELAXED, __HIP_MEMORY_SCOPE_AGENT); tab[e] = cnt; tab[32 + e] = ts; tab[65 + e] = gs; ts += (cnt + 255) >> 8; gs += cnt; }
        tab[32 + 32] = ts; tab[65 + 32] = gs; }
    __syncthreads();
}
__device__ __forceinline__ void moe_rowtab(const Ctx& X, const MoeOrder& S, const int* tokof) {
    LAS int* rt = (LAS int*)(X.lds + ROWTAB_OFF); pg8::Unit u;
    for (int i = X.tid >> 8; S.next(i, u); i += 2) { const int r = X.tid & 255, cnt = S.tab[u.e]; int rank = u.rt * 256 + r; rank = rank < cnt ? rank : cnt - 1;
        rt[i * 256 + r] = tokof[(size_t)u.e * NTOK + rank]; }
    __syncthreads();
}

struct EpiGateUp {
    bf16* ACT; const float* bg; const float* bu; LAS const int* tab; bf16* dummy;
    __device__ __forceinline__ void operator()(const f32x4 (&acc)[2][2][4][2], const pg8::Unit& u, int wr, int wc, int fr, int fq) const {
        const int e = u.e, pnl = u.pn - e * 8, col = pnl * 128 + wc * 32 + 8 * fq, cnt = tab[e], gs = tab[65 + e];
        const f32x4 g0 = *(const f32x4*)(bg + e * 1024 + col), g1 = *(const f32x4*)(bg + e * 1024 + col + 4), u0 = *(const f32x4*)(bu + e * 1024 + col), u1 = *(const f32x4*)(bu + e * 1024 + col + 4);
        bf16* const sink = dummy + threadIdx.x * 8;
#pragma unroll
        for (int ai = 0; ai < 2; ++ai)
#pragma unroll
            for (int m = 0; m < 4; ++m) {
                const int rank = u.rt * 256 + ai * 128 + wr * 64 + m * 16 + fr;
                f32x4 a0 = acc[ai][0][m][0] + g0, a1 = acc[ai][0][m][1] + g1, b0 = acc[ai][1][m][0] + u0, b1 = acc[ai][1][m][1] + u1, o0, o1;
#pragma unroll
                for (int i = 0; i < 4; ++i) {
                    float gt = fminf(a0[i], 7.f), up = fminf(fmaxf(b0[i], -7.f), 7.f); o0[i] = gt * (up + 1.f) * __builtin_amdgcn_rcpf(1.f + __builtin_amdgcn_exp2f(-1.702f * LOG2E * gt));
                    gt = fminf(a1[i], 7.f); up = fminf(fmaxf(b1[i], -7.f), 7.f); o1[i] = gt * (up + 1.f) * __builtin_amdgcn_rcpf(1.f + __builtin_amdgcn_exp2f(-1.702f * LOG2E * gt)); }
                bf16* dst = (rank < cnt) ? ACT + (size_t)(gs + rank) * 1024 + col : sink;
                *(v4u*)dst = pack8(o0, o1);
            }
    }
};
struct EpiDown {
    unsigned char* out; unsigned char* yshi; const float* bd; LAS const int* tab; LAS const int* rowtab; unsigned char* dummy;
    __device__ __forceinline__ void operator()(const f32x4 (&acc)[2][2][4][2], const pg8::Unit& u, int wr, int wc, int fr, int fq) const {
        const int e = u.e, pnl = u.pn - e * 4, cnt = tab[e];
        f32x4 bb[2][2];
#pragma unroll
        for (int bj = 0; bj < 2; ++bj) { const int col = pnl * 256 + bj * 128 + wc * 32 + 8 * fq; bb[bj][0] = *(const f32x4*)(bd + e * 1024 + col); bb[bj][1] = *(const f32x4*)(bd + e * 1024 + col + 4); }
        unsigned char* const sink = dummy + threadIdx.x * 16;
        const long long dlt = (long long)(yshi - out);
#pragma unroll
        for (int ai = 0; ai < 2; ++ai)
#pragma unroll
            for (int m = 0; m < 4; ++m) {
                const int r = ai * 128 + wr * 64 + m * 16 + fr, rank = u.rt * 256 + r;
                const int id = rowtab[u.ord * 256 + r], tok = id >> 2, k = id & 3;
                unsigned char* rowp = out + ((k >= 2) ? dlt : 0ll) + (size_t)tok * 4096 + (k & 1) * 2048;
#pragma unroll
                for (int bj = 0; bj < 2; ++bj) { const int col = pnl * 256 + bj * 128 + wc * 32 + 8 * fq;
                    unsigned char* dst = (rank < cnt) ? rowp + col * 2 : sink;
                    *(v4u*)dst = pack8(acc[ai][bj][m][0] + bb[bj][0], acc[ai][bj][m][1] + bb[bj][1]); }
            }
    }
};

__device__ __forceinline__ f32x4 ld_bf4(const bf16* p) { const v2u u = *(const v2u*)p; return (f32x4){bf_lo(u.x), bf_hi(u.x), bf_lo(u.y), bf_hi(u.y)}; }

__device__ __forceinline__ void top4_of8(const float (&v)[8], const int (&id)[8], float (&ov)[4], int (&oi)[4]) {
    unsigned taken = 0u;
#pragma unroll
    for (int k = 0; k < 4; ++k) { float best = -3.4e38f; int bi = 0x7fffffff, bp = 0;
#pragma unroll
        for (int c = 0; c < 8; ++c) { const bool free_ = ((taken >> c) & 1u) == 0u; const bool better = free_ && ((v[c] > best) || (v[c] == best && id[c] < bi)); best = better ? v[c] : best; bi = better ? id[c] : bi; bp = better ? c : bp; }
        ov[k] = best; oi[k] = bi; taken |= 1u << bp; }
}

__device__ __forceinline__ void phase6(const Args& A, const Ctx& X) {
    const float* x = A.in[0]; const float* gpost = A.in[5]; const float* gpre2 = A.in[16]; const float* b_router = A.in[19];
    const float* ADA = (const float*)(X.ws + WS_ADA);
    const bf16* WRH = (const bf16*)(X.ws + WS_WRT); const bf16* WRL = WRH + 32 * 1024;
    const bf16* MIXED = (const bf16*)(X.ws + WS_MIXED); bf16* H2 = (bf16*)((unsigned char*)X.out + OUT_H2); bf16* H2L = (bf16*)((unsigned char*)X.out + OUT_H2LO);
    int* TOPE = (int*)(X.ws + WS_TOPE); float* TOPW = (float*)(X.ws + WS_TOPW); int* RANK = (int*)(X.ws + WS_RANK); int* TOKOF = (int*)(X.ws + WS_TOKOF);
    unsigned* ctl = (unsigned*)(X.ws + WS_CTL);
    LAS unsigned char* wr_lds = X.lds;
    for (int pidx = X.tid; pidx < 8192; pidx += 512) { const int tb = pidx >> 12, row = (pidx & 4095) >> 7, c = pidx & 127;
        *(LAS v4u*)(wr_lds + tb * 66048 + row * 2064 + c * 16) = *(const v4u*)((tb ? WRL : WRH) + row * 1024 + c * 8); }
    LAS float* v_g1 = (LAS float*)(X.lds + ROWTAB_OFF);
    LAS float* v_g2 = v_g1 + 1024;
    LAS float* v_s2 = v_g2 + 1024;
    LAS int* e_of = (LAS int*)(v_s2 + 1024);
    LAS int* lcnt = e_of + 512;
    LAS int* lbase = lcnt + 32;
    const int lane = X.lane;
    for (int ch = blockIdx.x; ch < NTOK / 128; ch += X.G) {
        const int row0 = ch * 128, b = row0 / SEQ;
        __syncthreads();
        for (int j = X.tid; j < 1024; j += 512) { v_g1[j] = ADA[b * 6144 + 2048 + j] * gpost[j]; v_g2[j] = gpre2[j] * (1.f + ADA[b * 6144 + 4096 + j]); v_s2[j] = ADA[b * 6144 + 3072 + j]; }
        if (X.tid < 32) lcnt[X.tid] = 0;
        __syncthreads();
#ifdef PROBE_SUB
        unsigned tp6_ = (unsigned)__builtin_amdgcn_s_memrealtime();
#define P6STAMP(k) do { if (blockIdx.x == 0 && X.tid == 0) { const unsigned t_ = (unsigned)__builtin_amdgcn_s_memrealtime(); ((volatile LAS unsigned*)(X.lds + MISC_OFF))[50 + (k)] += t_ - tp6_; tp6_ = t_; } } while (0)
#else
#define P6STAMP(k) do { } while (0)
#endif
        const int wrow0 = row0 + X.wave;
#define P6_LOAD(MV, XV, ROW) do { _Pragma("unroll") for (int j = 0; j < 4; ++j) { const int k = 4 * lane + 256 * j; MV[j] = __builtin_nontemporal_load((const v2u*)(MIXED + (size_t)(ROW) * 1024 + k)); XV[j] = __builtin_nontemporal_load((const f32x4*)(x + (size_t)(ROW) * 1024 + k)); } } while (0)
#define P6_ROW(MVR, XVR, ROW) do { f32x4 mv[4], xv[4]; float ss = 0.f; \
            _Pragma("unroll") for (int j = 0; j < 4; ++j) { mv[j] = (f32x4){bf_lo(MVR[j].x), bf_hi(MVR[j].x), bf_lo(MVR[j].y), bf_hi(MVR[j].y)}; xv[j] = XVR[j]; \
                ss += (mv[j].x * mv[j].x + mv[j].y * mv[j].y) + (mv[j].z * mv[j].z + mv[j].w * mv[j].w); } \
            const float r1 = 1.f / sqrtf(wave_sum(ss) * (1.f / DM) + RMS_EPS); float s2 = 0.f; \
            _Pragma("unroll") for (int j = 0; j < 4; ++j) { const int k = 4 * lane + 256 * j; const f32x4 g = *(LAS f32x4*)(v_g1 + k); xv[j] = xv[j] + g * (mv[j] * r1); \
                s2 += (xv[j].x * xv[j].x + xv[j].y * xv[j].y) + (xv[j].z * xv[j].z + xv[j].w * xv[j].w); } \
            const float r2 = 1.f / sqrtf(wave_sum(s2) * (1.f / DM) + RMS_EPS); \
            _Pragma("unroll") for (int j = 0; j < 4; ++j) { const int k = 4 * lane + 256 * j; const f32x4 g = *(LAS f32x4*)(v_g2 + k), s = *(LAS f32x4*)(v_s2 + k); xv[j] = xv[j] * r2 * g + s; \
                v2u o; o.x = pk2(xv[j].x, xv[j].y); o.y = pk2(xv[j].z, xv[j].w); *(v2u*)(H2 + (size_t)(ROW) * 1024 + k) = o; \
                v2u ol; ol.x = pk2(xv[j].x - bf_lo(o.x), xv[j].y - bf_hi(o.x)); ol.y = pk2(xv[j].z - bf_lo(o.y), xv[j].w - bf_hi(o.y)); *(v2u*)(H2L + (size_t)(ROW) * 1024 + k) = ol; } } while (0)
        { v2u mA[4], mB[4]; f32x4 xA[4], xB[4];
          P6_LOAD(mA, xA, wrow0);
          for (int i = 0; i < 16; i += 2) {
              P6_LOAD(mB, xB, wrow0 + 8 * (i + 1));
              P6_ROW(mA, xA, wrow0 + 8 * i);
              if (i + 2 < 16) P6_LOAD(mA, xA, wrow0 + 8 * (i + 2));
              P6_ROW(mB, xB, wrow0 + 8 * (i + 1));
          } }
#undef P6_LOAD
#undef P6_ROW
        P6STAMP(0);
        asm volatile("s_waitcnt vmcnt(0)" ::: "memory");
        P6STAMP(1);
        f32x4 acc0 = {0.f, 0.f, 0.f, 0.f}, acc1 = {0.f, 0.f, 0.f, 0.f};
        { const int q = lane >> 4, t16 = lane & 15;
          const bf16* bh_p = H2 + (size_t)(wrow0 + 8 * t16) * 1024 + 8 * q; const bf16* bl_p = H2L + (size_t)(wrow0 + 8 * t16) * 1024 + 8 * q;
          LAS const unsigned char* ah_p = wr_lds + t16 * 2064 + 16 * q; LAS const unsigned char* al_p = ah_p + 66048;
#pragma unroll 8
          for (int kk = 0; kk < 32; ++kk) {
              const bf16x8 bh = __builtin_nontemporal_load((const bf16x8*)(bh_p + 32 * kk)), bl = __builtin_nontemporal_load((const bf16x8*)(bl_p + 32 * kk));
              const bf16x8 ah0 = *(LAS const bf16x8*)(ah_p + 64 * kk), al0 = *(LAS const bf16x8*)(al_p + 64 * kk), ah1 = *(LAS const bf16x8*)(ah_p + 16 * 2064 + 64 * kk), al1 = *(LAS const bf16x8*)(al_p + 16 * 2064 + 64 * kk);
              acc0 = __builtin_amdgcn_mfma_f32_16x16x32_bf16(ah0, bh, acc0, 0, 0, 0); acc0 = __builtin_amdgcn_mfma_f32_16x16x32_bf16(al0, bh, acc0, 0, 0, 0); acc0 = __builtin_amdgcn_mfma_f32_16x16x32_bf16(ah0, bl, acc0, 0, 0, 0);
              acc1 = __builtin_amdgcn_mfma_f32_16x16x32_bf16(ah1, bh, acc1, 0, 0, 0); acc1 = __builtin_amdgcn_mfma_f32_16x16x32_bf16(al1, bh, acc1, 0, 0, 0); acc1 = __builtin_amdgcn_mfma_f32_16x16x32_bf16(ah1, bl, acc1, 0, 0, 0);
          }
          P6STAMP(2);
          float cv[8]; int ci[8];
#pragma unroll
          for (int r = 0; r < 4; ++r) { ci[r] = 4 * q + r; cv[r] = acc0[r] + b_router[4 * q + r]; ci[4 + r] = 16 + 4 * q + r; cv[4 + r] = acc1[r] + b_router[16 + 4 * q + r]; }
          float tv[4]; int te[4];
          top4_of8(cv, ci, tv, te);
#pragma unroll
          for (int st = 16; st <= 32; st <<= 1) {
#pragma unroll
              for (int k = 0; k < 4; ++k) { cv[k] = tv[k]; ci[k] = te[k]; cv[4 + k] = __shfl_xor(tv[k], st); ci[4 + k] = __shfl_xor(te[k], st); }
              top4_of8(cv, ci, tv, te);
          }
          const float e1 = __expf(tv[1] - tv[0]), e2 = __expf(tv[2] - tv[0]), e3 = __expf(tv[3] - tv[0]), inv = 1.f / (1.f + e1 + e2 + e3);
          if (lane < 16) { const int row = wrow0 + 8 * lane, rl = X.wave + 8 * lane;
              *(int4*)(TOPE + (size_t)row * 4) = make_int4(te[0], te[1], te[2], te[3]); *(f32x4*)(TOPW + (size_t)row * 4) = (f32x4){inv, e1 * inv, e2 * inv, e3 * inv};
              e_of[rl * 4 + 0] = te[0]; e_of[rl * 4 + 1] = te[1]; e_of[rl * 4 + 2] = te[2]; e_of[rl * 4 + 3] = te[3]; }
        }
        P6STAMP(3);
        __syncthreads();
        const int e = e_of[X.tid]; const int lr = __hip_atomic_fetch_add(&lcnt[e], 1, __ATOMIC_RELAXED, __HIP_MEMORY_SCOPE_WORKGROUP);
        __syncthreads();
        if (X.tid < 32) lbase[X.tid] = (int)__hip_atomic_fetch_add(ctl + CW_ECNT + 64 * X.tid, (unsigned)lcnt[X.tid], __ATOMIC_RELAXED, __HIP_MEMORY_SCOPE_AGENT);
        __syncthreads();
        { const int rank = lbase[e] + lr, id = (row0 + (X.tid >> 2)) * 4 + (X.tid & 3); RANK[id] = rank; TOKOF[(size_t)e * NTOK + rank] = id; }
        P6STAMP(4);
    }
}

__device__ __forceinline__ void phase10(const Args& A, const Ctx& X) {
    const float* x = A.in[0]; const float* gpost = A.in[5]; const float* gpost2 = A.in[17];
    const float* ADA = (const float*)(X.ws + WS_ADA); const bf16* MIXED = (const bf16*)(X.ws + WS_MIXED);
    const float* TOPW = (const float*)(X.ws + WS_TOPW);
    LAS float* v_g1 = (LAS float*)X.lds; LAS float* v_g3 = v_g1 + 1024;
    const int lane = X.lane;
    for (int ch = blockIdx.x; ch < NTOK / 128; ch += X.G) {
        const int row0 = ch * 128, b = row0 / SEQ;
        __syncthreads();
        for (int j = X.tid; j < 1024; j += 512) { v_g1[j] = ADA[b * 6144 + 2048 + j] * gpost[j]; v_g3[j] = ADA[b * 6144 + 5120 + j] * gpost2[j]; }
        __syncthreads();
#define P10_LOAD(TW, MV, XV, YV, ROW) do { TW = *(const f32x4*)(TOPW + (size_t)(ROW) * 4); \
            const bf16* y0_ = (const bf16*)((const unsigned char*)X.out + (size_t)(ROW) * 4096); const bf16* y2_ = (const bf16*)(X.ws + WS_YSHI + (size_t)(ROW) * 4096); \
            _Pragma("unroll") for (int j = 0; j < 4; ++j) { const int k = 4 * lane + 256 * j; MV[j] = __builtin_nontemporal_load((const v2u*)(MIXED + (size_t)(ROW) * 1024 + k)); XV[j] = __builtin_nontemporal_load((const f32x4*)(x + (size_t)(ROW) * 1024 + k)); \
                YV[0][j] = __builtin_nontemporal_load((const v2u*)(y0_ + k)); YV[1][j] = __builtin_nontemporal_load((const v2u*)(y0_ + 1024 + k)); YV[2][j] = __builtin_nontemporal_load((const v2u*)(y2_ + k)); YV[3][j] = __builtin_nontemporal_load((const v2u*)(y2_ + 1024 + k)); } } while (0)
#define UNP_(u) ((f32x4){bf_lo((u).x), bf_hi((u).x), bf_lo((u).y), bf_hi((u).y)})
#define P10_ROW(TW, MV, XV, YV, ROW) do { f32x4 mv[4], yv[4]; float ss = 0.f, sy = 0.f; \
            _Pragma("unroll") for (int j = 0; j < 4; ++j) { mv[j] = UNP_(MV[j]); yv[j] = UNP_(YV[0][j]) * TW.x + UNP_(YV[1][j]) * TW.y + UNP_(YV[2][j]) * TW.z + UNP_(YV[3][j]) * TW.w; \
                ss += (mv[j].x * mv[j].x + mv[j].y * mv[j].y) + (mv[j].z * mv[j].z + mv[j].w * mv[j].w); \
                sy += (yv[j].x * yv[j].x + yv[j].y * yv[j].y) + (yv[j].z * yv[j].z + yv[j].w * yv[j].w); } \
            const float r1 = 1.f / sqrtf(wave_sum(ss) * (1.f / DM) + RMS_EPS), r3 = 1.f / sqrtf(wave_sum(sy) * (1.f / DM) + RMS_EPS);     \
            _Pragma("unroll") for (int j = 0; j < 4; ++j) { const int k = 4 * lane + 256 * j; const f32x4 g1 = *(LAS f32x4*)(v_g1 + k), g3 = *(LAS f32x4*)(v_g3 + k); \
                *(f32x4*)(X.out + (size_t)(ROW) * 1024 + k) = XV[j] + g1 * (mv[j] * r1) + g3 * (yv[j] * r3); } } while (0)
        { f32x4 twA, twB, xA[4], xB[4]; v2u mA[4], mB[4], yA[4][4], yB[4][4]; const int wrow0 = row0 + X.wave;
          for (int i = 0; i < 16; ++i) { P10_LOAD(twA, mA, xA, yA, wrow0 + 8 * i); P10_ROW(twA, mA, xA, yA, wrow0 + 8 * i); }
          (void)twB; (void)mB; (void)xB; (void)yB; }
#undef P10_LOAD
#undef P10_ROW
#undef UNP_
    }
}

constexpr int KT = 9216;
constexpr int AL_K = 0, AL_V = 36864, AL_ZERO = 69632, AL_TBL = 70656, AL_SELM = 72704, AL_TB2 = 73216, AL_IMPW = 78336;
constexpr float SM_THR = 24.f;
typedef short v4i16_t __attribute__((ext_vector_type(4)));
__device__ __forceinline__ int crow(int r, int hi) { return (r & 3) + 8 * (r >> 2) + 4 * hi; }
__device__ __forceinline__ s16x4 vtr(LAS const unsigned char* p) { return __builtin_bit_cast(s16x4, __builtin_amdgcn_ds_read_tr16_b64_v4i16((LAS v4i16_t*)p)); }

constexpr int AL_TT = 78336;
constexpr int TB2_LEN = 320, TB2_NEG = 64;
constexpr int CVQ_TOTAL = 96 * 256;
struct SideJob { f32x4 V[8]; int q; int loaded; int half; int pend; };
#define SJ_STEP(sj, A, ws, NGW) do { int pn_ = 0; \
        if ((sj).loaded) { CV_LDSW((sj).V, (sj).half); if ((sj).half) { const float* s_; bf16* d_; exp_src_dst(A, ws, (sj).q, s_, d_); CV_OUT(d_, 1024); (sj).q += (NGW); pn_ += 8; } (sj).half ^= 1; (sj).loaded = 0; } \
        if ((sj).q < CVQ_TOTAL) { const float* s_; bf16* d_; exp_src_dst(A, ws, (sj).q, s_, d_); CV_LOADH((sj).V, s_, 1024, (sj).half); (sj).loaded = 1; pn_ += 8; } (sj).pend = pn_; } while (0)

__device__ __forceinline__ void qk_tile(f32x16& p0, f32x16& p1, const f32x16& c0, const f32x16& c1, LAS const unsigned char* Ks, const bf16x8 (&qr)[4], int r32, int hi) {
    LAS const unsigned char* kb = Ks + hi * 1024 + r32 * 16;
    bf16x8 kf[8];
#pragma unroll
    for (int d0 = 0; d0 < 4; ++d0) { kf[2 * d0] = *(LAS const bf16x8*)(kb + d0 * 2048); kf[2 * d0 + 1] = *(LAS const bf16x8*)(kb + d0 * 2048 + 512); }
    __builtin_amdgcn_sched_barrier(0);
    p0 = __builtin_amdgcn_mfma_f32_32x32x16_bf16(kf[0], qr[0], c0, 0, 0, 0); p1 = __builtin_amdgcn_mfma_f32_32x32x16_bf16(kf[1], qr[0], c1, 0, 0, 0);
#pragma unroll
    for (int d0 = 1; d0 < 4; ++d0) { p0 = __builtin_amdgcn_mfma_f32_32x32x16_bf16(kf[2 * d0], qr[d0], p0, 0, 0, 0); p1 = __builtin_amdgcn_mfma_f32_32x32x16_bf16(kf[2 * d0 + 1], qr[d0], p1, 0, 0, 0); }
}
template <bool MASKED = false, bool LSUM = false>
__device__ __forceinline__ void pv_tile(f32x16 (&o)[2], const f32x16& p0, const f32x16& p1, LAS const unsigned char* Vs, int lane, int hi, unsigned keep, f32x16& lacc) {
    LAS const unsigned char* vb = Vs + ((lane >> 4) & 1) * 32 + (lane & 3) * 8 + (4 * hi + ((lane & 15) >> 2)) * 64;
    v4u pw[4];
    pw[0] = (v4u){pk2(p0[0], p0[1]), pk2(p0[2], p0[3]), pk2(p0[4], p0[5]), pk2(p0[6], p0[7])};
    pw[1] = (v4u){pk2(p0[8], p0[9]), pk2(p0[10], p0[11]), pk2(p0[12], p0[13]), pk2(p0[14], p0[15])};
    pw[2] = (v4u){pk2(p1[0], p1[1]), pk2(p1[2], p1[3]), pk2(p1[4], p1[5]), pk2(p1[6], p1[7])};
    pw[3] = (v4u){pk2(p1[8], p1[9]), pk2(p1[10], p1[11]), pk2(p1[12], p1[13]), pk2(p1[14], p1[15])};
    if (MASKED) {
#pragma unroll
        for (int k = 0; k < 4; ++k) pw[k] = pw[k] & keep; }
    if (LSUM) {
        const v4u on_ = (v4u){0x3F803F80u, 0x3F803F80u, 0x3F803F80u, 0x3F803F80u};
#pragma unroll
        for (int ks = 0; ks < 4; ++ks) lacc = __builtin_amdgcn_mfma_f32_32x32x16_bf16(__builtin_bit_cast(bf16x8, on_), __builtin_bit_cast(bf16x8, pw[ks]), lacc, 0, 0, 0);
    }
#pragma unroll
    for (int d0 = 0; d0 < 2; ++d0) {
        s16x4 vl[4], vh[4];
#pragma unroll
        for (int ks = 0; ks < 4; ++ks) { vl[ks] = vtr(vb + d0 * 4096 + ks * 1024); vh[ks] = vtr(vb + d0 * 4096 + ks * 1024 + 512); }
        __builtin_amdgcn_sched_barrier(0);
#pragma unroll
        for (int ks = 0; ks < 4; ++ks) {
            const bf16x8 vf = (bf16x8){vl[ks][0], vl[ks][1], vl[ks][2], vl[ks][3], vh[ks][0], vh[ks][1], vh[ks][2], vh[ks][3]};
            o[d0] = __builtin_amdgcn_mfma_f32_32x32x16_bf16(vf, __builtin_bit_cast(bf16x8, pw[ks]), o[d0], 0, 0, 0);
        }
    }
}
template <bool ADJ, bool LSUM = false>
__device__ __forceinline__ void softmax_core(f32x16& p0, f32x16& p1, f32x16& q0, f32x16& q1, float& m, float& l, f32x16 (&o)[2], f32x16& negm, bool rowon, f32x16& lacc) {
#define MX3_(a, b, c) __builtin_fmaxf(__builtin_fmaxf((a), (b)), (c))
    float ra = MX3_(p0[0], p0[1], p1[0]), rb = MX3_(p0[2], p0[3], p1[1]); ra = MX3_(ra, p1[2], p1[3]);
#pragma unroll
    for (int r = 4; r < 16; r += 4) { ra = MX3_(ra, p0[r], p0[r + 1]); rb = MX3_(rb, p0[r + 2], p0[r + 3]); ra = MX3_(ra, p1[r], p1[r + 1]); rb = MX3_(rb, p1[r + 2], p1[r + 3]); }
#undef MX3_
    float rm = __builtin_fmaxf(ra, rb);
    { auto rr = __builtin_amdgcn_permlane32_swap(__builtin_bit_cast(unsigned, rm), __builtin_bit_cast(unsigned, rm), false, false); rm = __builtin_fmaxf(__builtin_bit_cast(float, rr[0]), __builtin_bit_cast(float, rr[1])); }
    rm = rowon ? rm : NEGBIG;
    if (__any(rm > SM_THR)) {
        const float dl = fmaxf(rm, 0.f), alpha = __builtin_amdgcn_exp2f(-dl);
        m += dl; l *= alpha;
#pragma unroll
        for (int r = 0; r < 16; ++r) { p0[r] -= dl; p1[r] -= dl; o[0][r] *= alpha; o[1][r] *= alpha; negm[r] = -m; if (LSUM) lacc[r] *= alpha; }
        if (ADJ) {
#pragma unroll
            for (int r = 0; r < 16; ++r) { q0[r] -= dl; q1[r] -= dl; } }
    }
    if (LSUM) {
#pragma unroll
        for (int r = 0; r < 16; ++r) { p0[r] = __builtin_amdgcn_exp2f(p0[r]); p1[r] = __builtin_amdgcn_exp2f(p1[r]); }
    } else {
        float s = 0.f;
#pragma unroll
        for (int r = 0; r < 16; ++r) { p0[r] = __builtin_amdgcn_exp2f(p0[r]); p1[r] = __builtin_amdgcn_exp2f(p1[r]); s += p0[r] + p1[r]; }
        l += rowon ? s : 0.f;
    }
}

template <int MODE, int DRY = 0>
__device__ __forceinline__ void attn_branch(LAS unsigned char* L, int& buf, const bf16* __restrict__ Kg, const bf16* __restrict__ Vg, const bf16* __restrict__ KXg,
                                            int jlo, int jhi, const bf16x8 (&qr)[4], int tq, int tqmax, int hh, int qt, unsigned long long selm,
                                            float& m, float& l, f32x16 (&o)[2], float inv, int th, SideJob& sj, const Args& A, unsigned char* ws, int NGW) {
    const int tid = threadIdx.x, lane = tid & 63, wid = __builtin_amdgcn_readfirstlane(tid >> 6), r32 = lane & 31, hi = lane >> 5;
    LAS const float* TBL = (LAS const float*)(L + AL_TBL);
    const int koff = lane * 64 + wid * 8, voff = (16 * (wid & 3) + (lane >> 2)) * 64 + (wid >> 2) * 32 + (lane & 3) * 8;
#define ATT_GLOAD(t0_, bufn_) do { const int ta_ = (t0_), tb_ = ((t0_) + 1 <= jhi) ? (t0_) + 1 : (t0_); LAS unsigned char* kd_ = L + AL_K + (bufn_) * (2 * KT) + wid * 1024; LAS unsigned char* vd_ = L + AL_V + (bufn_) * 16384 + wid * 1024; \
        __builtin_amdgcn_global_load_lds((const unsigned*)(Kg + (size_t)ta_ * 4096 + koff), (LAS unsigned*)kd_, 16, 0, 0); __builtin_amdgcn_global_load_lds((const unsigned*)(Kg + (size_t)tb_ * 4096 + koff), (LAS unsigned*)(kd_ + KT), 16, 0, 0); \
        if (MODE != 4) { __builtin_amdgcn_global_load_lds((const unsigned*)(Vg + (size_t)ta_ * 4096 + voff), (LAS unsigned*)vd_, 16, 0, 0); __builtin_amdgcn_global_load_lds((const unsigned*)(Vg + (size_t)tb_ * 4096 + voff), (LAS unsigned*)(vd_ + 8192), 16, 0, 0); } \
        if (MODE == 0 && wid < 2) __builtin_amdgcn_global_load_lds((const unsigned*)(KXg + ((size_t)(wid ? tb_ : ta_) * 64 + lane) * 8), (LAS unsigned*)(L + AL_K + (bufn_) * (2 * KT) + wid * KT + 8192), 16, 0, 0); } while (0)
    if (DRY != 2) ATT_GLOAD(jlo, buf);
    if (MODE == 0) sj.pend = 0;
    f32x16 negm;
#pragma unroll
    for (int r = 0; r < 16; ++r) negm[r] = -m;
    const int cfar = (64 * qt >= 1167) ? ((64 * qt - 1167) >> 10) : -1;
    constexpr bool LS = (MODE == 2 || MODE == 3);
    f32x16 lacc = {};
    float carry = 0.f;
    for (int t0 = jlo; t0 <= jhi; t0 += 2) {
        LAS unsigned char* Ks = L + AL_K + buf * (2 * KT); LAS unsigned char* Vs = L + AL_V + buf * 16384;
        if (MODE == 0 && DRY == 0) { if (sj.pend == 0) asm volatile("s_waitcnt vmcnt(0)" ::: "memory"); else if (sj.pend == 8) asm volatile("s_waitcnt vmcnt(8)" ::: "memory"); else asm volatile("s_waitcnt vmcnt(16)" ::: "memory"); sj.pend = 0; }
        else asm volatile("s_waitcnt vmcnt(0)" ::: "memory");
        __syncthreads();
        if (DRY != 2 && t0 + 2 <= jhi) ATT_GLOAD(t0 + 2, buf ^ 1);
        if constexpr (MODE == 0) {
            if (DRY == 0 && (t0 & 3) == 0) { LAS bf16* TT = (LAS bf16*)(L + AL_TT + wid * 8192); SJ_STEP(sj, A, ws, NGW); }
        }
        if (DRY == 1 || (MODE == 0 && 64 * t0 > tqmax)) { buf ^= 1; continue; }
        f32x16 pa0, pa1, pb0, pb1;
        const bool mzero = (MODE != 0) && __all(m == 0.f);
#define ATT_QK(P0, P1, T, KOFF) do { \
            if (MODE == 0) { \
                { LAS const unsigned char* xa_ = hi ? (LAS const unsigned char*)(L + AL_ZERO + r32 * 16) : (LAS const unsigned char*)(Ks + (KOFF) + 8192 + r32 * 16);     \
                  const bf16x8 kx0_ = *(LAS const bf16x8*)xa_, kx1_ = *(LAS const bf16x8*)(xa_ + 512); int hv_ = hi; asm volatile("" : "+v"(hv_)); \
                  const v4u qxu_ = (v4u){hv_ ? 0u : 0x3F803F80u, hv_ ? 0u : 0x00003F80u, 0u, 0u}; const bf16x8 qx = __builtin_bit_cast(bf16x8, qxu_);     \
                  P0 = __builtin_amdgcn_mfma_f32_32x32x16_bf16(kx0_, qx, negm, 0, 0, 0); P1 = __builtin_amdgcn_mfma_f32_32x32x16_bf16(kx1_, qx, negm, 0, 0, 0); } \
                qk_tile(P0, P1, P0, P1, Ks + (KOFF), qr, r32, hi); } \
            else { const f32x16 z_ = {}; qk_tile(P0, P1, z_, z_, Ks + (KOFF), qr, r32, hi); \
                if (!mzero) { _Pragma("unroll") for (int r_ = 0; r_ < 16; ++r_) { P0[r_] -= m; P1[r_] -= m; } } } } while (0)
        ATT_QK(pa0, pa1, t0, 0);
        __builtin_amdgcn_sched_barrier(0);
        ATT_QK(pb0, pb1, t0 + 1, KT);
        __builtin_amdgcn_sched_barrier(0);
#define ATT_POST(P0, P1, T) do { const int key0_ = 64 * (T); \
            if (MODE == 0) { if (key0_ + 63 > tqmax - 31) { int d0_ = tq - key0_ - 4 * hi; asm volatile("" : "+v"(d0_)); \
                    _Pragma("unroll") for (int r_ = 0; r_ < 16; ++r_) { const int C_ = (r_ & 3) + 8 * (r_ >> 2); if (C_ > d0_) P0[r_] = NEGBIG; if (C_ + 32 > d0_) P1[r_] = NEGBIG; } } } \
            else { const bool general_ = (MODE == 1 || MODE == 4) ? ((T) > cfar) : (MODE == 2 ? ((T) >= qt - 2) : ((T) >= qt - 2 || (T) <= qt - 8)); \
                if (general_) { \
                    if (MODE == 3 && (T) <= qt - 8) {                            \
                        int d0_ = tq - key0_ - 4 * hi - 512; asm volatile("" : "+v"(d0_)); \
                        _Pragma("unroll") for (int r_ = 0; r_ < 16; ++r_) { const int C_ = (r_ & 3) + 8 * (r_ >> 2); if (C_ <= d0_) P0[r_] = NEGBIG; if (C_ + 32 <= d0_) P1[r_] = NEGBIG; } \
                    } else if (MODE == 2 || MODE == 3) { \
                          \
                        LAS const float* tb_ = (LAS const float*)(L + AL_TB2) + hh * TB2_LEN + (tq - key0_ - 4 * hi + TB2_NEG - 59); \
                        _Pragma("unroll") for (int r_ = 0; r_ < 16; ++r_) { P0[r_] += tb_[59 - ((r_ & 3) + 8 * (r_ >> 2))]; P1[r_] += tb_[59 - ((r_ & 3) + 8 * (r_ >> 2) + 32)]; if ((r_ & 1) == 1) __builtin_amdgcn_sched_barrier(0); } \
                    } else { \
                    int d0_ = tq - 31 - 16 * key0_ - 64 * hi; asm volatile("" : "+v"(d0_)); \
                    _Pragma("unroll") for (int r_ = 0; r_ < 16; ++r_) { _Pragma("unroll") for (int hb_ = 0; hb_ < 2; ++hb_) { \
                            const int dist_ = d0_ - 16 * ((r_ & 3) + 8 * (r_ >> 2) + 32 * hb_); \
                            const bool valid_ = dist_ >= 0; \
                            const float bias_ = TBL[min(max(dist_, 0), 127) * 4 + hh]; \
                            if (hb_) P1[r_] = valid_ ? P1[r_] + bias_ : NEGBIG; else P0[r_] = valid_ ? P0[r_] + bias_ : NEGBIG; } \
                        if ((r_ & 3) == 3) __builtin_amdgcn_sched_barrier(0); } } } } } while (0)
#define ATT_IMP(P0, P1, T) do { float S0_[4], S1_[4], s0_[4], s1_[4]; \
            if (MODE == 4) { _Pragma("unroll") for (int r_ = 0; r_ < 16; ++r_) { P0[r_] = __builtin_amdgcn_exp2f(P0[r_]) * inv; P1[r_] = __builtin_amdgcn_exp2f(P1[r_]) * inv; } } \
            _Pragma("unroll") for (int a_ = 0; a_ < 4; ++a_) { S0_[a_] = (P0[4 * a_] + P0[4 * a_ + 1]) + (P0[4 * a_ + 2] + P0[4 * a_ + 3]); S1_[a_] = (P1[4 * a_] + P1[4 * a_ + 1]) + (P1[4 * a_ + 2] + P1[4 * a_ + 3]); } \
            if (hi == 0) { _Pragma("unroll") for (int a_ = 0; a_ < 4; ++a_) { s0_[a_] = P0[4 * a_ + 3]; s1_[a_] = P1[4 * a_ + 3]; } } \
            else { s0_[0] = carry; s0_[1] = P0[3]; s0_[2] = P0[7]; s0_[3] = P0[11]; s1_[0] = P0[15]; s1_[1] = P1[3]; s1_[2] = P1[7]; s1_[3] = P1[11]; carry = P1[15]; } \
            LAS float* IW_ = (LAS float*)(L + AL_IMPW) + ((hh * 64) + (32 * th + r32)) * 64 + 16 * (T) + hi; \
            _Pragma("unroll") for (int a_ = 0; a_ < 4; ++a_) { IW_[2 * a_] = S0_[a_] + __shfl_xor(s0_[a_], 32); IW_[8 + 2 * a_] = S1_[a_] + __shfl_xor(s1_[a_], 32); } } while (0)
        {
            ATT_POST(pa0, pa1, t0);
            __builtin_amdgcn_sched_barrier(0);
            if (MODE != 4) { const bool on_ = (MODE == 2) ? (((selm >> t0) & 1ull) != 0ull) : true;
                softmax_core<true, LS>(pa0, pa1, pb0, pb1, m, l, o, negm, on_, lacc);
                if (MODE == 1) ATT_IMP(pa0, pa1, t0);
                __builtin_amdgcn_sched_barrier(0);
                if (MODE == 2) pv_tile<true, LS>(o, pa0, pa1, Vs, lane, hi, on_ ? 0xffffffffu : 0u, lacc); else pv_tile<false, LS>(o, pa0, pa1, Vs, lane, hi, 0xffffffffu, lacc); }
            else ATT_IMP(pa0, pa1, t0);
        }
        __builtin_amdgcn_sched_barrier(0);
        {
            ATT_POST(pb0, pb1, t0 + 1);
            if (MODE != 0 && t0 + 1 > jhi) {
#pragma unroll
                for (int r = 0; r < 16; ++r) { pb0[r] = NEGBIG; pb1[r] = NEGBIG; } }
            __builtin_amdgcn_sched_barrier(0);
            if (MODE != 4) { const bool on_ = (MODE == 2) ? (((selm >> (t0 + 1)) & 1ull) != 0ull) : true;
                softmax_core<false, LS>(pb0, pb1, pb0, pb1, m, l, o, negm, on_, lacc);
                if (MODE == 1 && t0 + 1 <= jhi) ATT_IMP(pb0, pb1, t0 + 1);
                __builtin_amdgcn_sched_barrier(0);
                if (MODE == 2) pv_tile<true, LS>(o, pb0, pb1, Vs + 8192, lane, hi, on_ ? 0xffffffffu : 0u, lacc); else pv_tile<false, LS>(o, pb0, pb1, Vs + 8192, lane, hi, 0xffffffffu, lacc); }
            else if (t0 + 1 <= jhi) ATT_IMP(pb0, pb1, t0 + 1);
        }
        buf ^= 1;
    }
    if (LS) l = 0.5f * lacc[0];
#undef ATT_GLOAD
#undef ATT_QK
#undef ATT_POST
#undef ATT_IMP
}

__device__ __forceinline__ void store_ot(bf16* dst  , const f32x16 (&o)[2], float scale, int hi) {
    asm volatile("" : "+v"(hi));
#pragma unroll
    for (int d0 = 0; d0 < 2; ++d0)
#pragma unroll
        for (int a = 0; a < 4; ++a) { v2u w; w.x = pk2(o[d0][4 * a] * scale, o[d0][4 * a + 1] * scale); w.y = pk2(o[d0][4 * a + 2] * scale, o[d0][4 * a + 3] * scale);
            *(v2u*)(dst + 32 * d0 + 8 * a + 4 * hi) = w; }
}

template <int DRY = 0>
__device__ __forceinline__ void fox_unit(const Args& A, const Ctx& X, int bh, int qb, int& buf, SideJob& sj) {
    const int lane = X.lane, wid = X.wave, r32 = lane & 31, hi = lane >> 5;
    const int tq = 256 * qb + 32 * wid + r32, tqmax = 256 * qb + 32 * wid + 31;
    const bf16* Q = (const bf16*)(X.ws + WS_FQ) + ((size_t)bh * SEQ + tq) * 64;
    bf16x8 qr[4];
#pragma unroll
    for (int d0 = 0; d0 < 4; ++d0) qr[d0] = *(const bf16x8*)(Q + d0 * 16 + hi * 8);
    float m = ((const float*)(X.ws + WS_KBIAS))[(size_t)bh * SEQ + tq], l = 0.f; f32x16 o[2]; o[0] = (f32x16){}; o[1] = (f32x16){};
    attn_branch<0, DRY>(X.lds, buf, (const bf16*)(X.ws + WS_FK) + (size_t)bh * SEQ * 64, (const bf16*)(X.ws + WS_FV) + (size_t)bh * SEQ * 64, (const bf16*)(X.ws + WS_KX) + (size_t)bh * SEQ * 8,
                   0, 4 * qb + 3, qr, tq, tqmax, 0, 0, 0ull, m, l, o, 0.f, 0, sj, A, X.ws, X.G * 8);
    const float lt = l + __shfl_xor(l, 32);
    const int b = bh >> 3, h = bh & 7;
    if (DRY == 0) store_ot((bf16*)((unsigned char*)X.out + OUT_OFOX) + ((size_t)b * SEQ + tq) * 512 + h * 64, o, 1.f / lt, hi);
    else asm volatile("" :: "v"(o[0]), "v"(o[1]), "v"(lt));
}

__device__ __forceinline__ void nsa_unit(const Args& A, const Ctx& X, int bg, int qt, int& buf, SideJob& sj, int& gprev) {
    const int tid = X.tid, lane = X.lane, wid = X.wave, r32 = lane & 31, hi = lane >> 5, hh = wid >> 1, th = wid & 1;
    const int b = bg >> 1, g = bg & 1, head = 4 * g + hh;
    const int tok = 32 * th + r32, tq = 64 * qt + tok, tqmax = 64 * qt + 32 * th + 31;
#ifdef PROBE_SUB
#define NSTAMP(k) do { if (blockIdx.x == 0 && X.tid == 0) { const unsigned t_ = (unsigned)__builtin_amdgcn_s_memrealtime(); ((volatile LAS unsigned*)(X.lds + MISC_OFF))[40 + (k)] += t_ - tprev_; tprev_ = t_; } } while (0)
    unsigned tprev_ = (unsigned)__builtin_amdgcn_s_memrealtime();
#else
#define NSTAMP(k) do { } while (0)
#endif
    LAS unsigned char* L = X.lds;
    __syncthreads();
    int tidv = tid; asm volatile("" : "+v"(tidv));
    if (g != gprev) {
    gprev = g;
    { const float* rel = A.in[15]; LAS float* TBL = (LAS float*)(L + AL_TBL); const int d = tidv >> 2, q = tidv & 3; TBL[tidv] = (rel[T5_BUCKET[d] * 8 + 4 * g + q] - rel[31 * 8 + 4 * g + q]) * LOG2E; }
    { const float* rel = A.in[15]; LAS float* TB2 = (LAS float*)(L + AL_TB2);
#pragma unroll 1
      for (int q = 0; q < 4; ++q) {
#pragma unroll 1
          for (int di = tidv; di < TB2_LEN; di += 512) { const int d = di - TB2_NEG, dc = d < 0 ? 0 : (d > 127 ? 127 : d);
              const float v = (rel[T5_BUCKET[dc] * 8 + 4 * g + q] - rel[31 * 8 + 4 * g + q]) * LOG2E;
              TB2[q * TB2_LEN + di] = (d < 0) ? NEGBIG : (d < 128 ? v : 0.f); } } }
    }
    { LAS v4u* z = (LAS v4u*)(L + AL_IMPW);
#pragma unroll
      for (int i = 0; i < 8; ++i) z[tidv + 512 * i] = (v4u){0u, 0u, 0u, 0u};
      if (tidv == 0) *(LAS int*)(L + ROWTAB_OFF + 1024) = 0; }
    const bf16* Q = (const bf16*)(X.ws + WS_NQ) + ((size_t)(b * 8 + head) * SEQ + tq) * 64;
    bf16x8 qr[4];
#pragma unroll
    for (int d0 = 0; d0 < 4; ++d0) qr[d0] = *(const bf16x8*)(Q + d0 * 16 + hi * 8);
    const float* gp = (const float*)(X.ws + WS_GATES) + ((size_t)b * SEQ + tq) * 24 + head * 3;
    const float g_cmp = gp[0], g_slc = gp[1], g_win = gp[2];
    __syncthreads();
    NSTAMP(0);
    const bf16* KV6 = (const bf16*)(X.ws + WS_KV6);
    const bf16* KC = (const bf16*)(X.ws + WS_KC) + (size_t)bg * 256 * 64; const bf16* VC = (const bf16*)(X.ws + WS_VC) + (size_t)bg * 256 * 64;
    const int nct = (4 * qt + 2) / 64;
    float m = 0.f, l = 0.f; f32x16 o[2]; o[0] = (f32x16){}; o[1] = (f32x16){};
#ifndef NSA_NO1
    attn_branch<1>(L, buf, KC, VC, nullptr, 0, nct, qr, tq, tqmax, hh, qt, 0ull, m, l, o, 0.f, th, sj, A, X.ws, 0);
#endif
    float lt = l + __shfl_xor(l, 32);
    const float inv_c = (tq >= 31 && lt > 0.f) ? 1.f / lt : 0.f;
    { const float sc = g_cmp * inv_c;
#pragma unroll
      for (int r = 0; r < 16; ++r) { o[0][r] *= sc; o[1][r] *= sc; } }
    LAS float* INVL = (LAS float*)(L + ROWTAB_OFF); LAS int* BUMP = (LAS int*)(L + ROWTAB_OFF + 1024);
    if (hi == 0) INVL[hh * 64 + tok] = inv_c;
    if (!__all(m == 0.f) && lane == 0) BUMP[0] = 1;
    __syncthreads();
#ifndef NSA_NO4
    if (BUMP[0] != 0) {
        { float m2 = m, l2 = 0.f; f32x16 od[2]; attn_branch<4>(L, buf, KC, VC, nullptr, 0, nct, qr, tq, tqmax, hh, qt, 0ull, m2, l2, od, inv_c, th, sj, A, X.ws, 0); }
        if (hi == 0) INVL[hh * 64 + tok] = 1.f;
        __syncthreads();
    }
#endif
    NSTAMP(1);
    {
        LAS const float* IW = (LAS const float*)(L + AL_IMPW); LAS unsigned long long* SELM = (LAS unsigned long long*)(L + AL_SELM);
        if (qt < 16) {
            if (lane < 8) SELM[8 * wid + lane] = (2ull << qt) - 1ull;
        } else {
        for (int ii = 0; ii < 8; ++ii) {
            const int tk = 8 * wid + ii, j = lane;
            const float imp = ((IW[(0 * 64 + tk) * 64 + j] * INVL[tk] + IW[(1 * 64 + tk) * 64 + j] * INVL[64 + tk]) + IW[(2 * 64 + tk) * 64 + j] * INVL[128 + tk]) + IW[(3 * 64 + tk) * 64 + j] * INVL[192 + tk];
            const bool forced = (j == 0) || (j == qt) || (j == qt - 1), svalid = (j <= qt);
            const float score = forced ? 1e9f : (svalid ? imp : -1e9f);
            const unsigned bits = __builtin_bit_cast(unsigned, score), u = (bits & 0x80000000u) ? ~bits : (bits | 0x80000000u);
            unsigned T = 0u;
#pragma unroll 8
            for (int bsel = 31; bsel >= 0; --bsel) { const unsigned Tc = T | (1u << bsel); if (__builtin_popcountll(__ballot(u >= Tc)) >= 16) T = Tc; }
            const unsigned long long gt = __ballot(u > T), eq = __ballot(u == T);
            const int need = 16 - __builtin_popcountll(gt);
            const int below = __builtin_amdgcn_mbcnt_hi((unsigned)(eq >> 32), __builtin_amdgcn_mbcnt_lo((unsigned)eq, 0u));
            const unsigned long long msk = gt | __ballot(u == T && below < need);
            if (lane == 0) SELM[tk] = msk;
        }
        }
    }
    __syncthreads();
    NSTAMP(2);
    const unsigned long long selm = ((LAS const unsigned long long*)(L + AL_SELM))[tok];
    int tidw = tid; asm volatile("" : "+v"(tidw));
    LAS float* ACC = (LAS float*)(L + AL_IMPW) + tidw;
#pragma unroll
    for (int r = 0; r < 16; ++r) { ACC[r * 512] = o[0][r]; ACC[(16 + r) * 512] = o[1][r]; }
    m = 0.f; l = 0.f; o[0] = (f32x16){}; o[1] = (f32x16){};
#ifndef NSA_NO2
    attn_branch<2>(L, buf, KV6 + 2 * KV6_STRIDE + (size_t)bg * SEQ * 64, KV6 + 3 * KV6_STRIDE + (size_t)bg * SEQ * 64, nullptr, 0, qt, qr, tq, tqmax, hh, qt, selm, m, l, o, 0.f, th, sj, A, X.ws, 0);
#endif
    lt = l + __shfl_xor(l, 32);
    { const float sc = g_slc / lt;
#pragma unroll
      for (int r = 0; r < 16; ++r) { ACC[r * 512] += o[0][r] * sc; ACC[(16 + r) * 512] += o[1][r] * sc; } }
    NSTAMP(3);
    m = 0.f; l = 0.f; o[0] = (f32x16){}; o[1] = (f32x16){};
#ifndef NSA_NO3
    attn_branch<3>(L, buf, KV6 + 4 * KV6_STRIDE + (size_t)bg * SEQ * 64, KV6 + 5 * KV6_STRIDE + (size_t)bg * SEQ * 64, nullptr, qt > 8 ? qt - 8 : 0, qt, qr, tq, tqmax, hh, qt, 0ull, m, l, o, 0.f, th, sj, A, X.ws, 0);
#endif
    lt = l + __shfl_xor(l, 32);
    { const float sc = g_win / lt;
#pragma unroll
      for (int r = 0; r < 16; ++r) { o[0][r] = ACC[r * 512] + o[0][r] * sc; o[1][r] = ACC[(16 + r) * 512] + o[1][r] * sc; } }
    NSTAMP(4);
    store_ot((bf16*)((unsigned char*)X.out + OUT_ONSA) + ((size_t)b * SEQ + tq) * 512 + head * 64, o, 1.f, hi);
}

__device__ __forceinline__ void phase3(const Args& A, const Ctx& X) {
    int buf = 0;
    if (X.tid < 64) ((LAS v4u*)(X.lds + AL_ZERO))[X.tid] = (v4u){0u, 0u, 0u, 0u};
    __syncthreads();
    SideJob sj; sj.q = X.vcu * 8 + X.wave; sj.loaded = 0; sj.half = 0; sj.pend = 0;
#ifdef PROBE_SUB
    unsigned tp3_ = (unsigned)__builtin_amdgcn_s_memrealtime();
#define P3STAMP(k) do { if (blockIdx.x == 0 && X.tid == 0) { const unsigned t_ = (unsigned)__builtin_amdgcn_s_memrealtime(); ((volatile LAS unsigned*)(X.lds + MISC_OFF))[40 + (k)] += t_ - tp3_; tp3_ = t_; } } while (0)
#else
#define P3STAMP(k) do { } while (0)
#endif
#ifndef NO_FOX
#ifdef FOX_DRY
    for (int u = X.vcu; u < 1024; u += X.G) { const int rd = u >> 8, v = u & 255, bh = v >> 2, s = v & 3; const int qb = (rd == 0) ? s : (rd == 1) ? 7 - s : (rd == 2) ? 8 + s : 15 - s;
        fox_unit<FOX_DRY>(A, X, bh, qb, buf, sj); }
    __syncthreads();
#endif
    REP(16) for (int u = X.vcu; u < 1024; u += X.G) { const int rd = u >> 8, v = u & 255, bh = v >> 2, s = v & 3; const int qb = (rd == 0) ? s : (rd == 1) ? 7 - s : (rd == 2) ? 8 + s : 15 - s;
        fox_unit(A, X, bh, qb, buf, sj); }
#endif
    P3STAMP(5);
    {
        const int lane = X.lane, NGW = X.G * 8; LAS bf16* TT = (LAS bf16*)(X.lds + AL_TT + X.wave * 8192);
        while (sj.loaded || sj.q < CVQ_TOTAL) { SJ_STEP(sj, A, X.ws, NGW); }
    }
    P3STAMP(6);
#ifndef NO_NSA
    int gprev = -1;
    {
        LAS int* QW = (LAS int*)(X.lds + ROWTAB_OFF + 1028); unsigned* qctr = (unsigned*)(X.ws + WS_CTL) + CW_NSAQ;
        for (;;) {
            __syncthreads();
            if (X.tid == 0) QW[0] = (int)__hip_atomic_fetch_add(qctr, 1u, __ATOMIC_RELAXED, __HIP_MEMORY_SCOPE_AGENT);
            __syncthreads();
            const int q = QW[0];
            if (q >= 1024) break;
            nsa_unit(A, X, q & 15, 63 - (q >> 4), buf, sj, gprev);
        }
    }
#endif
}

#ifndef MK_N_LAUNCHES
#define MK_N_LAUNCHES 1
#endif
constexpr int N_PHASES = 11;
static_assert(AL_IMPW + 65536 <= MISC_OFF && AL_TT + 8 * 8192 <= MISC_OFF && AL_TB2 + 4 * TB2_LEN * 4 <= AL_IMPW && RING_BYTES <= MISC_OFF && ROWTAB_OFF + 18 * 1024 <= LDS_BYTES && TAB_OFF + 100 * 4 <= ROWTAB_OFF, "LDS map");

__global__ void __launch_bounds__(512, 2) fwd(Args args) {
    extern __shared__ __attribute__((aligned(16))) unsigned char lds_raw[];
    Ctx X;
    X.out = args.out; X.ws = args.ws;
    X.lds = (LAS unsigned char*)lds_raw;
    X.tid = threadIdx.x; X.lane = X.tid & 63; X.wave = __builtin_amdgcn_readfirstlane(X.tid >> 6);
    X.G = gridDim.x; { const int bx = blockIdx.x; X.vcu = (X.G % 8 == 0) ? (bx % 8) * (X.G / 8) + bx / 8 : bx; }
    volatile LAS unsigned* MISC = (volatile LAS unsigned*)(X.lds + MISC_OFF);
    if (X.tid < 64) MISC[X.tid] = 0u;
    __syncthreads();
    const int lo = args.ph_lo, hi = args.ph_hi;
    unsigned* ctl = (unsigned*)(X.ws + WS_CTL);
    XcdBarrier bar; bar.bar = ctl + CW_BAR; bar.x = 0; bar.st = MISC + 8;
    if (hi - lo > 1) bar = xcd_barrier_post(ctl + CW_BAR, MISC + 8);
#ifndef PHMASK
#define PHMASK 0x7ff
#endif
#define IN(k) ((((PHMASK) >> (k)) & 1) && lo <= (k) && (k) < hi)
#ifndef PROBE_PHASE
#define PROBE_PHASE -1
#endif
#define STAMP(i) do { if (PROBE_PHASE >= 0 && blockIdx.x == 0 && X.tid == 0) { const unsigned long long t_ = __builtin_amdgcn_s_memrealtime(); MISC[16 + 2 * (i)] = (unsigned)t_; MISC[17 + 2 * (i)] = (unsigned)(t_ >> 32); } } while (0)
#define SEAM(k) do { if (IN(k) && IN((k) + 1)) xcd_barrier(bar); STAMP((k) + 1); } while (0)
    unsigned char* ws = X.ws;
    const int bid = (int)blockIdx.x;

    STAMP(0);
    if (IN(0)) { REP(0) phase0a(args, X); SEAM(0); }
    if (IN(1)) { REP(1) phase0b(args, X); SEAM(1); }
    if (IN(2)) {
        pg8::Gemm g{(const bf16*)((unsigned char*)X.out + OUT_H), (const bf16*)(ws + WS_WIN), 1024};
        pg8::StaticOrder S; S.init(NTOK, NPROJ, X.G, bid, 1024);
        EpiInProj E{ws, args.in[7]};
        pg8::gemm_phase<EpiInProj, pg8::StaticOrder>(X.lds, g, S, E);
        if constexpr (((DUP_MASK) >> 2) & 1) pg8::gemm_phase<EpiInProj, pg8::StaticOrder>(X.lds, g, S, E);
        SEAM(2);
    }
    if (IN(3)) { REP(3) phase2(args, X); SEAM(3); }
#ifdef PROBE_BLK
    unsigned tb4_ = (unsigned)__builtin_amdgcn_s_memrealtime();
#endif
    if (IN(4)) { REP(4) phase3(args, X);
#ifdef PROBE_BLK
        if (blockIdx.x == PROBE_BLK && X.tid == 0) { ((volatile unsigned*)(X.ws + WS_CTL))[8] = (unsigned)__builtin_amdgcn_s_memrealtime() - tb4_; }
#endif
        SEAM(4); }
    if (IN(5)) {
        pg8::StaticOrder S; S.init(NTOK, 1024, X.G, bid, 512);
        {
        { pg8::Gemm g{(const bf16*)((unsigned char*)X.out + OUT_OFOX), (const bf16*)(ws + WS_WFOX), 512};
          EpiGate<false> E{(bf16*)(ws + WS_GATED), (const bf16*)(ws + WS_SGF)};
          pg8::gemm_phase<EpiGate<false>, pg8::StaticOrder>(X.lds, g, S, E); }
        { pg8::Gemm g{(const bf16*)((unsigned char*)X.out + OUT_ONSA), (const bf16*)(ws + WS_WNSA), 512};
          EpiGate<true> E{(bf16*)(ws + WS_GATED), (const bf16*)(ws + WS_SGN)};
          pg8::gemm_phase<EpiGate<true>, pg8::StaticOrder>(X.lds, g, S, E); }
        }
        SEAM(5);
    }
    if (IN(6)) {
        pg8::Gemm g{(const bf16*)(ws + WS_GATED), (const bf16*)(ws + WS_WMIX), 1024};
        pg8::StaticOrder S; S.init(NTOK, 1024, X.G, bid, 1024);
        EpiPlain E{(bf16*)(ws + WS_MIXED), 1024};
        pg8::gemm_phase<EpiPlain, pg8::StaticOrder>(X.lds, g, S, E);
        if constexpr (((DUP_MASK) >> 6) & 1) pg8::gemm_phase<EpiPlain, pg8::StaticOrder>(X.lds, g, S, E);
        SEAM(6);
    }
#ifdef PROBE_BLK7
    unsigned tb7_ = (unsigned)__builtin_amdgcn_s_memrealtime();
#endif
    if (IN(7)) { phase6(args, X);
#ifdef PROBE_BLK7
        if (blockIdx.x == PROBE_BLK7 && X.tid == 0) { ((volatile unsigned*)(X.ws + WS_CTL))[8] = (unsigned)__builtin_amdgcn_s_memrealtime() - tb7_; }
#endif
        SEAM(7); }
    if (IN(8)) {
        moe_tables(args, X);
        LAS const int* tab = (LAS const int*)(X.lds + TAB_OFF);
        MoeOrder S{X.G, bid, 8, 0, tab, (LAS const int*)(X.lds + ROWTAB_OFF)};
        moe_rowtab(X, S, (const int*)(ws + WS_TOKOF));
        pg8::Gemm g{(const bf16*)((unsigned char*)X.out + OUT_H2), (const bf16*)(ws + WS_WGU), 1024};
        EpiGateUp E{(bf16*)(ws + WS_ACT), args.in[21], args.in[23], tab, (bf16*)(ws + WS_DUMMY)};
        REP(8) pg8::gemm_phase<EpiGateUp, MoeOrder>(X.lds, g, S, E);
        SEAM(8);
    }
    if (IN(9)) {
        moe_tables(args, X);
        LAS const int* tab = (LAS const int*)(X.lds + TAB_OFF);
        MoeOrder S{X.G, bid, 4, 1, tab, (LAS const int*)(X.lds + ROWTAB_OFF)};
        moe_rowtab(X, S, (const int*)(ws + WS_TOKOF));
        pg8::Gemm g{(const bf16*)(ws + WS_ACT), (const bf16*)(ws + WS_WD), 1024};
        EpiDown E{(unsigned char*)X.out, ws + WS_YSHI, args.in[25], tab, (LAS const int*)(X.lds + ROWTAB_OFF), ws + WS_DUMMY};
        REP(9) pg8::gemm_phase<EpiDown, MoeOrder>(X.lds, g, S, E);
        SEAM(9);
    }
    if (IN(10)) { phase10(args, X); }
    if (PROBE_PHASE >= 0 && blockIdx.x == 0 && X.tid == 0) {
        const unsigned long long te = __builtin_amdgcn_s_memrealtime();
        unsigned long long t0, t1;
        if (PROBE_PHASE == 10) { t0 = ((unsigned long long)MISC[17 + 20] << 32) | MISC[16 + 20]; t1 = te; }
        else { t0 = ((unsigned long long)MISC[17 + 2 * PROBE_PHASE] << 32) | MISC[16 + 2 * PROBE_PHASE]; t1 = ((unsigned long long)MISC[19 + 2 * PROBE_PHASE] << 32) | MISC[18 + 2 * PROBE_PHASE]; }
#if defined(PROBE_BLK) || defined(PROBE_BLK7)
        const unsigned long long target = 8ull * (unsigned long long)__hip_atomic_load((unsigned*)(X.ws + WS_CTL) + 8, __ATOMIC_RELAXED, __HIP_MEMORY_SCOPE_AGENT);
#elif defined(PROBE_SUB)
        const unsigned long long target = 8ull * (unsigned long long)MISC[(PROBE_SUB >= 10 ? 40 : 40) + PROBE_SUB];
#else
        const unsigned long long target = 8ull * (t1 - t0);
#endif
        while (__builtin_amdgcn_s_memrealtime() - te < target) __builtin_amdgcn_s_sleep(8);
    }
#undef IN
#undef SEAM
}

extern "C" void kernel_launch(void* const* d_in, const int* in_sizes, int n_in, void* d_out, int out_size, void* d_ws, size_t ws_size, hipStream_t stream) {
    static int grid = 0;
    if (grid == 0) {
        if (n_in != 26 || in_sizes[0] != NTOK * DM || out_size != NTOK * DM || ws_size < WS_END) {
            fprintf(stderr, "kernel_launch: unexpected shapes / workspace (n_in %d, ws %zu, need %zu); nothing launched\n", n_in, ws_size, (size_t)WS_END); grid = -1; return; }
        int dev = 0, cus = 0, per_cu = 0;
        if (hipGetDevice(&dev) != hipSuccess || hipDeviceGetAttribute(&cus, hipDeviceAttributeMultiprocessorCount, dev) != hipSuccess) { grid = -1; return; }
        if (hipFuncSetAttribute((const void*)fwd, hipFuncAttributeMaxDynamicSharedMemorySize, LDS_BYTES) != hipSuccess) { fprintf(stderr, "kernel_launch: hipFuncSetAttribute failed\n"); grid = -1; return; }
        if (hipOccupancyMaxActiveBlocksPerMultiprocessor(&per_cu, (const void*)fwd, 512, LDS_BYTES) != hipSuccess || per_cu < 1) { fprintf(stderr, "kernel_launch: occupancy query says %d\n", per_cu); }
        (void)hipGetLastError();
        grid = cus;
    }
    if (grid < 0) return;
    if (hipMemsetAsync((char*)d_ws + WS_CTL, 0, CTL_ZERO_BYTES, stream) != hipSuccess) return;
    Args a{};
    for (int i = 0; i < 26; ++i) a.in[i] = (const float*)d_in[i];
    a.out = (float*)d_out; a.ws = (unsigned char*)d_ws;
#if MK_N_LAUNCHES == 1
    a.ph_lo = 0; a.ph_hi = N_PHASES;
    hipLaunchKernelGGL(fwd, dim3(grid), dim3(512), LDS_BYTES, stream, a);
#else
    for (int p = 0; p < N_PHASES; ++p) { a.ph_lo = p; a.ph_hi = p + 1; hipLaunchKernelGGL(fwd, dim3(grid), dim3(512), LDS_BYTES, stream, a); }
#endif
}
```

```cpp
#include <hip/hip_runtime.h>
#include <cstdio>
#include <cstdint>

#define GAS __attribute__((address_space(1)))
#define LAS __attribute__((address_space(3)))
typedef unsigned short bf16;
typedef unsigned v4u __attribute__((ext_vector_type(4)));
typedef unsigned v2u __attribute__((ext_vector_type(2)));
typedef float f32x2 __attribute__((ext_vector_type(2)));
typedef float f32x4 __attribute__((ext_vector_type(4)));
typedef float f32x16 __attribute__((ext_vector_type(16)));
typedef short bf16x8 __attribute__((ext_vector_type(8)));
typedef short s16x4 __attribute__((ext_vector_type(4)));
typedef __bf16 bf16x2_t __attribute__((ext_vector_type(2)));

constexpr int NB = 8, SEQ = 4096, DM = 1024, NTOK = NB * SEQ;
constexpr int NPROJ = 5120;
constexpr int NEXP = 32, TOPK = 4;
constexpr float LOG2E = 1.4426950408889634f;
constexpr float QSCALE = 0.125f * 1.4426950408889634f;
constexpr float RMS_EPS = 1e-6f;
constexpr float NEGBIG = -1e30f;

__device__ __forceinline__ unsigned pk2(float lo, float hi) { f32x2 v = {lo, hi}; bf16x2_t b = __builtin_convertvector(v, bf16x2_t); return __builtin_bit_cast(unsigned, b); }
__device__ __forceinline__ float bf_lo(unsigned u) { return __builtin_bit_cast(float, u << 16); }
__device__ __forceinline__ float bf_hi(unsigned u) { return __builtin_bit_cast(float, u & 0xffff0000u); }
__device__ __forceinline__ float wave_sum(float v) {
    int t;
    t = __builtin_amdgcn_update_dpp(0, __builtin_bit_cast(int, v), 0xB1, 0xF, 0xF, false); v += __builtin_bit_cast(float, t);
    t = __builtin_amdgcn_update_dpp(0, __builtin_bit_cast(int, v), 0x4E, 0xF, 0xF, false); v += __builtin_bit_cast(float, t);
    t = __builtin_amdgcn_update_dpp(0, __builtin_bit_cast(int, v), 0x141, 0xF, 0xF, false); v += __builtin_bit_cast(float, t);
    t = __builtin_amdgcn_update_dpp(0, __builtin_bit_cast(int, v), 0x140, 0xF, 0xF, false); v += __builtin_bit_cast(float, t);
    const int vi = __builtin_bit_cast(int, v);
    const float r0 = __builtin_bit_cast(float, __builtin_amdgcn_readlane(vi, 0)), r1 = __builtin_bit_cast(float, __builtin_amdgcn_readlane(vi, 16)),
                r2 = __builtin_bit_cast(float, __builtin_amdgcn_readlane(vi, 32)), r3 = __builtin_bit_cast(float, __builtin_amdgcn_readlane(vi, 48));
    return (r0 + r1) + (r2 + r3);
}
__device__ __forceinline__ float sigmoidf_(float x) { return __builtin_amdgcn_rcpf(1.f + __builtin_amdgcn_exp2f(-1.4426950408889634f * x)); }
#define LDS_WAIT() asm volatile("s_waitcnt lgkmcnt(0)" ::: "memory")
#define VM_WAIT() asm volatile("s_waitcnt vmcnt(0)" ::: "memory")

namespace pg8 {
#define PG8_LAS __attribute__((address_space(3)))
typedef unsigned short bf16_t;
typedef unsigned u32x4 __attribute__((ext_vector_type(4)));
constexpr int BM = 256, BK = 64, HALF = 128, HTB = HALF * BK * 2  , STAGE_BYTES = 8 * HTB, NXCD = 8, WGM = 8;

__host__ __device__ __forceinline__ int lds_byte(int r, int c) { const int st = (r >> 4) * 2 + (c >> 5), rr = r & 15, cc = c & 31, ob = rr * 64 + cc * 2; return st * 1024 + (ob ^ (((ob >> 9) & 1) << 5)); }
__host__ __device__ __forceinline__ void stage_rc(int b, int& R, int& C) { const int st = b / 1024, sb = b % 1024, swz = sb ^ (((sb >> 9) & 1) << 5); R = (st >> 1) * 16 + swz / 64; C = (st & 1) * 32 + (swz % 64) / 2; }
__host__ __device__ __forceinline__ int perm32(int rho) { const int n = rho >> 4, i = rho & 15; return 8 * (i >> 2) + 4 * n + (i & 3); }

struct Unit { int pm, pn, e, rt, ord; };
struct Gemm { const bf16_t* A; const bf16_t* Bt; int K; };

struct StaticOrder {
    int nM, nN, nwg, G, c, lda2;
    __device__ void init(int M, int N, int G_, int c_, int lda_elems) { nM = M / BM; nN = N / BM; nwg = nM * nN; G = G_; c = c_; lda2 = lda_elems * 2; }
    __device__ bool next(int i, Unit& u) const {
        const long L = (long)i * G + c; if (L >= nwg) return false;
        int wgid = (int)L; { const int q = nwg / NXCD, r = nwg % NXCD, xcd = wgid % NXCD, off = wgid / NXCD; wgid = (xcd < r ? xcd * (q + 1) : r * (q + 1) + (xcd - r) * q) + off; }
        const int nig = WGM * nN, gid = wgid / nig, fm = gid * WGM, gsz = (nM - fm) < WGM ? (nM - fm) : WGM;
        u.pm = fm + ((wgid % nig) % gsz); u.pn = (wgid % nig) / gsz; u.e = 0; u.rt = 0; u.ord = i; return true;
    }
    __device__ __forceinline__ unsigned a_off(const Unit& u, int r) const { return (unsigned)(u.pm * BM + r) * (unsigned)lda2; }
};

template <class Epi, class Sched, bool ALIGN_EPI = true, bool FP8 = false>
__device__ __forceinline__ void gemm_phase(PG8_LAS unsigned char* lds, const Gemm g, const Sched& S, const Epi& E) {
    const int tid = threadIdx.x, wid = __builtin_amdgcn_readfirstlane(tid >> 6), lane = tid & 63, wr = wid >> 2, wc = wid & 3, fr = lane & 15, fq = lane >> 4;
    const int K = g.K, nt = K / BK;
    int RA[2], CA2[2]; unsigned voffB[2];
#pragma unroll
    for (int i = 0; i < 2; ++i) { int R, C; stage_rc(tid * 16 + i * 8192, R, C); const int Rb = (R & ~31) + perm32(R & 31);
        RA[i] = R; CA2[i] = C * 2; voffB[i] = (unsigned)(Rb * K + C) * 2u; }
    const size_t kstep = (size_t)(BK * 2);
    const size_t hstep = (size_t)HALF * K * 2;
    const size_t tstep = 2 * hstep;
    const unsigned ldsw = (unsigned)wid * 1024u;
    const int aoff = lds_byte(wr * 64 + fr, fq * 8), boff = lds_byte(wc * 32 + fr, fq * 8);
#define PG8_SA(b, h) (((b) * 2 + (h)) * HTB)
#define PG8_SB(b, h) ((4 + (b) * 2 + (h)) * HTB)
#define PG8_STAGE(bufoff, gbase, voff) do { _Pragma("unroll") for (int _i = 0; _i < 2; ++_i) \
        __builtin_amdgcn_global_load_lds((const unsigned*)((const char*)(gbase) + (voff)[_i]), (PG8_LAS unsigned*)(lds + (bufoff) + ldsw + _i * 8192), 16, 0, 0); } while (0)
#define PG8_LDA(dst, b, h) do { _Pragma("unroll") for (int m = 0; m < 4; ++m) _Pragma("unroll") for (int k = 0; k < 2; ++k) dst[m][k] = *(const PG8_LAS bf16x8*)(lds + PG8_SA(b, h) + aoff + m * 2048 + k * 1024); } while (0)
#define PG8_LDB(dst, b, h) do { _Pragma("unroll") for (int n = 0; n < 2; ++n) _Pragma("unroll") for (int k = 0; k < 2; ++k) dst[n][k] = *(const PG8_LAS bf16x8*)(lds + PG8_SB(b, h) + boff + n * 2048 + k * 1024); } while (0)
#define PG8_MMA(ai, bj, At, Bt) do { __builtin_amdgcn_s_setprio(1); _Pragma("unroll") for (int m = 0; m < 4; ++m) _Pragma("unroll") for (int n = 0; n < 2; ++n) { \
        if constexpr (FP8) { typedef int v8i_ __attribute__((ext_vector_type(8))); typedef int v4i_ __attribute__((ext_vector_type(4))); \
            const v8i_ bb_ = __builtin_shufflevector(__builtin_bit_cast(v4i_, Bt[n][0]), __builtin_bit_cast(v4i_, Bt[n][1]), 0, 1, 2, 3, 4, 5, 6, 7), \
                       aa_ = __builtin_shufflevector(__builtin_bit_cast(v4i_, At[m][0]), __builtin_bit_cast(v4i_, At[m][1]), 0, 1, 2, 3, 4, 5, 6, 7); \
            asm volatile("v_mfma_scale_f32_16x16x128_f8f6f4 %0, %1, %2, %0, %3, %3 op_sel_hi:[0,0,0]" : "+v"(acc[ai][bj][m][n]) : "v"(bb_), "v"(aa_), "v"(f8scale)); } \
        else { _Pragma("unroll") for (int k = 0; k < 2; ++k) acc[ai][bj][m][n] = __builtin_amdgcn_mfma_f32_16x16x32_bf16(Bt[n][k], At[m][k], acc[ai][bj][m][n], 0, 0, 0); } } \
        __builtin_amdgcn_s_setprio(0); } while (0)
#define PG8_WAIT_V(n) asm volatile("s_waitcnt vmcnt(" #n ")" ::: "memory")
#define PG8_WAIT_L(n) asm volatile("s_waitcnt lgkmcnt(" #n ")" ::: "memory")
#define PG8_BAR __builtin_amdgcn_s_barrier()
#define PG8_SCHED __builtin_amdgcn_sched_barrier(0)
    const int f8scale = 0x7f7f7f7f;
    Unit cur, nxt; int ui = 0;
    if (!S.next(0, cur)) return;
    f32x4 acc[2][2][4][2];
#pragma unroll
    for (int a = 0; a < 2; ++a)
#pragma unroll
        for (int b = 0; b < 2; ++b)
#pragma unroll
            for (int m = 0; m < 4; ++m)
#pragma unroll
                for (int n = 0; n < 2; ++n) acc[a][b][m][n] = (f32x4){0.f, 0.f, 0.f, 0.f};
    bf16x8 At[4][2], B0[2][2], B1[2][2];
    const char* gA = (const char*)g.A;
    unsigned oc0[2], oc1[2], on0[2], on1[2];
#pragma unroll
    for (int i = 0; i < 2; ++i) { oc0[i] = S.a_off(cur, RA[i]) + CA2[i]; oc1[i] = S.a_off(cur, HALF + RA[i]) + CA2[i]; }
    const char* cB = (const char*)g.Bt + (size_t)cur.pn * tstep;
    PG8_STAGE(PG8_SB(0, 0), cB, voffB); PG8_STAGE(PG8_SB(0, 1), cB + hstep, voffB); PG8_STAGE(PG8_SA(0, 0), gA, oc0); PG8_STAGE(PG8_SA(0, 1), gA, oc1);
    if (wr == 1) PG8_BAR;
    PG8_WAIT_V(2); PG8_BAR;
    PG8_STAGE(PG8_SB(1, 0), cB + kstep, voffB); PG8_STAGE(PG8_SA(1, 0), gA + kstep, oc0); PG8_STAGE(PG8_SB(1, 1), cB + hstep + kstep, voffB);
    PG8_WAIT_V(6); PG8_BAR;
    for (;;) {
        const bool has_next = S.next(ui + 1, nxt);
        if (has_next) {
#pragma unroll
            for (int i = 0; i < 2; ++i) { on0[i] = S.a_off(nxt, RA[i]) + CA2[i]; on1[i] = S.a_off(nxt, HALF + RA[i]) + CA2[i]; }
        } else {
#pragma unroll
            for (int i = 0; i < 2; ++i) { on0[i] = oc0[i]; on1[i] = oc1[i]; }
        }
        const char* nB = has_next ? (const char*)g.Bt + (size_t)nxt.pn * tstep : cB;
#pragma unroll 1
        for (int t = 0; t < nt; t += 2) {
            const bool last = (t == nt - 2);
            const char* a1 = gA + (size_t)(t + 1) * kstep;
            const char* a2 = last ? gA : gA + (size_t)(t + 2) * kstep; const char* b2 = last ? nB : cB + (size_t)(t + 2) * kstep;
            const char* a3 = a2 + kstep; const char* b3 = b2 + kstep;
            unsigned s0[2], s1[2];
#pragma unroll
            for (int i = 0; i < 2; ++i) { s0[i] = last ? on0[i] : oc0[i]; s1[i] = last ? on1[i] : oc1[i]; }
            PG8_LDB(B0, 0, 0); PG8_LDB(B1, 0, 1); PG8_SCHED; PG8_LDA(At, 0, 0); PG8_STAGE(PG8_SA(1, 1), a1, oc1);
            PG8_WAIT_V(8); PG8_WAIT_L(0); PG8_BAR; PG8_MMA(0, 0, At, B0); PG8_MMA(0, 1, At, B1); PG8_BAR; PG8_SCHED;
            PG8_LDA(At, 0, 1); PG8_STAGE(PG8_SB(0, 0), b2, voffB); PG8_STAGE(PG8_SB(0, 1), b2 + hstep, voffB); PG8_STAGE(PG8_SA(0, 0), a2, s0);
            PG8_WAIT_V(8); PG8_WAIT_L(0); PG8_BAR; PG8_MMA(1, 0, At, B0); PG8_MMA(1, 1, At, B1); PG8_BAR; PG8_SCHED;
            PG8_LDB(B0, 1, 0); PG8_LDB(B1, 1, 1); PG8_SCHED; PG8_LDA(At, 1, 0); PG8_STAGE(PG8_SA(0, 1), a2, s1);
            PG8_WAIT_V(8); PG8_WAIT_L(0); PG8_BAR; PG8_MMA(0, 0, At, B0); PG8_MMA(0, 1, At, B1); PG8_BAR; PG8_SCHED;
            PG8_LDA(At, 1, 1); PG8_STAGE(PG8_SB(1, 0), b3, voffB); PG8_STAGE(PG8_SB(1, 1), b3 + hstep, voffB); PG8_STAGE(PG8_SA(1, 0), a3, s0);
            PG8_WAIT_V(8); PG8_WAIT_L(0); PG8_BAR; PG8_MMA(1, 0, At, B0); PG8_MMA(1, 1, At, B1); PG8_BAR; PG8_SCHED;
        }
        if constexpr (ALIGN_EPI) { if (wr == 0) PG8_BAR; }
        E(acc, cur, wr, wc, fr, fq);
        if (!has_next) break;
#pragma unroll
        for (int a = 0; a < 2; ++a)
#pragma unroll
            for (int b = 0; b < 2; ++b)
#pragma unroll
                for (int m = 0; m < 4; ++m)
#pragma unroll
                    for (int n = 0; n < 2; ++n) acc[a][b][m][n] = (f32x4){0.f, 0.f, 0.f, 0.f};
        cur = nxt; cB = nB; ++ui;
#pragma unroll
        for (int i = 0; i < 2; ++i) { oc0[i] = on0[i]; oc1[i] = on1[i]; }
        if constexpr (ALIGN_EPI) { if (wr == 1) PG8_BAR; }
    }
    PG8_WAIT_V(0);
    if constexpr (!ALIGN_EPI) { if (wr == 0) PG8_BAR; }
    PG8_BAR;
#undef PG8_SA
#undef PG8_SB
#undef PG8_STAGE
#undef PG8_LDA
#undef PG8_LDB
#undef PG8_MMA
#undef PG8_WAIT_V
#undef PG8_WAIT_L
#undef PG8_BAR
#undef PG8_SCHED
}
}

#define XB_TMO      128
#define XB_XCNT(j)  (256  + 64 * (j))
#define XB_XSUB(j)  (1280 + 64 * (j))
#define XB_XGEN(j)  (2304 + 64 * (j))
#define XB_TOP      3328
#define XB_TOPGEN   3392
#define XCD_BAR_WORDS 3456
#define XB_SPIN_CAP (1u << 18)

__device__ __forceinline__ unsigned xb_ld(unsigned* p)              { return __hip_atomic_load(p, __ATOMIC_RELAXED, __HIP_MEMORY_SCOPE_AGENT); }
__device__ __forceinline__ unsigned xb_add(unsigned* p, unsigned v) { return __hip_atomic_fetch_add(p, v, __ATOMIC_RELAXED, __HIP_MEMORY_SCOPE_AGENT); }
__device__ __forceinline__ unsigned xb_xcc_id() { return (unsigned)__builtin_amdgcn_s_getreg((3 << 11) | 20) & 0xFu; }
#define XB_SPIN(cond, bar) do { unsigned _sp = 0; while (cond) { __builtin_amdgcn_s_sleep(1); \
    if ((++_sp & 255u) == 0u) { if (xb_ld(&(bar)[XB_TMO])) break; if (_sp > XB_SPIN_CAP) { atomicAdd(&(bar)[XB_TMO], 1u); break; } } } } while (0)

struct XcdBarrier {
    unsigned* bar; unsigned x;
    volatile LAS unsigned* st;
};

__device__ __forceinline__ XcdBarrier xcd_barrier_post(unsigned* bar, volatile LAS unsigned* st) {
    XcdBarrier b; b.bar = bar; b.x = xb_xcc_id(); b.st = st;
    if (threadIdx.x == 0) (void)xb_add(&bar[XB_XCNT(b.x)], 1u);
    return b;
}
__device__ __forceinline__ void xcd_barrier_complete(unsigned* bar, unsigned x, unsigned& nloc, unsigned& nx) {
    const unsigned G = gridDim.x * gridDim.y * gridDim.z;
    unsigned sum, cnt, mine, sp = 0u;
    for (;;) {
        sum = 0u; cnt = 0u; mine = 0u;
#pragma unroll
        for (unsigned j = 0; j < 16; ++j) { const unsigned c = xb_ld(&bar[XB_XCNT(j)]); sum += c; cnt += (c > 0u) ? 1u : 0u; mine = (j == x) ? c : mine; }
        if (sum == G) break;
        __builtin_amdgcn_s_sleep(1);
        if ((++sp & 255u) == 0u) { if (xb_ld(&bar[XB_TMO])) break; if (sp > XB_SPIN_CAP) { atomicAdd(&bar[XB_TMO], 1u); break; } }
    }
    nloc = mine > 0u ? mine : 1u; nx = cnt > 0u ? cnt : 1u;
}

__device__ __forceinline__ void xcd_barrier(const XcdBarrier& b) {
    asm volatile("s_waitcnt vmcnt(0)" ::: "memory");
    __syncthreads();
    if (threadIdx.x == 0) {
        unsigned* bar = b.bar;
        __builtin_amdgcn_s_waitcnt(0);
        unsigned nloc = b.st[0], nx = b.st[1];
        if (nloc == 0u) { xcd_barrier_complete(bar, b.x, nloc, nx); b.st[0] = nloc; b.st[1] = nx; }
        const unsigned old = xb_add(&bar[XB_XSUB(b.x)], 1u);
        const unsigned gen = old / nloc;
        if (old + 1u == (gen + 1u) * nloc) {
            __builtin_amdgcn_fence(__ATOMIC_RELEASE, "agent");
            asm volatile("s_waitcnt vmcnt(0)" ::: "memory");
            const unsigned og = xb_add(&bar[XB_TOP], 1u);
            const unsigned tg = og / nx;
            if (og + 1u == (tg + 1u) * nx) xb_add(&bar[XB_TOPGEN], 1u);
            else XB_SPIN(xb_ld(&bar[XB_TOPGEN]) == tg, bar);
            __builtin_amdgcn_fence(__ATOMIC_ACQUIRE, "agent");
            xb_add(&bar[XB_XGEN(b.x)], 1u);
            asm volatile("s_waitcnt vmcnt(0)" ::: "memory");
        } else {
            XB_SPIN(xb_ld(&bar[XB_XGEN(b.x)]) == gen, bar);
            __builtin_amdgcn_fence(__ATOMIC_ACQUIRE, "agent");
            asm volatile("s_waitcnt vmcnt(0)" ::: "memory");
        }
    }
    __syncthreads();
}

#ifndef DUP_MASK
#define DUP_MASK 0
#endif
#define REP(k) for (int rep_ = 0; rep_ < ((((DUP_MASK) >> (k)) & 1) + 1); ++rep_)

constexpr size_t MiB = 1u << 20;
constexpr size_t WS_CTL = 0, CTL_ZERO_BYTES = 1 * MiB;
constexpr size_t WS_ADAP = 1 * MiB;
constexpr size_t WS_ADA = 4 * MiB;
constexpr size_t WS_DUMMY = 4 * MiB + 768 * 1024;
constexpr size_t WS_CB = 4 * MiB + 512 * 1024;
constexpr size_t WS_LOGF = 5 * MiB;
constexpr size_t WS_GATES = 6 * MiB;
constexpr size_t WS_KBIAS = 9 * MiB;
constexpr size_t WS_KC = 10 * MiB, WS_VC = 10 * MiB + 512 * 1024;
constexpr size_t WS_WRT = 11 * MiB;
constexpr size_t WS_WCK = 11 * MiB + 256 * 1024, WS_WCV = 11 * MiB + 512 * 1024;
constexpr size_t WS_TOPE = 12 * MiB, WS_TOPW = 12 * MiB + 512 * 1024, WS_RANK = 13 * MiB;
constexpr size_t WS_KX = 14 * MiB;
constexpr size_t WS_TOKOF = 14 * MiB;
constexpr size_t WS_WFOX = 18 * MiB, WS_WNSA = 19 * MiB, WS_WMIX = 20 * MiB, WS_WIN = 22 * MiB;
constexpr size_t WS_WD = 32 * MiB;
constexpr size_t WS_WGU = 96 * MiB;
constexpr size_t WS_YSHI = 96 * MiB;
constexpr size_t WS_FQ = 224 * MiB, WS_FK = 256 * MiB, WS_FV = 288 * MiB, WS_NQ = 320 * MiB;
constexpr size_t WS_KV6 = 352 * MiB;
constexpr size_t WS_SGF = 400 * MiB, WS_SGN = 464 * MiB;
constexpr size_t WS_MIXED = 224 * MiB;
constexpr size_t WS_GATED = 288 * MiB;
constexpr size_t WS_ACT = 288 * MiB;
constexpr size_t WS_H2F8 = 416 * MiB;
constexpr size_t WS_END = 544 * MiB;
constexpr size_t OUT_H = 0, OUT_OFOX = 64 * MiB, OUT_ONSA = 96 * MiB, OUT_H2 = 0, OUT_H2LO = 64 * MiB;
constexpr size_t KV6_STRIDE = (size_t)NTOK * 128;

constexpr int CW_TMO = 0;
constexpr int CW_BAR = 4096;
constexpr int CW_NSAQ = 3072;
constexpr int CW_ECNT = 32768;

constexpr int RING_BYTES = 131072;
constexpr int MISC_OFF = 143872;
constexpr int TAB_OFF = 143872 + 256;
constexpr int ROWTAB_OFF = 143872 + 1024;
constexpr int LDS_BYTES = 163840;

__device__ const unsigned char T5_BUCKET[128] = {
 0,1,2,3,4,5,6,7,8,9,10,11,12,13,14,15,16,16,16,17,17,18,18,18,19,19,19,20,20,20,20,21,21,21,21,22,22,22,22,22,23,23,23,23,23,23,24,24,24,24,24,24,25,25,25,25,25,25,25,26,26,26,26,26,26,26,26,
 27,27,27,27,27,27,27,27,27,27,28,28,28,28,28,28,28,28,28,28,29,29,29,29,29,29,29,29,29,29,29,29,30,30,30,30,30,30,30,30,30,30,30,30,30,30,31,31,31,31,31,31,31,31,31,31,31,31,31,31,31};

struct Args { const float* in[26]; float* out; unsigned char* ws; int ph_lo, ph_hi; };
struct Ctx {
    float* out; unsigned char* ws;
    LAS unsigned char* lds; int tid, lane, wave, vcu, G;
};

__device__ __forceinline__ void conv64(const float* __restrict__ W, size_t ldw, int col, int k0, bf16* __restrict__ dst) {
#pragma unroll
    for (int h = 0; h < 2; ++h) {
        float v[32];
#pragma unroll
        for (int kk = 0; kk < 32; ++kk) v[kk] = W[(size_t)(k0 + h * 32 + kk) * ldw + col];
#pragma unroll
        for (int q = 0; q < 4; ++q) { v4u o; o.x = pk2(v[8 * q], v[8 * q + 1]); o.y = pk2(v[8 * q + 2], v[8 * q + 3]); o.z = pk2(v[8 * q + 4], v[8 * q + 5]); o.w = pk2(v[8 * q + 6], v[8 * q + 7]);
            *(v4u*)(dst + h * 32 + q * 8) = o; }
    }
}
__device__ __forceinline__ void conv_item(const float* W, size_t ldw, int col0, int ncb, bf16* WT, int Kd, int dst_row0, int r, int lane) {
    const int cbk = r % ncb, kb = r / ncb;
    conv64(W, ldw, col0 + cbk * 64 + lane, kb * 64, WT + (size_t)(dst_row0 + cbk * 64 + lane) * Kd + kb * 64);
}

#define CV_LOADH(V, src, ldw, h) do { const unsigned vo_ = (unsigned)((2 * (lane >> 4) * (ldw) + (lane & 15) * 4) * 4); const float* sh_ = (src) + (size_t)(32 * (h)) * (ldw); \
        _Pragma("unroll") for (int i_ = 0; i_ < 8; ++i_) V[i_] = __builtin_nontemporal_load((const f32x4*)((const char*)(sh_ + (size_t)(8 * (i_ >> 1) + (i_ & 1)) * (ldw)) + vo_)); } while (0)
#define CV_LDSW(V, h) do { LAS unsigned* T32_ = (LAS unsigned*)TT; const int a_ = lane & 15, b_ = lane >> 4; \
        _Pragma("unroll") for (int m_ = 0; m_ < 4; ++m_) { _Pragma("unroll") for (int c_ = 0; c_ < 4; ++c_) T32_[(4 * a_ + c_) * 32 + ((((4 * (h) + m_) ^ (a_ & 7)) << 2) | b_)] = pk2(V[2 * m_][c_], V[2 * m_ + 1][c_]); } } while (0)
#define CV_OUT(dst, Kd) do { _Pragma("unroll") for (int j_ = 0; j_ < 8; ++j_) { const v4u o_ = *(LAS const v4u*)((LAS const unsigned char*)TT + lane * 128 + ((j_ ^ ((lane >> 2) & 7)) << 4)); *(v4u*)((dst) + (size_t)lane * (Kd) + 8 * j_) = o_; } } while (0)
#define CONV_SMALL(W, ldw, col0, ncb, WT, Kd, dst_row0, r) do { const int cb_ = (r) % (ncb), kb_ = (r) / (ncb); f32x4 V0_[8], V1_[8]; \
        const float* src_ = (W) + (size_t)(kb_ * 64) * (ldw) + (col0) + cb_ * 64; CV_LOADH(V0_, src_, (ldw), 0); CV_LOADH(V1_, src_, (ldw), 1); \
        bf16* dst_ = (WT) + (size_t)((dst_row0) + cb_ * 64) * (Kd) + kb_ * 64; CV_LDSW(V0_, 0); CV_LDSW(V1_, 1); CV_OUT(dst_, (Kd)); } while (0)
__device__ __forceinline__ void exp_src_dst(const Args& A, unsigned char* ws, int q, const float*& src, bf16*& dst) {
    const int mat = q >> 8, rr = q & 255, cb = rr & 15, kb = rr >> 4, kind = mat >> 5, e = mat & 31, n = cb * 64;
    const float* W = (kind == 0 ? A.in[20] : (kind == 1 ? A.in[22] : A.in[24])) + (size_t)e * 1048576;
    src = W + (size_t)(kb * 64) * 1024 + n;
    const int drow = (kind == 2) ? e * 1024 + n : e * 2048 + (n >> 7) * 256 + (n & 127) + kind * 128;
    dst = (bf16*)(ws + (kind == 2 ? WS_WD : WS_WGU)) + (size_t)drow * 1024 + kb * 64;
}

#define CVF_LOADQ(V, src, ldw, qtr) do { const unsigned vo_ = (unsigned)((4 * (lane >> 4) * (ldw) + (lane & 15) * 4) * 4); const float* sq_ = (src) + (size_t)(32 * (qtr)) * (ldw); \
        _Pragma("unroll") for (int i_ = 0; i_ < 8; ++i_) V[i_] = __builtin_nontemporal_load((const f32x4*)((const char*)(sq_ + (size_t)(16 * (i_ >> 2) + (i_ & 3)) * (ldw)) + vo_)); } while (0)
#define CVF_LDSW(V, qtr) do { LAS unsigned* T32_ = (LAS unsigned*)TT; const int a_ = lane & 15, b_ = lane >> 4; \
        _Pragma("unroll") for (int mm_ = 0; mm_ < 2; ++mm_) { _Pragma("unroll") for (int c_ = 0; c_ < 4; ++c_) { \
            int pk_ = __builtin_amdgcn_cvt_pk_fp8_f32(V[4 * mm_][c_] * 32.f, V[4 * mm_ + 1][c_] * 32.f, 0, false); pk_ = __builtin_amdgcn_cvt_pk_fp8_f32(V[4 * mm_ + 2][c_] * 32.f, V[4 * mm_ + 3][c_] * 32.f, pk_, true); \
            T32_[(4 * a_ + c_) * 32 + ((((2 * (qtr) + mm_) ^ (a_ & 7)) << 2) | b_)] = (unsigned)pk_; } } } while (0)
#define CVF_OUT(dstb) do { _Pragma("unroll") for (int j_ = 0; j_ < 8; ++j_) { const v4u o_ = *(LAS const v4u*)((LAS const unsigned char*)TT + lane * 128 + ((j_ ^ ((lane >> 2) & 7)) << 4)); *(v4u*)((dstb) + (size_t)lane * 1024 + 16 * j_) = o_; } } while (0)
__device__ __forceinline__ void exp_src_dst8(const Args& A, unsigned char* ws, int q, const float*& src, unsigned char*& dst) {
    const int mat = q >> 7, rr = q & 127, cb = rr & 15, kb = rr >> 4, kind = mat >> 5, e = mat & 31, n = cb * 64;
    const float* W = (kind == 0 ? A.in[20] : (kind == 1 ? A.in[22] : A.in[24])) + (size_t)e * 1048576;
    src = W + (size_t)(kb * 128) * 1024 + n;
    const int drow = (kind == 2) ? e * 1024 + n : e * 2048 + (n >> 7) * 256 + (n & 127) + kind * 128;
    dst = ws + (kind == 2 ? WS_WD : WS_WGU) + (size_t)drow * 1024 + kb * 128;
}

__device__ __forceinline__ void phase0a(const Args& A, const Ctx& X) {
    const float* c = A.in[1]; const float* w_ada = A.in[2]; const float* w_in = A.in[6];
    LAS float* sl = (LAS float*)X.lds;
    for (int i = X.tid; i < 8192; i += 512) { const float v = c[i]; sl[i] = v / (1.f + __expf(-v)); }
    __syncthreads();
    const int gw = X.vcu * 8 + X.wave, NGW = X.G * 8, lane = X.lane;
    unsigned char* ws = X.ws;
    bf16* WIN = (bf16*)(ws + WS_WIN);
    LAS bf16* TT = (LAS bf16*)(X.lds + 32768 + X.wave * 8192);
    constexpr int J_ADA = 24 * 16, J_INA = 24 * 16, J_INB = 20 * 16, J_INC = 32 * 16, J_IND = 256, J_FOX = 16 * 8, J_NSA = 16 * 8, J_MIX = 16 * 16, J_CK = 32, J_CV = 32, J_RT = 32, J_CB = 128;
    constexpr int NITEMS = J_ADA + J_INA + J_INB + J_INC + J_IND + J_FOX + J_NSA + J_MIX + J_CK + J_CV + J_RT + J_CB;
    for (int it = gw; it < NITEMS; it += NGW) {
        int r = it;
        if (r < J_ADA) {
            const int cb = r % 24, ks = r / 24, j = cb * 256 + lane * 4; f32x4 acc[8];
#pragma unroll
            for (int b = 0; b < 8; ++b) acc[b] = (f32x4){0.f, 0.f, 0.f, 0.f};
            for (int k4 = 0; k4 < 4; ++k4) {
                f32x4 w[16];
#pragma unroll
                for (int kk = 0; kk < 16; ++kk) w[kk] = __builtin_nontemporal_load((const f32x4*)(w_ada + (size_t)(ks * 64 + k4 * 16 + kk) * 6144 + j));
#pragma unroll
                for (int kk = 0; kk < 16; ++kk) {
#pragma unroll
                    for (int b = 0; b < 8; ++b) acc[b] += w[kk] * sl[b * 1024 + ks * 64 + k4 * 16 + kk]; }
            }
            float* P = (float*)(ws + WS_ADAP);
#pragma unroll
            for (int b = 0; b < 8; ++b) *(f32x4*)(P + (size_t)(ks * 8 + b) * 6144 + j) = acc[b];
            continue; }
        r -= J_ADA;
        if (r < J_INA) { CONV_SMALL(w_in, 4896, 0, 24, WIN, 1024, 0, r); continue; } r -= J_INA;
        if (r < J_INB) { CONV_SMALL(w_in, 4896, 1544, 20, WIN, 1024, 1536, r); continue; } r -= J_INB;
        if (r < J_INC) { CONV_SMALL(w_in, 4896, 2848, 32, WIN, 1024, 2816, r); continue; } r -= J_INC;
        if (r < J_IND) {
            const int row = 4864 + r; const int col = (row < 4872) ? 1536 + (row - 4864) : (row < 4896 ? 2824 + (row - 4872) : -1);
            float v[16];
#pragma unroll
            for (int i = 0; i < 16; ++i) v[i] = w_in[(size_t)(lane * 16 + i) * 4896 + (col >= 0 ? col : 0)];
#pragma unroll
            for (int i = 0; i < 16; ++i) v[i] = (col >= 0) ? v[i] : 0.f;
            v4u o0, o1; o0.x = pk2(v[0], v[1]); o0.y = pk2(v[2], v[3]); o0.z = pk2(v[4], v[5]); o0.w = pk2(v[6], v[7]); o1.x = pk2(v[8], v[9]); o1.y = pk2(v[10], v[11]); o1.z = pk2(v[12], v[13]); o1.w = pk2(v[14], v[15]);
            *(v4u*)(WIN + (size_t)row * 1024 + lane * 16) = o0; *(v4u*)(WIN + (size_t)row * 1024 + lane * 16 + 8) = o1;
            continue; }
        r -= J_IND;
        if (r < J_FOX) { CONV_SMALL(A.in[12], 1024, 0, 16, (bf16*)(ws + WS_WFOX), 512, 0, r); continue; } r -= J_FOX;
        if (r < J_NSA) { CONV_SMALL(A.in[13], 1024, 0, 16, (bf16*)(ws + WS_WNSA), 512, 0, r); continue; } r -= J_NSA;
        if (r < J_MIX) { CONV_SMALL(A.in[14], 1024, 0, 16, (bf16*)(ws + WS_WMIX), 1024, 0, r); continue; } r -= J_MIX;
        if (r < J_CK) { CONV_SMALL(A.in[10], 64, 0, 1, (bf16*)(ws + WS_WCK), 2048, 0, r); continue; } r -= J_CK;
        if (r < J_CV) { CONV_SMALL(A.in[11], 64, 0, 1, (bf16*)(ws + WS_WCV), 2048, 0, r); continue; } r -= J_CV;
        if (r < J_RT) { const float* wr_ = A.in[18]; bf16* WRH = (bf16*)(ws + WS_WRT); bf16* WRL = WRH + 32 * 1024;
#pragma unroll
            for (int i = 0; i < 16; ++i) { const int k = lane + 64 * i; const float w = wr_[k * 32 + r]; const unsigned h = pk2(w, 0.f) & 0xffffu; const float hf = bf_lo(h);
                WRH[r * 1024 + k] = (bf16)h; WRL[r * 1024 + k] = (bf16)(pk2(w - hf, 0.f) & 0xffffu); }
            continue; }
        r -= J_RT;
        { const int which = r >> 6, j = r & 63; const float* pe = A.in[8 + which]; const float* wc = A.in[10 + which]; float s = 0.f;
#pragma unroll 8
            for (int i = 0; i < 32; ++i) { const int q = lane * 32 + i; s += pe[q] * wc[q * 64 + j]; }
            s = wave_sum(s); if (lane == 0) ((float*)(ws + WS_CB))[which * 64 + j] = s; }
    }
}

__device__ __forceinline__ void phase0b(const Args& A, const Ctx& X) {
    const float* P = (const float*)(X.ws + WS_ADAP); const float* b_ada = A.in[3];
    float* ADA = (float*)(X.ws + WS_ADA);
    for (int gid = blockIdx.x * 512 + X.tid; gid < 8 * 6144; gid += X.G * 512) {
        const int b = gid / 6144, col = gid % 6144; float s = b_ada[col];
#pragma unroll
        for (int ks = 0; ks < 16; ++ks) s += P[(size_t)(ks * 8 + b) * 6144 + col];
        ADA[gid] = s;
    }
    LAS float* gs = (LAS float*)X.lds;
    LAS float* sh = gs + 1024;
    const float* x = A.in[0]; const float* g = A.in[4];
    bf16* H = (bf16*)((unsigned char*)X.out + OUT_H);
    for (int ch = blockIdx.x; ch < NTOK / 128; ch += X.G) {
        const int row0 = ch * 128, b = row0 / SEQ;
        __syncthreads();
        for (int j = X.tid; j < 2048; j += 512) { float s = b_ada[j];
#pragma unroll
            for (int ks = 0; ks < 16; ++ks) s += P[(size_t)(ks * 8 + b) * 6144 + j];
            if (j < 1024) sh[j] = s; else gs[j - 1024] = g[j - 1024] * (1.f + s); }
        __syncthreads();
#define P0_ROW(V, ROW) do { float ss = 0.f; \
            _Pragma("unroll") for (int j = 0; j < 4; ++j) ss += (V[j].x * V[j].x + V[j].y * V[j].y) + (V[j].z * V[j].z + V[j].w * V[j].w); \
            const float rstd = 1.f / sqrtf(wave_sum(ss) * (1.f / DM) + RMS_EPS); v2u* o8 = (v2u*)(H + (size_t)(ROW) * DM) + X.lane; \
            _Pragma("unroll") for (int j = 0; j < 4; ++j) { const int k = 4 * X.lane + 256 * j; const f32x4 gg = *(LAS f32x4*)(gs + k), ss4 = *(LAS f32x4*)(sh + k); \
                v2u o; o.x = pk2(V[j].x * rstd * gg.x + ss4.x, V[j].y * rstd * gg.y + ss4.y); o.y = pk2(V[j].z * rstd * gg.z + ss4.z, V[j].w * rstd * gg.w + ss4.w); o8[64 * j] = o; } } while (0)
#define P0_LOAD(V, ROW) do { const f32x4* xr_ = (const f32x4*)(x + (size_t)(ROW) * DM) + X.lane; _Pragma("unroll") for (int j = 0; j < 4; ++j) V[j] = __builtin_nontemporal_load(xr_ + 64 * j); } while (0)
        { f32x4 vA[4], vB[4]; const int wrow0 = row0 + X.wave;
          for (int i = 0; i < 16; ++i) { P0_LOAD(vA, wrow0 + 8 * i); P0_ROW(vA, wrow0 + 8 * i); } (void)vB; }
#undef P0_ROW
#undef P0_LOAD
    }
}

__device__ __forceinline__ void phase2(const Args& A, const Ctx& X) {
    const int lane = X.lane, wid = X.wave, r32 = lane & 31, hi = lane >> 5;
    LAS float* red = (LAS float*)X.lds;
    for (int it = blockIdx.x; it < 256; it += X.G) {
        const int cblk = it & 7, which = (it >> 3) & 1, bg = it >> 4;
        const bf16* src = (const bf16*)(X.ws + WS_KV6) + (size_t)which * KV6_STRIDE + (size_t)bg * SEQ * 64;
        const bf16* WT = (const bf16*)(X.ws + (which ? WS_WCV : WS_WCK));
        const int c0 = cblk * 32, kbase = wid * 256;
        f32x16 acc0 = {}, acc1 = {};
        const bf16* ap = src + (size_t)(16 * (c0 + r32)) * 64 + kbase + hi * 8;
        const bf16* bp0 = WT + (size_t)r32 * 2048 + kbase + hi * 8;
        const bf16* bp1 = WT + (size_t)(32 + r32) * 2048 + kbase + hi * 8;
#pragma unroll
        for (int kk = 0; kk < 16; ++kk) {
            const bf16x8 a = *(const bf16x8*)(ap + kk * 16), b0 = *(const bf16x8*)(bp0 + kk * 16), b1 = *(const bf16x8*)(bp1 + kk * 16);
            acc0 = __builtin_amdgcn_mfma_f32_32x32x16_bf16(a, b0, acc0, 0, 0, 0);
            acc1 = __builtin_amdgcn_mfma_f32_32x32x16_bf16(a, b1, acc1, 0, 0, 0);
        }
        __syncthreads();
#pragma unroll
        for (int r = 0; r < 16; ++r) { const int row = (r & 3) + 8 * (r >> 2) + 4 * hi; red[(wid * 32 + row) * 64 + r32] = acc0[r]; red[(wid * 32 + row) * 64 + 32 + r32] = acc1[r]; }
        __syncthreads();
        { const int c = X.tid >> 4, n4 = (X.tid & 15) * 4; f32x4 s = *(const f32x4*)((const float*)(X.ws + WS_CB) + which * 64 + n4);
#pragma unroll
          for (int w = 0; w < 8; ++w) s += *(LAS f32x4*)(red + (w * 32 + c) * 64 + n4);
          if (c0 + c == 255) s = (f32x4){0.f, 0.f, 0.f, 0.f};
          v2u o; o.x = pk2(s.x, s.y); o.y = pk2(s.z, s.w);
          *(v2u*)((bf16*)(X.ws + (which ? WS_VC : WS_KC)) + ((size_t)bg * 256 + c0 + c) * 64 + n4) = o; }
    }
    for (int sq = blockIdx.x; sq < 64; sq += X.G) {
        const int b = sq >> 3, h = sq & 7; const float* lf = (const float*)(X.ws + WS_LOGF) + (size_t)b * SEQ * 8 + h;
        float v[8];
#pragma unroll
        for (int i = 0; i < 8; ++i) v[i] = lf[(size_t)(X.tid * 8 + i) * 8];
#pragma unroll
        for (int i = 1; i < 8; ++i) v[i] += v[i - 1];
        float incl = v[7];
#pragma unroll
        for (int o = 1; o < 64; o <<= 1) { const float t = __shfl_up(incl, o); if (lane >= o) incl += t; }
        __syncthreads();
        if (lane == 63) red[wid] = incl;
        __syncthreads();
        float pre = incl - v[7];
        for (int w = 0; w < wid; ++w) pre += red[w];
        float* kb = (float*)(X.ws + WS_KBIAS) + (size_t)sq * SEQ + X.tid * 8;
        *(f32x4*)kb = (f32x4){-(pre + v[0]) * LOG2E, -(pre + v[1]) * LOG2E, -(pre + v[2]) * LOG2E, -(pre + v[3]) * LOG2E};
        *(f32x4*)(kb + 4) = (f32x4){-(pre + v[4]) * LOG2E, -(pre + v[5]) * LOG2E, -(pre + v[6]) * LOG2E, -(pre + v[7]) * LOG2E};
        { v4u* kx = (v4u*)((bf16*)(X.ws + WS_KX) + ((size_t)sq * SEQ + X.tid * 8) * 8);
#pragma unroll
          for (int i = 0; i < 8; ++i) { const float b0 = -(pre + v[i]) * LOG2E; const unsigned h = pk2(b0, 0.f) & 0xffffu; const float r1 = b0 - bf_lo(h); const unsigned md = pk2(r1, 0.f) & 0xffffu; const float r2 = r1 - bf_lo(md);
              kx[i] = (v4u){h | (md << 16), pk2(r2, 0.f) & 0xffffu, 0u, 0u}; } }
    }
}

__device__ __forceinline__ v4u pack8(const f32x4 a, const f32x4 b) { v4u w; w.x = pk2(a[0], a[1]); w.y = pk2(a[2], a[3]); w.z = pk2(b[0], b[1]); w.w = pk2(b[2], b[3]); return w; }

struct EpiInProj {
    unsigned char* ws; const float* b_forget;
    __device__ __forceinline__ void operator()(const f32x4 (&acc)[2][2][4][2], const pg8::Unit& u, int wr, int wc, int fr, int fq) const {
        part<0>(acc, u, wr, wc, fr, fq); part<1>(acc, u, wr, wc, fr, fq);
    }
    template <int bj> __device__ __forceinline__ void part(const f32x4 (&acc)[2][2][4][2], const pg8::Unit& u, int wr, int wc, int fr, int fq) const {
        const int row0 = u.pm * 256 + wr * 64 + fr, b = (u.pm * 256) >> 12;
        {
            const int cb = u.pn * 256 + bj * 128 + wc * 32;
            if (cb >= 4896) return;
            if (cb < 4864) {
                bf16* base; int pitch; float scl = 1.f; bool sig = false;
                if (cb < 2048) { const int tt = cb >> 9, head = (cb & 511) >> 6; if (tt == 0 || tt == 3) scl = QSCALE; pitch = 64;
                    base = (bf16*)(ws + WS_FQ) + (size_t)tt * ((size_t)NTOK * 512) + ((size_t)(b * 7 + head) * SEQ) * 64 + (cb & 63) + 8 * fq; }
                else if (cb < 2816) { const int q = cb - 2048, idx6 = q >> 7, grp = (q & 127) >> 6; pitch = 64;
                    base = (bf16*)(ws + WS_KV6) + (size_t)idx6 * KV6_STRIDE + ((size_t)(b + grp) * SEQ) * 64 + (cb & 63) + 8 * fq; }
                else { const int q = cb - 2816, which = q >> 10; pitch = 1024; sig = true; base = (bf16*)(ws + (which ? WS_SGN : WS_SGF)) + (q & 1023) + 8 * fq; }
#pragma unroll
                for (int ai = 0; ai < 2; ++ai)
#pragma unroll
                    for (int m = 0; m < 4; ++m) {
                        const int row = row0 + ai * 128 + m * 16;
                        f32x4 v0 = acc[ai][bj][m][0], v1 = acc[ai][bj][m][1];
                        if (sig) {
#pragma unroll
                            for (int i = 0; i < 4; ++i) { v0[i] = sigmoidf_(v0[i]); v1[i] = sigmoidf_(v1[i]); }
                        } else { v0 = v0 * scl; v1 = v1 * scl; }
                        *(v4u*)(base + (size_t)row * pitch) = pack8(v0, v1);
                    }
            } else {
#pragma unroll
                for (int ai = 0; ai < 2; ++ai)
#pragma unroll
                    for (int m = 0; m < 4; ++m) {
                        const int row = row0 + ai * 128 + m * 16;
                        const f32x4 v0 = acc[ai][bj][m][0], v1 = acc[ai][bj][m][1]; f32x4 o0, o1;
                        if (fq == 0) {
#pragma unroll
                            for (int i = 0; i < 4; ++i) { const float z0 = v0[i] + b_forget[i], z1 = v1[i] + b_forget[4 + i];
                                o0[i] = fminf(z0, 0.f) - log1pf(__expf(-fabsf(z0))); o1[i] = fminf(z1, 0.f) - log1pf(__expf(-fabsf(z1))); }
                        } else {
#pragma unroll
                            for (int i = 0; i < 4; ++i) { o0[i] = sigmoidf_(v0[i]); o1[i] = sigmoidf_(v1[i]); }
                        }
                        float* dst = (fq == 0) ? (float*)(ws + WS_LOGF) + (size_t)row * 8 : (float*)(ws + WS_GATES) + (size_t)row * 24 + 8 * (fq - 1);
                        *(f32x4*)dst = o0; *(f32x4*)(dst + 4) = o1;
                    }
            }
        }
    }
};

template <bool ADD> struct EpiGate {
    bf16* O; const bf16* SG;
    __device__ __forceinline__ void operator()(const f32x4 (&acc)[2][2][4][2], const pg8::Unit& u, int wr, int wc, int fr, int fq) const {
        const size_t off0 = (size_t)(u.pm * 256 + wr * 64 + fr) * 1024 + u.pn * 256 + wc * 32 + 8 * fq;
#pragma unroll
        for (int ai = 0; ai < 2; ++ai) {
            v4u g[4][2], p[4][2];
#pragma unroll
            for (int m = 0; m < 4; ++m)
#pragma unroll
                for (int bj = 0; bj < 2; ++bj) { const size_t off = off0 + (size_t)(ai * 128 + m * 16) * 1024 + bj * 128; g[m][bj] = __builtin_nontemporal_load((const v4u*)(SG + off)); if (ADD) p[m][bj] = *(const v4u*)(O + off); }
#pragma unroll
            for (int m = 0; m < 4; ++m)
#pragma unroll
                for (int bj = 0; bj < 2; ++bj) {
                    const size_t off = off0 + (size_t)(ai * 128 + m * 16) * 1024 + bj * 128; const v4u gg = g[m][bj];
                    f32x4 v0 = acc[ai][bj][m][0], v1 = acc[ai][bj][m][1];
                    v0[0] *= bf_lo(gg.x); v0[1] *= bf_hi(gg.x); v0[2] *= bf_lo(gg.y); v0[3] *= bf_hi(gg.y); v1[0] *= bf_lo(gg.z); v1[1] *= bf_hi(gg.z); v1[2] *= bf_lo(gg.w); v1[3] *= bf_hi(gg.w);
                    if (ADD) { const v4u pp = p[m][bj];
                        v0[0] += bf_lo(pp.x); v0[1] += bf_hi(pp.x); v0[2] += bf_lo(pp.y); v0[3] += bf_hi(pp.y); v1[0] += bf_lo(pp.z); v1[1] += bf_hi(pp.z); v1[2] += bf_lo(pp.w); v1[3] += bf_hi(pp.w); }
                    *(v4u*)(O + off) = pack8(v0, v1);
                }
        }
    }
};

struct EpiPlain {
    bf16* O; int ldc;
    __device__ __forceinline__ void operator()(const f32x4 (&acc)[2][2][4][2], const pg8::Unit& u, int wr, int wc, int fr, int fq) const {
#pragma unroll
        for (int ai = 0; ai < 2; ++ai)
#pragma unroll
            for (int m = 0; m < 4; ++m)
#pragma unroll
                for (int bj = 0; bj < 2; ++bj) {
                    const size_t off = (size_t)(u.pm * 256 + ai * 128 + wr * 64 + m * 16 + fr) * ldc + u.pn * 256 + bj * 128 + wc * 32 + 8 * fq;
                    *(v4u*)(O + off) = pack8(acc[ai][bj][m][0], acc[ai][bj][m][1]);
                }
    }
};

struct MoeOrder {
    int G, c, NP, mode;
    LAS const int* tab; LAS const int* rowtab;
    __device__ __forceinline__ bool next(int i, pg8::Unit& u) const {
        const int ntile = tab[32 + 32], x = c & 7, y = c >> 3, per = G >> 3, nx = (ntile - x + 7) >> 3;
        const int U = i * per + y;
        if (U >= nx * NP) return false;
        const int ti = x + 8 * (U / NP), pnl = U % NP; int e = 0;
#pragma unroll 1
        for (int k = 1; k < 32; ++k) e = (tab[32 + k] <= ti) ? k : e;
        u.e = e; u.rt = ti - tab[32 + e]; u.pm = ti; u.pn = e * NP + pnl; u.ord = i; return true;
    }
    __device__ __forceinline__ unsigned a_off(const pg8::Unit& u, int r) const {
        if (mode == 0) return (unsigned)(rowtab[u.ord * 256 + r] >> 2) * 1024u;
        const int cnt = tab[u.e]; int rank = u.rt * 256 + r; rank = rank < cnt ? rank : cnt - 1;
        return (unsigned)(tab[65 + u.e] + rank) * 1024u;
    }
};
__device__ __forceinline__ void moe_tables(const Args& A, const Ctx& X) {
    LAS int* tab = (LAS int*)(X.lds + TAB_OFF);
    __syncthreads();
    if (X.tid == 0) { const unsigned* ctl = (const unsigned*)(X.ws + WS_CTL); int ts = 0, gs = 0;
        for (int e = 0; e < 32; ++e) { const int cnt = (int)__hip_atomic_load(ctl + CW_ECNT + 64 * e, __ATOMIC_RELAXED, __HIP_MEMORY_SCOPE_AGENT); tab[e] = cnt; tab[32 + e] = ts; tab[65 + e] = gs; ts += (cnt + 255) >> 8; gs += cnt; }
        tab[32 + 32] = ts; tab[65 + 32] = gs; }
    __syncthreads();
}
__device__ __forceinline__ void moe_rowtab(const Ctx& X, const MoeOrder& S, const int* tokof) {
    LAS int* rt = (LAS int*)(X.lds + ROWTAB_OFF); pg8::Unit u;
    for (int i = X.tid >> 8; S.next(i, u); i += 2) { const int r = X.tid & 255, cnt = S.tab[u.e]; int rank = u.rt * 256 + r; rank = rank < cnt ? rank : cnt - 1;
        rt[i * 256 + r] = tokof[(size_t)u.e * NTOK + rank]; }
    __syncthreads();
}

struct EpiGateUp {
    unsigned char* ACT; const float* bg; const float* bu; LAS const int* tab; unsigned char* dummy;
    __device__ __forceinline__ void operator()(const f32x4 (&acc)[2][2][4][2], const pg8::Unit& u, int wr, int wc, int fr, int fq) const {
        const int e = u.e, pnl = u.pn - e * 8, col = pnl * 128 + wc * 32 + 8 * fq, cnt = tab[e], gs = tab[65 + e];
        const f32x4 g0 = *(const f32x4*)(bg + e * 1024 + col), g1 = *(const f32x4*)(bg + e * 1024 + col + 4), u0 = *(const f32x4*)(bu + e * 1024 + col), u1 = *(const f32x4*)(bu + e * 1024 + col + 4);
        unsigned char* const sink = dummy + threadIdx.x * 8;
        constexpr float WS = 1.f / 32.f;
#pragma unroll
        for (int ai = 0; ai < 2; ++ai)
#pragma unroll
            for (int m = 0; m < 4; ++m) {
                const int rank = u.rt * 256 + ai * 128 + wr * 64 + m * 16 + fr;
                f32x4 a0 = acc[ai][0][m][0] * WS + g0, a1 = acc[ai][0][m][1] * WS + g1, b0 = acc[ai][1][m][0] * WS + u0, b1 = acc[ai][1][m][1] * WS + u1, o0, o1;
#pragma unroll
                for (int i = 0; i < 4; ++i) {
                    float gt = fminf(a0[i], 7.f), up = fminf(fmaxf(b0[i], -7.f), 7.f); o0[i] = gt * (up + 1.f) * __builtin_amdgcn_rcpf(1.f + __builtin_amdgcn_exp2f(-1.702f * LOG2E * gt));
                    gt = fminf(a1[i], 7.f); up = fminf(fmaxf(b1[i], -7.f), 7.f); o1[i] = gt * (up + 1.f) * __builtin_amdgcn_rcpf(1.f + __builtin_amdgcn_exp2f(-1.702f * LOG2E * gt)); }
                int p0 = __builtin_amdgcn_cvt_pk_fp8_f32(o0[0], o0[1], 0, false); p0 = __builtin_amdgcn_cvt_pk_fp8_f32(o0[2], o0[3], p0, true);
                int p1 = __builtin_amdgcn_cvt_pk_fp8_f32(o1[0], o1[1], 0, false); p1 = __builtin_amdgcn_cvt_pk_fp8_f32(o1[2], o1[3], p1, true);
                unsigned char* dst = (rank < cnt) ? ACT + (size_t)(gs + rank) * 1024 + col : sink;
                *(v2u*)dst = (v2u){(unsigned)p0, (unsigned)p1};
            }
    }
};
struct EpiDown {
    unsigned char* out; unsigned char* yshi; const float* bd; LAS const int* tab; LAS const int* rowtab; unsigned char* dummy;
    __device__ __forceinline__ void operator()(const f32x4 (&acc)[2][2][4][2], const pg8::Unit& u, int wr, int wc, int fr, int fq) const {
        const int e = u.e, pnl = u.pn - e * 4, cnt = tab[e];
        f32x4 bb[2][2];
#pragma unroll
        for (int bj = 0; bj < 2; ++bj) { const int col = pnl * 256 + bj * 128 + wc * 32 + 8 * fq; bb[bj][0] = *(const f32x4*)(bd + e * 1024 + col); bb[bj][1] = *(const f32x4*)(bd + e * 1024 + col + 4); }
        unsigned char* const sink = dummy + threadIdx.x * 16;
        const long long dlt = (long long)(yshi - out);
#pragma unroll
        for (int ai = 0; ai < 2; ++ai)
#pragma unroll
            for (int m = 0; m < 4; ++m) {
                const int r = ai * 128 + wr * 64 + m * 16 + fr, rank = u.rt * 256 + r;
                const int id = rowtab[u.ord * 256 + r], tok = id >> 2, k = id & 3;
                unsigned char* rowp = out + ((k >= 2) ? dlt : 0ll) + (size_t)tok * 4096 + (k & 1) * 2048;
#pragma unroll
                for (int bj = 0; bj < 2; ++bj) { const int col = pnl * 256 + bj * 128 + wc * 32 + 8 * fq;
                    unsigned char* dst = (rank < cnt) ? rowp + col * 2 : sink;
                    *(v4u*)dst = pack8(acc[ai][bj][m][0] * (1.f / 32.f) + bb[bj][0], acc[ai][bj][m][1] * (1.f / 32.f) + bb[bj][1]); }
            }
    }
};

__device__ __forceinline__ f32x4 ld_bf4(const bf16* p) { const v2u u = *(const v2u*)p; return (f32x4){bf_lo(u.x), bf_hi(u.x), bf_lo(u.y), bf_hi(u.y)}; }

__device__ __forceinline__ void top4_of8(const float (&v)[8], const int (&id)[8], float (&ov)[4], int (&oi)[4]) {
    unsigned taken = 0u;
#pragma unroll
    for (int k = 0; k < 4; ++k) { float best = -3.4e38f; int bi = 0x7fffffff, bp = 0;
#pragma unroll
        for (int c = 0; c < 8; ++c) { const bool free_ = ((taken >> c) & 1u) == 0u; const bool better = free_ && ((v[c] > best) || (v[c] == best && id[c] < bi)); best = better ? v[c] : best; bi = better ? id[c] : bi; bp = better ? c : bp; }
        ov[k] = best; oi[k] = bi; taken |= 1u << bp; }
}

__device__ __forceinline__ void phase6(const Args& A, const Ctx& X) {
    const float* x = A.in[0]; const float* gpost = A.in[5]; const float* gpre2 = A.in[16]; const float* b_router = A.in[19];
    const float* ADA = (const float*)(X.ws + WS_ADA);
    const bf16* WRH = (const bf16*)(X.ws + WS_WRT); const bf16* WRL = WRH + 32 * 1024;
    const bf16* MIXED = (const bf16*)(X.ws + WS_MIXED); bf16* H2 = (bf16*)((unsigned char*)X.out + OUT_H2); bf16* H2L = (bf16*)((unsigned char*)X.out + OUT_H2LO); unsigned char* H2F8 = X.ws + WS_H2F8;
    int* TOPE = (int*)(X.ws + WS_TOPE); float* TOPW = (float*)(X.ws + WS_TOPW); int* RANK = (int*)(X.ws + WS_RANK); int* TOKOF = (int*)(X.ws + WS_TOKOF);
    unsigned* ctl = (unsigned*)(X.ws + WS_CTL);
    LAS unsigned char* wr_lds = X.lds;
    for (int pidx = X.tid; pidx < 8192; pidx += 512) { const int tb = pidx >> 12, row = (pidx & 4095) >> 7, c = pidx & 127;
        *(LAS v4u*)(wr_lds + tb * 66048 + row * 2064 + c * 16) = *(const v4u*)((tb ? WRL : WRH) + row * 1024 + c * 8); }
    LAS float* v_g1 = (LAS float*)(X.lds + ROWTAB_OFF);
    LAS float* v_g2 = v_g1 + 1024;
    LAS float* v_s2 = v_g2 + 1024;
    LAS int* e_of = (LAS int*)(v_s2 + 1024);
    LAS int* lcnt = e_of + 512;
    LAS int* lbase = lcnt + 32;
    const int lane = X.lane;
    for (int ch = blockIdx.x; ch < NTOK / 128; ch += X.G) {
        const int row0 = ch * 128, b = row0 / SEQ;
        __syncthreads();
        for (int j = X.tid; j < 1024; j += 512) { v_g1[j] = ADA[b * 6144 + 2048 + j] * gpost[j]; v_g2[j] = gpre2[j] * (1.f + ADA[b * 6144 + 4096 + j]); v_s2[j] = ADA[b * 6144 + 3072 + j]; }
        if (X.tid < 32) lcnt[X.tid] = 0;
        __syncthreads();
#ifdef PROBE_SUB
        unsigned tp6_ = (unsigned)__builtin_amdgcn_s_memrealtime();
#define P6STAMP(k) do { if (blockIdx.x == 0 && X.tid == 0) { const unsigned t_ = (unsigned)__builtin_amdgcn_s_memrealtime(); ((volatile LAS unsigned*)(X.lds + MISC_OFF))[50 + (k)] += t_ - tp6_; tp6_ = t_; } } while (0)
#else
#define P6STAMP(k) do { } while (0)
#endif
        const int wrow0 = row0 + X.wave;
#define P6_LOAD(MV, XV, ROW) do { _Pragma("unroll") for (int j = 0; j < 4; ++j) { const int k = 4 * lane + 256 * j; MV[j] = __builtin_nontemporal_load((const v2u*)(MIXED + (size_t)(ROW) * 1024 + k)); XV[j] = __builtin_nontemporal_load((const f32x4*)(x + (size_t)(ROW) * 1024 + k)); } } while (0)
#define P6_ROW(MVR, XVR, ROW) do { f32x4 mv[4], xv[4]; float ss = 0.f; \
            _Pragma("unroll") for (int j = 0; j < 4; ++j) { mv[j] = (f32x4){bf_lo(MVR[j].x), bf_hi(MVR[j].x), bf_lo(MVR[j].y), bf_hi(MVR[j].y)}; xv[j] = XVR[j]; \
                ss += (mv[j].x * mv[j].x + mv[j].y * mv[j].y) + (mv[j].z * mv[j].z + mv[j].w * mv[j].w); } \
            const float r1 = 1.f / sqrtf(wave_sum(ss) * (1.f / DM) + RMS_EPS); float s2 = 0.f; \
            _Pragma("unroll") for (int j = 0; j < 4; ++j) { const int k = 4 * lane + 256 * j; const f32x4 g = *(LAS f32x4*)(v_g1 + k); xv[j] = xv[j] + g * (mv[j] * r1); \
                s2 += (xv[j].x * xv[j].x + xv[j].y * xv[j].y) + (xv[j].z * xv[j].z + xv[j].w * xv[j].w); } \
            const float r2 = 1.f / sqrtf(wave_sum(s2) * (1.f / DM) + RMS_EPS); \
            _Pragma("unroll") for (int j = 0; j < 4; ++j) { const int k = 4 * lane + 256 * j; const f32x4 g = *(LAS f32x4*)(v_g2 + k), s = *(LAS f32x4*)(v_s2 + k); xv[j] = xv[j] * r2 * g + s; \
                v2u o; o.x = pk2(xv[j].x, xv[j].y); o.y = pk2(xv[j].z, xv[j].w); *(v2u*)(H2 + (size_t)(ROW) * 1024 + k) = o; \
                { int f8_ = __builtin_amdgcn_cvt_pk_fp8_f32(xv[j].x, xv[j].y, 0, false); f8_ = __builtin_amdgcn_cvt_pk_fp8_f32(xv[j].z, xv[j].w, f8_, true); *(int*)(H2F8 + (size_t)(ROW) * 1024 + k) = f8_; } \
                v2u ol; ol.x = pk2(xv[j].x - bf_lo(o.x), xv[j].y - bf_hi(o.x)); ol.y = pk2(xv[j].z - bf_lo(o.y), xv[j].w - bf_hi(o.y)); *(v2u*)(H2L + (size_t)(ROW) * 1024 + k) = ol; } } while (0)
        { v2u mA[4], mB[4]; f32x4 xA[4], xB[4];
          P6_LOAD(mA, xA, wrow0);
          for (int i = 0; i < 16; i += 2) {
              P6_LOAD(mB, xB, wrow0 + 8 * (i + 1));
              P6_ROW(mA, xA, wrow0 + 8 * i);
              if (i + 2 < 16) P6_LOAD(mA, xA, wrow0 + 8 * (i + 2));
              P6_ROW(mB, xB, wrow0 + 8 * (i + 1));
          } }
#undef P6_LOAD
#undef P6_ROW
        P6STAMP(0);
        asm volatile("s_waitcnt vmcnt(0)" ::: "memory");
        P6STAMP(1);
        f32x4 acc0 = {0.f, 0.f, 0.f, 0.f}, acc1 = {0.f, 0.f, 0.f, 0.f};
        { const int q = lane >> 4, t16 = lane & 15;
          const bf16* bh_p = H2 + (size_t)(wrow0 + 8 * t16) * 1024 + 8 * q; const bf16* bl_p = H2L + (size_t)(wrow0 + 8 * t16) * 1024 + 8 * q;
          LAS const unsigned char* ah_p = wr_lds + t16 * 2064 + 16 * q; LAS const unsigned char* al_p = ah_p + 66048;
#pragma unroll 8
          for (int kk = 0; kk < 32; ++kk) {
              const bf16x8 bh = __builtin_nontemporal_load((const bf16x8*)(bh_p + 32 * kk)), bl = __builtin_nontemporal_load((const bf16x8*)(bl_p + 32 * kk));
              const bf16x8 ah0 = *(LAS const bf16x8*)(ah_p + 64 * kk), al0 = *(LAS const bf16x8*)(al_p + 64 * kk), ah1 = *(LAS const bf16x8*)(ah_p + 16 * 2064 + 64 * kk), al1 = *(LAS const bf16x8*)(al_p + 16 * 2064 + 64 * kk);
              acc0 = __builtin_amdgcn_mfma_f32_16x16x32_bf16(ah0, bh, acc0, 0, 0, 0); acc0 = __builtin_amdgcn_mfma_f32_16x16x32_bf16(al0, bh, acc0, 0, 0, 0); acc0 = __builtin_amdgcn_mfma_f32_16x16x32_bf16(ah0, bl, acc0, 0, 0, 0);
              acc1 = __builtin_amdgcn_mfma_f32_16x16x32_bf16(ah1, bh, acc1, 0, 0, 0); acc1 = __builtin_amdgcn_mfma_f32_16x16x32_bf16(al1, bh, acc1, 0, 0, 0); acc1 = __builtin_amdgcn_mfma_f32_16x16x32_bf16(ah1, bl, acc1, 0, 0, 0);
          }
          P6STAMP(2);
          float cv[8]; int ci[8];
#pragma unroll
          for (int r = 0; r < 4; ++r) { ci[r] = 4 * q + r; cv[r] = acc0[r] + b_router[4 * q + r]; ci[4 + r] = 16 + 4 * q + r; cv[4 + r] = acc1[r] + b_router[16 + 4 * q + r]; }
          float tv[4]; int te[4];
          top4_of8(cv, ci, tv, te);
#pragma unroll
          for (int st = 16; st <= 32; st <<= 1) {
#pragma unroll
              for (int k = 0; k < 4; ++k) { cv[k] = tv[k]; ci[k] = te[k]; cv[4 + k] = __shfl_xor(tv[k], st); ci[4 + k] = __shfl_xor(te[k], st); }
              top4_of8(cv, ci, tv, te);
          }
          const float e1 = __expf(tv[1] - tv[0]), e2 = __expf(tv[2] - tv[0]), e3 = __expf(tv[3] - tv[0]), inv = 1.f / (1.f + e1 + e2 + e3);
          if (lane < 16) { const int row = wrow0 + 8 * lane, rl = X.wave + 8 * lane;
              *(int4*)(TOPE + (size_t)row * 4) = make_int4(te[0], te[1], te[2], te[3]); *(f32x4*)(TOPW + (size_t)row * 4) = (f32x4){inv, e1 * inv, e2 * inv, e3 * inv};
              e_of[rl * 4 + 0] = te[0]; e_of[rl * 4 + 1] = te[1]; e_of[rl * 4 + 2] = te[2]; e_of[rl * 4 + 3] = te[3]; }
        }
        P6STAMP(3);
        __syncthreads();
        const int e = e_of[X.tid]; const int lr = __hip_atomic_fetch_add(&lcnt[e], 1, __ATOMIC_RELAXED, __HIP_MEMORY_SCOPE_WORKGROUP);
        __syncthreads();
        if (X.tid < 32) lbase[X.tid] = (int)__hip_atomic_fetch_add(ctl + CW_ECNT + 64 * X.tid, (unsigned)lcnt[X.tid], __ATOMIC_RELAXED, __HIP_MEMORY_SCOPE_AGENT);
        __syncthreads();
        { const int rank = lbase[e] + lr, id = (row0 + (X.tid >> 2)) * 4 + (X.tid & 3); RANK[id] = rank; TOKOF[(size_t)e * NTOK + rank] = id; }
        P6STAMP(4);
    }
}

__device__ __forceinline__ void phase10(const Args& A, const Ctx& X) {
    const float* x = A.in[0]; const float* gpost = A.in[5]; const float* gpost2 = A.in[17];
    const float* ADA = (const float*)(X.ws + WS_ADA); const bf16* MIXED = (const bf16*)(X.ws + WS_MIXED);
    const float* TOPW = (const float*)(X.ws + WS_TOPW);
    LAS float* v_g1 = (LAS float*)X.lds; LAS float* v_g3 = v_g1 + 1024;
    const int lane = X.lane;
    for (int ch = blockIdx.x; ch < NTOK / 128; ch += X.G) {
        const int row0 = ch * 128, b = row0 / SEQ;
        __syncthreads();
        for (int j = X.tid; j < 1024; j += 512) { v_g1[j] = ADA[b * 6144 + 2048 + j] * gpost[j]; v_g3[j] = ADA[b * 6144 + 5120 + j] * gpost2[j]; }
        __syncthreads();
#define P10_LOAD(TW, MV, XV, YV, ROW) do { TW = *(const f32x4*)(TOPW + (size_t)(ROW) * 4); \
            const bf16* y0_ = (const bf16*)((const unsigned char*)X.out + (size_t)(ROW) * 4096); const bf16* y2_ = (const bf16*)(X.ws + WS_YSHI + (size_t)(ROW) * 4096); \
            _Pragma("unroll") for (int j = 0; j < 4; ++j) { const int k = 4 * lane + 256 * j; MV[j] = __builtin_nontemporal_load((const v2u*)(MIXED + (size_t)(ROW) * 1024 + k)); XV[j] = __builtin_nontemporal_load((const f32x4*)(x + (size_t)(ROW) * 1024 + k)); \
                YV[0][j] = __builtin_nontemporal_load((const v2u*)(y0_ + k)); YV[1][j] = __builtin_nontemporal_load((const v2u*)(y0_ + 1024 + k)); YV[2][j] = __builtin_nontemporal_load((const v2u*)(y2_ + k)); YV[3][j] = __builtin_nontemporal_load((const v2u*)(y2_ + 1024 + k)); } } while (0)
#define UNP_(u) ((f32x4){bf_lo((u).x), bf_hi((u).x), bf_lo((u).y), bf_hi((u).y)})
#define P10_ROW(TW, MV, XV, YV, ROW) do { f32x4 mv[4], yv[4]; float ss = 0.f, sy = 0.f; \
            _Pragma("unroll") for (int j = 0; j < 4; ++j) { mv[j] = UNP_(MV[j]); yv[j] = UNP_(YV[0][j]) * TW.x + UNP_(YV[1][j]) * TW.y + UNP_(YV[2][j]) * TW.z + UNP_(YV[3][j]) * TW.w; \
                ss += (mv[j].x * mv[j].x + mv[j].y * mv[j].y) + (mv[j].z * mv[j].z + mv[j].w * mv[j].w); \
                sy += (yv[j].x * yv[j].x + yv[j].y * yv[j].y) + (yv[j].z * yv[j].z + yv[j].w * yv[j].w); } \
            const float r1 = 1.f / sqrtf(wave_sum(ss) * (1.f / DM) + RMS_EPS), r3 = 1.f / sqrtf(wave_sum(sy) * (1.f / DM) + RMS_EPS);     \
            _Pragma("unroll") for (int j = 0; j < 4; ++j) { const int k = 4 * lane + 256 * j; const f32x4 g1 = *(LAS f32x4*)(v_g1 + k), g3 = *(LAS f32x4*)(v_g3 + k); \
                *(f32x4*)(X.out + (size_t)(ROW) * 1024 + k) = XV[j] + g1 * (mv[j] * r1) + g3 * (yv[j] * r3); } } while (0)
        { f32x4 twA, twB, xA[4], xB[4]; v2u mA[4], mB[4], yA[4][4], yB[4][4]; const int wrow0 = row0 + X.wave;
          for (int i = 0; i < 16; ++i) { P10_LOAD(twA, mA, xA, yA, wrow0 + 8 * i); P10_ROW(twA, mA, xA, yA, wrow0 + 8 * i); }
          (void)twB; (void)mB; (void)xB; (void)yB; }
#undef P10_LOAD
#undef P10_ROW
#undef UNP_
    }
}

constexpr int KT = 9216;
constexpr int AL_K = 0, AL_V = 36864, AL_ZERO = 69632, AL_TBL = 70656, AL_SELM = 72704, AL_TB2 = 73216, AL_IMPW = 78336;
constexpr float SM_THR = 24.f;
typedef short v4i16_t __attribute__((ext_vector_type(4)));
__device__ __forceinline__ int crow(int r, int hi) { return (r & 3) + 8 * (r >> 2) + 4 * hi; }
__device__ __forceinline__ s16x4 vtr(LAS const unsigned char* p) { return __builtin_bit_cast(s16x4, __builtin_amdgcn_ds_read_tr16_b64_v4i16((LAS v4i16_t*)p)); }

constexpr int AL_TT = 78336;
constexpr int TB2_LEN = 320, TB2_NEG = 64;
constexpr int CVQ_TOTAL = 96 * 128;
struct SideJob { f32x4 V[8]; int q; int loaded; int qtr; int pend; };
#define SJ_STEP(sj, A, ws, NGW) do { int pn_ = 0; \
        if ((sj).loaded) { CVF_LDSW((sj).V, (sj).qtr); if ((sj).qtr == 3) { const float* s_; unsigned char* d_; exp_src_dst8(A, ws, (sj).q, s_, d_); CVF_OUT(d_); (sj).q += (NGW); pn_ += 8; } (sj).qtr = ((sj).qtr + 1) & 3; (sj).loaded = 0; } \
        if ((sj).q < CVQ_TOTAL) { const float* s_; unsigned char* d_; exp_src_dst8(A, ws, (sj).q, s_, d_); CVF_LOADQ((sj).V, s_, 1024, (sj).qtr); (sj).loaded = 1; pn_ += 8; } (sj).pend = pn_; } while (0)

__device__ __forceinline__ void qk_tile(f32x16& p0, f32x16& p1, const f32x16& c0, const f32x16& c1, LAS const unsigned char* Ks, const bf16x8 (&qr)[4], int r32, int hi) {
    LAS const unsigned char* kb = Ks + hi * 1024 + r32 * 16;
    bf16x8 kf[8];
#pragma unroll
    for (int d0 = 0; d0 < 4; ++d0) { kf[2 * d0] = *(LAS const bf16x8*)(kb + d0 * 2048); kf[2 * d0 + 1] = *(LAS const bf16x8*)(kb + d0 * 2048 + 512); }
    __builtin_amdgcn_sched_barrier(0);
    p0 = __builtin_amdgcn_mfma_f32_32x32x16_bf16(kf[0], qr[0], c0, 0, 0, 0); p1 = __builtin_amdgcn_mfma_f32_32x32x16_bf16(kf[1], qr[0], c1, 0, 0, 0);
#pragma unroll
    for (int d0 = 1; d0 < 4; ++d0) { p0 = __builtin_amdgcn_mfma_f32_32x32x16_bf16(kf[2 * d0], qr[d0], p0, 0, 0, 0); p1 = __builtin_amdgcn_mfma_f32_32x32x16_bf16(kf[2 * d0 + 1], qr[d0], p1, 0, 0, 0); }
}
template <bool MASKED = false>
__device__ __forceinline__ void pv_tile(f32x16 (&o)[2], const f32x16& p0, const f32x16& p1, LAS const unsigned char* Vs, int lane, int hi, unsigned keep = 0xffffffffu) {
    LAS const unsigned char* vb = Vs + ((lane >> 4) & 1) * 32 + (lane & 3) * 8 + (4 * hi + ((lane & 15) >> 2)) * 64;
    v4u pw[4];
    pw[0] = (v4u){pk2(p0[0], p0[1]), pk2(p0[2], p0[3]), pk2(p0[4], p0[5]), pk2(p0[6], p0[7])};
    pw[1] = (v4u){pk2(p0[8], p0[9]), pk2(p0[10], p0[11]), pk2(p0[12], p0[13]), pk2(p0[14], p0[15])};
    pw[2] = (v4u){pk2(p1[0], p1[1]), pk2(p1[2], p1[3]), pk2(p1[4], p1[5]), pk2(p1[6], p1[7])};
    pw[3] = (v4u){pk2(p1[8], p1[9]), pk2(p1[10], p1[11]), pk2(p1[12], p1[13]), pk2(p1[14], p1[15])};
    if (MASKED) {
#pragma unroll
        for (int k = 0; k < 4; ++k) pw[k] = pw[k] & keep; }
#pragma unroll
    for (int d0 = 0; d0 < 2; ++d0) {
        s16x4 vl[4], vh[4];
#pragma unroll
        for (int ks = 0; ks < 4; ++ks) { vl[ks] = vtr(vb + d0 * 4096 + ks * 1024); vh[ks] = vtr(vb + d0 * 4096 + ks * 1024 + 512); }
        __builtin_amdgcn_sched_barrier(0);
#pragma unroll
        for (int ks = 0; ks < 4; ++ks) {
            const bf16x8 vf = (bf16x8){vl[ks][0], vl[ks][1], vl[ks][2], vl[ks][3], vh[ks][0], vh[ks][1], vh[ks][2], vh[ks][3]};
            o[d0] = __builtin_amdgcn_mfma_f32_32x32x16_bf16(vf, __builtin_bit_cast(bf16x8, pw[ks]), o[d0], 0, 0, 0);
        }
    }
}
template <bool ADJ>
__device__ __forceinline__ void softmax_core(f32x16& p0, f32x16& p1, f32x16& q0, f32x16& q1, float& m, float& l, f32x16 (&o)[2], f32x16& negm, bool rowon = true) {
#define MX3_(a, b, c) __builtin_fmaxf(__builtin_fmaxf((a), (b)), (c))
    float ra = MX3_(p0[0], p0[1], p1[0]), rb = MX3_(p0[2], p0[3], p1[1]); ra = MX3_(ra, p1[2], p1[3]);
#pragma unroll
    for (int r = 4; r < 16; r += 4) { ra = MX3_(ra, p0[r], p0[r + 1]); rb = MX3_(rb, p0[r + 2], p0[r + 3]); ra = MX3_(ra, p1[r], p1[r + 1]); rb = MX3_(rb, p1[r + 2], p1[r + 3]); }
#undef MX3_
    float rm = __builtin_fmaxf(ra, rb);
    { auto rr = __builtin_amdgcn_permlane32_swap(__builtin_bit_cast(unsigned, rm), __builtin_bit_cast(unsigned, rm), false, false); rm = __builtin_fmaxf(__builtin_bit_cast(float, rr[0]), __builtin_bit_cast(float, rr[1])); }
    rm = rowon ? rm : NEGBIG;
    if (__any(rm > SM_THR)) {
        const float dl = fmaxf(rm, 0.f), alpha = __builtin_amdgcn_exp2f(-dl);
        m += dl; l *= alpha;
#pragma unroll
        for (int r = 0; r < 16; ++r) { p0[r] -= dl; p1[r] -= dl; o[0][r] *= alpha; o[1][r] *= alpha; negm[r] = -m; }
        if (ADJ) {
#pragma unroll
            for (int r = 0; r < 16; ++r) { q0[r] -= dl; q1[r] -= dl; } }
    }
    float s = 0.f;
#pragma unroll
    for (int r = 0; r < 16; ++r) { p0[r] = __builtin_amdgcn_exp2f(p0[r]); p1[r] = __builtin_amdgcn_exp2f(p1[r]); s += p0[r] + p1[r]; }
    l += rowon ? s : 0.f;
}

template <int MODE, int DRY = 0>
__device__ __forceinline__ void attn_branch(LAS unsigned char* L, int& buf, const bf16* __restrict__ Kg, const bf16* __restrict__ Vg, const bf16* __restrict__ KXg,
                                            int jlo, int jhi, const bf16x8 (&qr)[4], int tq, int tqmax, int hh, int qt, unsigned long long selm,
                                            float& m, float& l, f32x16 (&o)[2], float inv, int th, SideJob& sj, const Args& A, unsigned char* ws, int NGW) {
    const int tid = threadIdx.x, lane = tid & 63, wid = __builtin_amdgcn_readfirstlane(tid >> 6), r32 = lane & 31, hi = lane >> 5;
    LAS const float* TBL = (LAS const float*)(L + AL_TBL);
    int lo_ = lane; asm volatile("" : "+v"(lo_));
    const int koff = lo_ * 64 + wid * 8, voff = (16 * (wid & 3) + (lo_ >> 2)) * 64 + (wid >> 2) * 32 + (lo_ & 3) * 8;
#define ATT_GLOAD(t0_, bufn_) do { const int ta_ = (t0_), tb_ = ((t0_) + 1 <= jhi) ? (t0_) + 1 : (t0_); LAS unsigned char* kd_ = L + AL_K + (bufn_) * (2 * KT) + wid * 1024; LAS unsigned char* vd_ = L + AL_V + (bufn_) * 16384 + wid * 1024; \
        __builtin_amdgcn_global_load_lds((const unsigned*)(Kg + (size_t)ta_ * 4096 + koff), (LAS unsigned*)kd_, 16, 0, 0); __builtin_amdgcn_global_load_lds((const unsigned*)(Kg + (size_t)tb_ * 4096 + koff), (LAS unsigned*)(kd_ + KT), 16, 0, 0); \
        if (MODE != 4) { __builtin_amdgcn_global_load_lds((const unsigned*)(Vg + (size_t)ta_ * 4096 + voff), (LAS unsigned*)vd_, 16, 0, 0); __builtin_amdgcn_global_load_lds((const unsigned*)(Vg + (size_t)tb_ * 4096 + voff), (LAS unsigned*)(vd_ + 8192), 16, 0, 0); } \
        if (MODE == 0 && wid < 2) __builtin_amdgcn_global_load_lds((const unsigned*)(KXg + ((size_t)(wid ? tb_ : ta_) * 64 + lane) * 8), (LAS unsigned*)(L + AL_K + (bufn_) * (2 * KT) + wid * KT + 8192), 16, 0, 0); } while (0)
    if (DRY != 2) ATT_GLOAD(jlo, buf);
    if (MODE == 0) sj.pend = 0;
    f32x16 negm;
#pragma unroll
    for (int r = 0; r < 16; ++r) negm[r] = -m;
    const int cfar = (64 * qt >= 1167) ? ((64 * qt - 1167) >> 10) : -1;
    float carry = 0.f;
    for (int t0 = jlo; t0 <= jhi; t0 += 2) {
        LAS unsigned char* Ks = L + AL_K + buf * (2 * KT); LAS unsigned char* Vs = L + AL_V + buf * 16384;
        if (MODE == 0 && DRY == 0) { if (sj.pend == 0) asm volatile("s_waitcnt vmcnt(0)" ::: "memory"); else if (sj.pend == 8) asm volatile("s_waitcnt vmcnt(8)" ::: "memory"); else asm volatile("s_waitcnt vmcnt(16)" ::: "memory"); sj.pend = 0; }
        else asm volatile("s_waitcnt vmcnt(0)" ::: "memory");
        __syncthreads();
        if (DRY != 2 && t0 + 2 <= jhi) ATT_GLOAD(t0 + 2, buf ^ 1);
        if constexpr (MODE == 0) {
            if (DRY == 0 && (t0 & 3) == 0) { LAS bf16* TT = (LAS bf16*)(L + AL_TT + wid * 8192); SJ_STEP(sj, A, ws, NGW); }
        }
        if (DRY == 1 || (MODE == 0 && 64 * t0 > tqmax)) { buf ^= 1; continue; }
        f32x16 pa0, pa1, pb0, pb1;
        const bool mzero = (MODE != 0) && __all(m == 0.f);
#define ATT_QK(P0, P1, T, KOFF) do { \
            if (MODE == 0) { \
                { LAS const unsigned char* xa_ = hi ? (LAS const unsigned char*)(L + AL_ZERO + r32 * 16) : (LAS const unsigned char*)(Ks + (KOFF) + 8192 + r32 * 16);     \
                  const bf16x8 kx0_ = *(LAS const bf16x8*)xa_, kx1_ = *(LAS const bf16x8*)(xa_ + 512); int hv_ = hi; asm volatile("" : "+v"(hv_)); \
                  const v4u qxu_ = (v4u){hv_ ? 0u : 0x3F803F80u, hv_ ? 0u : 0x00003F80u, 0u, 0u}; const bf16x8 qx = __builtin_bit_cast(bf16x8, qxu_);     \
                  P0 = __builtin_amdgcn_mfma_f32_32x32x16_bf16(kx0_, qx, negm, 0, 0, 0); P1 = __builtin_amdgcn_mfma_f32_32x32x16_bf16(kx1_, qx, negm, 0, 0, 0); } \
                qk_tile(P0, P1, P0, P1, Ks + (KOFF), qr, r32, hi); } \
            else { const f32x16 z_ = {}; qk_tile(P0, P1, z_, z_, Ks + (KOFF), qr, r32, hi); \
                if (!mzero) { _Pragma("unroll") for (int r_ = 0; r_ < 16; ++r_) { P0[r_] -= m; P1[r_] -= m; } } } } while (0)
        ATT_QK(pa0, pa1, t0, 0);
        __builtin_amdgcn_sched_barrier(0);
        ATT_QK(pb0, pb1, t0 + 1, KT);
        __builtin_amdgcn_sched_barrier(0);
#define ATT_POST(P0, P1, T) do { const int key0_ = 64 * (T); \
            if (MODE == 0) { if (key0_ + 63 > tqmax - 31) { int d0_ = tq - key0_ - 4 * hi; asm volatile("" : "+v"(d0_)); \
                    _Pragma("unroll") for (int r_ = 0; r_ < 16; ++r_) { const int C_ = (r_ & 3) + 8 * (r_ >> 2); if (C_ > d0_) P0[r_] = NEGBIG; if (C_ + 32 > d0_) P1[r_] = NEGBIG; } } } \
            else { const bool general_ = (MODE == 1 || MODE == 4) ? ((T) > cfar) : (MODE == 2 ? ((T) >= qt - 2) : ((T) >= qt - 2 || (T) <= qt - 8)); \
                if (general_) { \
                    if (MODE == 3 && (T) <= qt - 8) {                            \
                        int d0_ = tq - key0_ - 4 * hi - 512; asm volatile("" : "+v"(d0_)); \
                        _Pragma("unroll") for (int r_ = 0; r_ < 16; ++r_) { const int C_ = (r_ & 3) + 8 * (r_ >> 2); if (C_ <= d0_) P0[r_] = NEGBIG; if (C_ + 32 <= d0_) P1[r_] = NEGBIG; } \
                    } else if (MODE == 2 || MODE == 3) { \
                          \
                        LAS const float* tb_ = (LAS const float*)(L + AL_TB2) + hh * TB2_LEN + (tq - key0_ - 4 * hi + TB2_NEG - 59); \
                        _Pragma("unroll") for (int r_ = 0; r_ < 16; ++r_) { P0[r_] += tb_[59 - ((r_ & 3) + 8 * (r_ >> 2))]; P1[r_] += tb_[59 - ((r_ & 3) + 8 * (r_ >> 2) + 32)]; if ((r_ & 1) == 1) __builtin_amdgcn_sched_barrier(0); } \
                    } else { \
                    int d0_ = tq - 31 - 16 * key0_ - 64 * hi; asm volatile("" : "+v"(d0_)); \
                    _Pragma("unroll") for (int r_ = 0; r_ < 16; ++r_) { _Pragma("unroll") for (int hb_ = 0; hb_ < 2; ++hb_) { \
                            const int dist_ = d0_ - 16 * ((r_ & 3) + 8 * (r_ >> 2) + 32 * hb_); \
                            const bool valid_ = dist_ >= 0; \
                            const float bias_ = TBL[min(max(dist_, 0), 127) * 4 + hh]; \
                            if (hb_) P1[r_] = valid_ ? P1[r_] + bias_ : NEGBIG; else P0[r_] = valid_ ? P0[r_] + bias_ : NEGBIG; } \
                        if ((r_ & 3) == 3) __builtin_amdgcn_sched_barrier(0); } } } } } while (0)
#define ATT_IMP(P0, P1, T) do { float S0_[4], S1_[4], s0_[4], s1_[4]; \
            if (MODE == 4) { _Pragma("unroll") for (int r_ = 0; r_ < 16; ++r_) { P0[r_] = __builtin_amdgcn_exp2f(P0[r_]) * inv; P1[r_] = __builtin_amdgcn_exp2f(P1[r_]) * inv; } } \
            _Pragma("unroll") for (int a_ = 0; a_ < 4; ++a_) { S0_[a_] = (P0[4 * a_] + P0[4 * a_ + 1]) + (P0[4 * a_ + 2] + P0[4 * a_ + 3]); S1_[a_] = (P1[4 * a_] + P1[4 * a_ + 1]) + (P1[4 * a_ + 2] + P1[4 * a_ + 3]); } \
            if (hi == 0) { _Pragma("unroll") for (int a_ = 0; a_ < 4; ++a_) { s0_[a_] = P0[4 * a_ + 3]; s1_[a_] = P1[4 * a_ + 3]; } } \
            else { s0_[0] = carry; s0_[1] = P0[3]; s0_[2] = P0[7]; s0_[3] = P0[11]; s1_[0] = P0[15]; s1_[1] = P1[3]; s1_[2] = P1[7]; s1_[3] = P1[11]; carry = P1[15]; } \
            LAS float* IW_ = (LAS float*)(L + AL_IMPW) + ((hh * 64) + (32 * th + r32)) * 64 + 16 * (T) + hi; \
            _Pragma("unroll") for (int a_ = 0; a_ < 4; ++a_) { IW_[2 * a_] = S0_[a_] + __shfl_xor(s0_[a_], 32); IW_[8 + 2 * a_] = S1_[a_] + __shfl_xor(s1_[a_], 32); } } while (0)
        {
            ATT_POST(pa0, pa1, t0);
            __builtin_amdgcn_sched_barrier(0);
            if (MODE != 4) { const bool on_ = (MODE == 2) ? (((selm >> t0) & 1ull) != 0ull) : true;
                softmax_core<true>(pa0, pa1, pb0, pb1, m, l, o, negm, on_);
                if (MODE == 1) ATT_IMP(pa0, pa1, t0);
                __builtin_amdgcn_sched_barrier(0);
                if (MODE == 2) pv_tile<true>(o, pa0, pa1, Vs, lane, hi, on_ ? 0xffffffffu : 0u); else pv_tile(o, pa0, pa1, Vs, lane, hi); }
            else ATT_IMP(pa0, pa1, t0);
        }
        __builtin_amdgcn_sched_barrier(0);
        {
            ATT_POST(pb0, pb1, t0 + 1);
            if (MODE != 0 && t0 + 1 > jhi) {
#pragma unroll
                for (int r = 0; r < 16; ++r) { pb0[r] = NEGBIG; pb1[r] = NEGBIG; } }
            __builtin_amdgcn_sched_barrier(0);
            if (MODE != 4) { const bool on_ = (MODE == 2) ? (((selm >> (t0 + 1)) & 1ull) != 0ull) : true;
                softmax_core<false>(pb0, pb1, pb0, pb1, m, l, o, negm, on_);
                if (MODE == 1 && t0 + 1 <= jhi) ATT_IMP(pb0, pb1, t0 + 1);
                __builtin_amdgcn_sched_barrier(0);
                if (MODE == 2) pv_tile<true>(o, pb0, pb1, Vs + 8192, lane, hi, on_ ? 0xffffffffu : 0u); else pv_tile(o, pb0, pb1, Vs + 8192, lane, hi); }
            else if (t0 + 1 <= jhi) ATT_IMP(pb0, pb1, t0 + 1);
        }
        buf ^= 1;
    }
#undef ATT_GLOAD
#undef ATT_QK
#undef ATT_POST
#undef ATT_IMP
}

__device__ __forceinline__ void store_ot(bf16* dst  , const f32x16 (&o)[2], float scale, int hi) {
    asm volatile("" : "+v"(hi));
#pragma unroll
    for (int d0 = 0; d0 < 2; ++d0)
#pragma unroll
        for (int a = 0; a < 4; ++a) { v2u w; w.x = pk2(o[d0][4 * a] * scale, o[d0][4 * a + 1] * scale); w.y = pk2(o[d0][4 * a + 2] * scale, o[d0][4 * a + 3] * scale);
            *(v2u*)(dst + 32 * d0 + 8 * a + 4 * hi) = w; }
}

template <int DRY = 0>
__device__ __forceinline__ void fox_unit(const Args& A, const Ctx& X, int bh, int qb, int& buf, SideJob& sj) {
    const int lane = X.lane, wid = X.wave, r32 = lane & 31, hi = lane >> 5;
    const int tq = 256 * qb + 32 * wid + r32, tqmax = 256 * qb + 32 * wid + 31;
    const bf16* Q = (const bf16*)(X.ws + WS_FQ) + ((size_t)bh * SEQ + tq) * 64;
    bf16x8 qr[4];
#pragma unroll
    for (int d0 = 0; d0 < 4; ++d0) qr[d0] = *(const bf16x8*)(Q + d0 * 16 + hi * 8);
    float m = ((const float*)(X.ws + WS_KBIAS))[(size_t)bh * SEQ + tq], l = 0.f; f32x16 o[2]; o[0] = (f32x16){}; o[1] = (f32x16){};
    attn_branch<0, DRY>(X.lds, buf, (const bf16*)(X.ws + WS_FK) + (size_t)bh * SEQ * 64, (const bf16*)(X.ws + WS_FV) + (size_t)bh * SEQ * 64, (const bf16*)(X.ws + WS_KX) + (size_t)bh * SEQ * 8,
                   0, 4 * qb + 3, qr, tq, tqmax, 0, 0, 0ull, m, l, o, 0.f, 0, sj, A, X.ws, X.G * 8);
    const float lt = l + __shfl_xor(l, 32);
    const int b = bh >> 3, h = bh & 7;
    if (DRY == 0) store_ot((bf16*)((unsigned char*)X.out + OUT_OFOX) + ((size_t)b * SEQ + tq) * 512 + h * 64, o, 1.f / lt, hi);
    else asm volatile("" :: "v"(o[0]), "v"(o[1]), "v"(lt));
}

__device__ __forceinline__ void nsa_unit(const Args& A, const Ctx& X, int bg, int qt, int& buf, SideJob& sj, int& gprev) {
    const int tid = X.tid, lane = X.lane, wid = X.wave, r32 = lane & 31, hi = lane >> 5, hh = wid >> 1, th = wid & 1;
    const int b = bg >> 1, g = bg & 1, head = 4 * g + hh;
    const int tok = 32 * th + r32, tq = 64 * qt + tok, tqmax = 64 * qt + 32 * th + 31;
#ifdef PROBE_SUB
#define NSTAMP(k) do { if (blockIdx.x == 0 && X.tid == 0) { const unsigned t_ = (unsigned)__builtin_amdgcn_s_memrealtime(); ((volatile LAS unsigned*)(X.lds + MISC_OFF))[40 + (k)] += t_ - tprev_; tprev_ = t_; } } while (0)
    unsigned tprev_ = (unsigned)__builtin_amdgcn_s_memrealtime();
#else
#define NSTAMP(k) do { } while (0)
#endif
    LAS unsigned char* L = X.lds;
    __syncthreads();
    int tidv = tid; asm volatile("" : "+v"(tidv));
    if (g != gprev) {
    gprev = g;
    { const float* rel = A.in[15]; LAS float* TBL = (LAS float*)(L + AL_TBL); const int d = tidv >> 2, q = tidv & 3; TBL[tidv] = (rel[T5_BUCKET[d] * 8 + 4 * g + q] - rel[31 * 8 + 4 * g + q]) * LOG2E; }
    { const float* rel = A.in[15]; LAS float* TB2 = (LAS float*)(L + AL_TB2);
#pragma unroll 1
      for (int q = 0; q < 4; ++q) {
#pragma unroll 1
          for (int di = tidv; di < TB2_LEN; di += 512) { const int d = di - TB2_NEG, dc = d < 0 ? 0 : (d > 127 ? 127 : d);
              const float v = (rel[T5_BUCKET[dc] * 8 + 4 * g + q] - rel[31 * 8 + 4 * g + q]) * LOG2E;
              TB2[q * TB2_LEN + di] = (d < 0) ? NEGBIG : (d < 128 ? v : 0.f); } } }
    }
    { LAS v4u* z = (LAS v4u*)(L + AL_IMPW);
#pragma unroll
      for (int i = 0; i < 8; ++i) z[tidv + 512 * i] = (v4u){0u, 0u, 0u, 0u};
      if (tidv == 0) *(LAS int*)(L + ROWTAB_OFF + 1024) = 0; }
    const bf16* Q = (const bf16*)(X.ws + WS_NQ) + ((size_t)(b * 8 + head) * SEQ + tq) * 64;
    bf16x8 qr[4];
#pragma unroll
    for (int d0 = 0; d0 < 4; ++d0) qr[d0] = *(const bf16x8*)(Q + d0 * 16 + hi * 8);
    const float* gp = (const float*)(X.ws + WS_GATES) + ((size_t)b * SEQ + tq) * 24 + head * 3;
    const float g_cmp = gp[0], g_slc = gp[1], g_win = gp[2];
    __syncthreads();
    NSTAMP(0);
    const bf16* KV6 = (const bf16*)(X.ws + WS_KV6);
    const bf16* KC = (const bf16*)(X.ws + WS_KC) + (size_t)bg * 256 * 64; const bf16* VC = (const bf16*)(X.ws + WS_VC) + (size_t)bg * 256 * 64;
    const int nct = (4 * qt + 2) / 64;
    float m = 0.f, l = 0.f; f32x16 o[2]; o[0] = (f32x16){}; o[1] = (f32x16){};
#ifndef NSA_NO1
    attn_branch<1>(L, buf, KC, VC, nullptr, 0, nct, qr, tq, tqmax, hh, qt, 0ull, m, l, o, 0.f, th, sj, A, X.ws, 0);
#endif
    float lt = l + __shfl_xor(l, 32);
    const float inv_c = (tq >= 31 && lt > 0.f) ? 1.f / lt : 0.f;
    { const float sc = g_cmp * inv_c;
#pragma unroll
      for (int r = 0; r < 16; ++r) { o[0][r] *= sc; o[1][r] *= sc; } }
    LAS float* INVL = (LAS float*)(L + ROWTAB_OFF); LAS int* BUMP = (LAS int*)(L + ROWTAB_OFF + 1024);
    if (hi == 0) INVL[hh * 64 + tok] = inv_c;
    if (!__all(m == 0.f) && lane == 0) BUMP[0] = 1;
    __syncthreads();
#ifndef NSA_NO4
    if (BUMP[0] != 0) {
        { float m2 = m, l2 = 0.f; f32x16 od[2]; attn_branch<4>(L, buf, KC, VC, nullptr, 0, nct, qr, tq, tqmax, hh, qt, 0ull, m2, l2, od, inv_c, th, sj, A, X.ws, 0); }
        if (hi == 0) INVL[hh * 64 + tok] = 1.f;
        __syncthreads();
    }
#endif
    NSTAMP(1);
    {
        LAS const float* IW = (LAS const float*)(L + AL_IMPW); LAS unsigned long long* SELM = (LAS unsigned long long*)(L + AL_SELM);
        if (qt < 16) {
            if (lane < 8) SELM[8 * wid + lane] = (2ull << qt) - 1ull;
        } else {
        for (int ii = 0; ii < 8; ++ii) {
            const int tk = 8 * wid + ii, j = lane;
            const float imp = ((IW[(0 * 64 + tk) * 64 + j] * INVL[tk] + IW[(1 * 64 + tk) * 64 + j] * INVL[64 + tk]) + IW[(2 * 64 + tk) * 64 + j] * INVL[128 + tk]) + IW[(3 * 64 + tk) * 64 + j] * INVL[192 + tk];
            const bool forced = (j == 0) || (j == qt) || (j == qt - 1), svalid = (j <= qt);
            const float score = forced ? 1e9f : (svalid ? imp : -1e9f);
            const unsigned bits = __builtin_bit_cast(unsigned, score), u = (bits & 0x80000000u) ? ~bits : (bits | 0x80000000u);
            unsigned T = 0u;
#pragma unroll 8
            for (int bsel = 31; bsel >= 0; --bsel) { const unsigned Tc = T | (1u << bsel); if (__builtin_popcountll(__ballot(u >= Tc)) >= 16) T = Tc; }
            const unsigned long long gt = __ballot(u > T), eq = __ballot(u == T);
            const int need = 16 - __builtin_popcountll(gt);
            const int below = __builtin_amdgcn_mbcnt_hi((unsigned)(eq >> 32), __builtin_amdgcn_mbcnt_lo((unsigned)eq, 0u));
            const unsigned long long msk = gt | __ballot(u == T && below < need);
            if (lane == 0) SELM[tk] = msk;
        }
        }
    }
    __syncthreads();
    NSTAMP(2);
    const unsigned long long selm = ((LAS const unsigned long long*)(L + AL_SELM))[tok];
    int tidw = tid; asm volatile("" : "+v"(tidw));
    LAS float* ACC = (LAS float*)(L + AL_IMPW) + tidw;
#pragma unroll
    for (int r = 0; r < 16; ++r) { ACC[r * 512] = o[0][r]; ACC[(16 + r) * 512] = o[1][r]; }
    m = 0.f; l = 0.f; o[0] = (f32x16){}; o[1] = (f32x16){};
#ifndef NSA_NO2
    attn_branch<2>(L, buf, KV6 + 2 * KV6_STRIDE + (size_t)bg * SEQ * 64, KV6 + 3 * KV6_STRIDE + (size_t)bg * SEQ * 64, nullptr, 0, qt, qr, tq, tqmax, hh, qt, selm, m, l, o, 0.f, th, sj, A, X.ws, 0);
#endif
    lt = l + __shfl_xor(l, 32);
    { const float sc = g_slc / lt;
#pragma unroll
      for (int r = 0; r < 16; ++r) { ACC[r * 512] += o[0][r] * sc; ACC[(16 + r) * 512] += o[1][r] * sc; } }
    NSTAMP(3);
    m = 0.f; l = 0.f; o[0] = (f32x16){}; o[1] = (f32x16){};
#ifndef NSA_NO3
    attn_branch<3>(L, buf, KV6 + 4 * KV6_STRIDE + (size_t)bg * SEQ * 64, KV6 + 5 * KV6_STRIDE + (size_t)bg * SEQ * 64, nullptr, qt > 8 ? qt - 8 : 0, qt, qr, tq, tqmax, hh, qt, 0ull, m, l, o, 0.f, th, sj, A, X.ws, 0);
#endif
    lt = l + __shfl_xor(l, 32);
    { const float sc = g_win / lt;
#pragma unroll
      for (int r = 0; r < 16; ++r) { o[0][r] = ACC[r * 512] + o[0][r] * sc; o[1][r] = ACC[(16 + r) * 512] + o[1][r] * sc; } }
    NSTAMP(4);
    store_ot((bf16*)((unsigned char*)X.out + OUT_ONSA) + ((size_t)b * SEQ + tq) * 512 + head * 64, o, 1.f, hi);
}

__device__ __forceinline__ void phase3(const Args& A, const Ctx& X) {
    int buf = 0;
    if (X.tid < 64) ((LAS v4u*)(X.lds + AL_ZERO))[X.tid] = (v4u){0u, 0u, 0u, 0u};
    __syncthreads();
    SideJob sj; sj.q = X.vcu * 8 + X.wave; sj.loaded = 0; sj.qtr = 0; sj.pend = 0;
#ifdef PROBE_SUB
    unsigned tp3_ = (unsigned)__builtin_amdgcn_s_memrealtime();
#define P3STAMP(k) do { if (blockIdx.x == 0 && X.tid == 0) { const unsigned t_ = (unsigned)__builtin_amdgcn_s_memrealtime(); ((volatile LAS unsigned*)(X.lds + MISC_OFF))[40 + (k)] += t_ - tp3_; tp3_ = t_; } } while (0)
#else
#define P3STAMP(k) do { } while (0)
#endif
#ifndef NO_FOX
#ifdef FOX_DRY
    for (int u = X.vcu; u < 1024; u += X.G) { const int rd = u >> 8, v = u & 255, bh = v >> 2, s = v & 3; const int qb = (rd == 0) ? s : (rd == 1) ? 7 - s : (rd == 2) ? 8 + s : 15 - s;
        fox_unit<FOX_DRY>(A, X, bh, qb, buf, sj); }
    __syncthreads();
#endif
    REP(16) for (int u = X.vcu; u < 1024; u += X.G) { const int rd = u >> 8, v = u & 255, bh = v >> 2, s = v & 3; const int qb = (rd == 0) ? s : (rd == 1) ? 7 - s : (rd == 2) ? 8 + s : 15 - s;
        fox_unit(A, X, bh, qb, buf, sj); }
#endif
    P3STAMP(5);
    {
        const int lane = X.lane, NGW = X.G * 8; LAS bf16* TT = (LAS bf16*)(X.lds + AL_TT + X.wave * 8192);
        while (sj.loaded || sj.q < CVQ_TOTAL) { SJ_STEP(sj, A, X.ws, NGW); }
    }
    P3STAMP(6);
#ifndef NO_NSA
    int gprev = -1;
    {
        LAS int* QW = (LAS int*)(X.lds + ROWTAB_OFF + 1028); unsigned* qctr = (unsigned*)(X.ws + WS_CTL) + CW_NSAQ;
        for (;;) {
            __syncthreads();
            if (X.tid == 0) QW[0] = (int)__hip_atomic_fetch_add(qctr, 1u, __ATOMIC_RELAXED, __HIP_MEMORY_SCOPE_AGENT);
            __syncthreads();
            const int q = QW[0];
            if (q >= 1024) break;
            nsa_unit(A, X, q & 15, 63 - (q >> 4), buf, sj, gprev);
        }
    }
#endif
}

#ifndef MK_N_LAUNCHES
#define MK_N_LAUNCHES 1
#endif
constexpr int N_PHASES = 11;
static_assert(AL_IMPW + 65536 <= MISC_OFF && AL_TT + 8 * 8192 <= MISC_OFF && AL_TB2 + 4 * TB2_LEN * 4 <= AL_IMPW && RING_BYTES <= MISC_OFF && ROWTAB_OFF + 18 * 1024 <= LDS_BYTES && TAB_OFF + 100 * 4 <= ROWTAB_OFF, "LDS map");

__global__ void __launch_bounds__(512, 2) fwd(Args args) {
    extern __shared__ __attribute__((aligned(16))) unsigned char lds_raw[];
    Ctx X;
    X.out = args.out; X.ws = args.ws;
    X.lds = (LAS unsigned char*)lds_raw;
    X.tid = threadIdx.x; X.lane = X.tid & 63; X.wave = __builtin_amdgcn_readfirstlane(X.tid >> 6);
    X.G = gridDim.x; { const int bx = blockIdx.x; X.vcu = (X.G % 8 == 0) ? (bx % 8) * (X.G / 8) + bx / 8 : bx; }
    volatile LAS unsigned* MISC = (volatile LAS unsigned*)(X.lds + MISC_OFF);
    if (X.tid < 64) MISC[X.tid] = 0u;
    __syncthreads();
    const int lo = args.ph_lo, hi = args.ph_hi;
    unsigned* ctl = (unsigned*)(X.ws + WS_CTL);
    XcdBarrier bar; bar.bar = ctl + CW_BAR; bar.x = 0; bar.st = MISC + 8;
    if (hi - lo > 1) bar = xcd_barrier_post(ctl + CW_BAR, MISC + 8);
#ifndef PHMASK
#define PHMASK 0x7ff
#endif
#define IN(k) ((((PHMASK) >> (k)) & 1) && lo <= (k) && (k) < hi)
#ifndef PROBE_PHASE
#define PROBE_PHASE -1
#endif
#define STAMP(i) do { if (PROBE_PHASE >= 0 && blockIdx.x == 0 && X.tid == 0) { const unsigned long long t_ = __builtin_amdgcn_s_memrealtime(); MISC[16 + 2 * (i)] = (unsigned)t_; MISC[17 + 2 * (i)] = (unsigned)(t_ >> 32); } } while (0)
#define SEAM(k) do { if (IN(k) && IN((k) + 1)) xcd_barrier(bar); STAMP((k) + 1); } while (0)
    unsigned char* ws = X.ws;
    const int bid = (int)blockIdx.x;

    STAMP(0);
    if (IN(0)) { REP(0) phase0a(args, X); SEAM(0); }
    if (IN(1)) { REP(1) phase0b(args, X); SEAM(1); }
    if (IN(2)) {
        pg8::Gemm g{(const bf16*)((unsigned char*)X.out + OUT_H), (const bf16*)(ws + WS_WIN), 1024};
        pg8::StaticOrder S; S.init(NTOK, NPROJ, X.G, bid, 1024);
        EpiInProj E{ws, args.in[7]};
        pg8::gemm_phase<EpiInProj, pg8::StaticOrder>(X.lds, g, S, E);
        if constexpr (((DUP_MASK) >> 2) & 1) pg8::gemm_phase<EpiInProj, pg8::StaticOrder>(X.lds, g, S, E);
        SEAM(2);
    }
    if (IN(3)) { REP(3) phase2(args, X); SEAM(3); }
#ifdef PROBE_BLK
    unsigned tb4_ = (unsigned)__builtin_amdgcn_s_memrealtime();
#endif
    if (IN(4)) { REP(4) phase3(args, X);
#ifdef PROBE_BLK
        if (blockIdx.x == PROBE_BLK && X.tid == 0) { ((volatile unsigned*)(X.ws + WS_CTL))[8] = (unsigned)__builtin_amdgcn_s_memrealtime() - tb4_; }
#endif
        SEAM(4); }
    if (IN(5)) {
        pg8::StaticOrder S; S.init(NTOK, 1024, X.G, bid, 512);
        {
        { pg8::Gemm g{(const bf16*)((unsigned char*)X.out + OUT_OFOX), (const bf16*)(ws + WS_WFOX), 512};
          EpiGate<false> E{(bf16*)(ws + WS_GATED), (const bf16*)(ws + WS_SGF)};
          pg8::gemm_phase<EpiGate<false>, pg8::StaticOrder>(X.lds, g, S, E); }
        { pg8::Gemm g{(const bf16*)((unsigned char*)X.out + OUT_ONSA), (const bf16*)(ws + WS_WNSA), 512};
          EpiGate<true> E{(bf16*)(ws + WS_GATED), (const bf16*)(ws + WS_SGN)};
          pg8::gemm_phase<EpiGate<true>, pg8::StaticOrder>(X.lds, g, S, E); }
        }
        SEAM(5);
    }
    if (IN(6)) {
        pg8::Gemm g{(const bf16*)(ws + WS_GATED), (const bf16*)(ws + WS_WMIX), 1024};
        pg8::StaticOrder S; S.init(NTOK, 1024, X.G, bid, 1024);
        EpiPlain E{(bf16*)(ws + WS_MIXED), 1024};
        pg8::gemm_phase<EpiPlain, pg8::StaticOrder>(X.lds, g, S, E);
        if constexpr (((DUP_MASK) >> 6) & 1) pg8::gemm_phase<EpiPlain, pg8::StaticOrder>(X.lds, g, S, E);
        SEAM(6);
    }
#ifdef PROBE_BLK7
    unsigned tb7_ = (unsigned)__builtin_amdgcn_s_memrealtime();
#endif
    if (IN(7)) { phase6(args, X);
#ifdef PROBE_BLK7
        if (blockIdx.x == PROBE_BLK7 && X.tid == 0) { ((volatile unsigned*)(X.ws + WS_CTL))[8] = (unsigned)__builtin_amdgcn_s_memrealtime() - tb7_; }
#endif
        SEAM(7); }
    if (IN(8)) {
        moe_tables(args, X);
        LAS const int* tab = (LAS const int*)(X.lds + TAB_OFF);
        MoeOrder S{X.G, bid, 8, 0, tab, (LAS const int*)(X.lds + ROWTAB_OFF)};
        moe_rowtab(X, S, (const int*)(ws + WS_TOKOF));
        pg8::Gemm g{(const bf16*)(ws + WS_H2F8), (const bf16*)(ws + WS_WGU), 512};
        EpiGateUp E{ws + WS_ACT, args.in[21], args.in[23], tab, ws + WS_DUMMY};
        REP(8) pg8::gemm_phase<EpiGateUp, MoeOrder, true, true>(X.lds, g, S, E);
        SEAM(8);
    }
    if (IN(9)) {
        moe_tables(args, X);
        LAS const int* tab = (LAS const int*)(X.lds + TAB_OFF);
        MoeOrder S{X.G, bid, 4, 1, tab, (LAS const int*)(X.lds + ROWTAB_OFF)};
        moe_rowtab(X, S, (const int*)(ws + WS_TOKOF));
        pg8::Gemm g{(const bf16*)(ws + WS_ACT), (const bf16*)(ws + WS_WD), 512};
        EpiDown E{(unsigned char*)X.out, ws + WS_YSHI, args.in[25], tab, (LAS const int*)(X.lds + ROWTAB_OFF), ws + WS_DUMMY};
        REP(9) pg8::gemm_phase<EpiDown, MoeOrder, true, true>(X.lds, g, S, E);
        SEAM(9);
    }
    if (IN(10)) { phase10(args, X); }
    if (PROBE_PHASE >= 0 && blockIdx.x == 0 && X.tid == 0) {
        const unsigned long long te = __builtin_amdgcn_s_memrealtime();
        unsigned long long t0, t1;
        if (PROBE_PHASE == 10) { t0 = ((unsigned long long)MISC[17 + 20] << 32) | MISC[16 + 20]; t1 = te; }
        else { t0 = ((unsigned long long)MISC[17 + 2 * PROBE_PHASE] << 32) | MISC[16 + 2 * PROBE_PHASE]; t1 = ((unsigned long long)MISC[19 + 2 * PROBE_PHASE] << 32) | MISC[18 + 2 * PROBE_PHASE]; }
#if defined(PROBE_BLK) || defined(PROBE_BLK7)
        const unsigned long long target = 8ull * (unsigned long long)__hip_atomic_load((unsigned*)(X.ws + WS_CTL) + 8, __ATOMIC_RELAXED, __HIP_MEMORY_SCOPE_AGENT);
#elif defined(PROBE_SUB)
        const unsigned long long target = 8ull * (unsigned long long)MISC[(PROBE_SUB >= 10 ? 40 : 40) + PROBE_SUB];
#else
        const unsigned long long target = 8ull * (t1 - t0);
#endif
        while (__builtin_amdgcn_s_memrealtime() - te < target) __builtin_amdgcn_s_sleep(8);
    }
#undef IN
#undef SEAM
}

extern "C" void kernel_launch(void* const* d_in, const int* in_sizes, int n_in, void* d_out, int out_size, void* d_ws, size_t ws_size, hipStream_t stream) {
    static int grid = 0;
    if (grid == 0) {
        if (n_in != 26 || in_sizes[0] != NTOK * DM || out_size != NTOK * DM || ws_size < WS_END) {
            fprintf(stderr, "kernel_launch: unexpected shapes / workspace (n_in %d, ws %zu, need %zu); nothing launched\n", n_in, ws_size, (size_t)WS_END); grid = -1; return; }
        int dev = 0, cus = 0, per_cu = 0;
        if (hipGetDevice(&dev) != hipSuccess || hipDeviceGetAttribute(&cus, hipDeviceAttributeMultiprocessorCount, dev) != hipSuccess) { grid = -1; return; }
        if (hipFuncSetAttribute((const void*)fwd, hipFuncAttributeMaxDynamicSharedMemorySize, LDS_BYTES) != hipSuccess) { fprintf(stderr, "kernel_launch: hipFuncSetAttribute failed\n"); grid = -1; return; }
        if (hipOccupancyMaxActiveBlocksPerMultiprocessor(&per_cu, (const void*)fwd, 512, LDS_BYTES) != hipSuccess || per_cu < 1) { fprintf(stderr, "kernel_launch: occupancy query says %d\n", per_cu); }
        (void)hipGetLastError();
        grid = cus;
    }
    if (grid < 0) return;
    if (hipMemsetAsync((char*)d_ws + WS_CTL, 0, CTL_ZERO_BYTES, stream) != hipSuccess) return;
    Args a{};
    for (int i = 0; i < 26; ++i) a.in[i] = (const float*)d_in[i];
    a.out = (float*)d_out; a.ws = (unsigned char*)d_ws;
#if MK_N_LAUNCHES == 1
    a.ph_lo = 0; a.ph_hi = N_PHASES;
    hipLaunchKernelGGL(fwd, dim3(grid), dim3(512), LDS_BYTES, stream, a);
#else
    for (int p = 0; p < N_PHASES; ++p) { a.ph_lo = p; a.ph_hi = p + 1; hipLaunchKernelGGL(fwd, dim3(grid), dim3(512), LDS_BYTES, stream, a); }
#endif
}
```
